# Optimizing an MI355X kernel written in HIP

```python
import math
import jax, jax.numpy as jnp
from jax import lax
import numpy as np

D_MODEL = 1024
BATCH = 8
SEQ = 4096
DEPTH = 4

GRID_W = 64
CTX_LEN = 256
N_MIXERS = 3
BLOCK = 128
ROPE_THETA = 10000.0
LN_EPS = 1e-5
RMS_EPS = 1e-6
DN_ALPHA = (2.0 * DEPTH) ** 0.25
DN_BETA = (8.0 * DEPTH) ** -0.25

A_HEADS = 16
A_KV_HEADS = 4
A_GROUP = A_HEADS // A_KV_HEADS
A_HEAD_DIM = D_MODEL // A_HEADS
A_WINDOW = 128
A_Q_COLS = A_HEADS * A_HEAD_DIM
A_KV_COLS = A_KV_HEADS * A_HEAD_DIM
A_IN_COLS = A_Q_COLS + 2 * A_KV_COLS

B_HEADS = 16
B_NOPE = 64
B_ROPE = 32
B_V = 64
B_Q_RANK = 512
B_KV_RANK = 256
B_IN_COLS = B_Q_RANK + B_KV_RANK + B_ROPE

C_HEADS = 8
C_HEAD_DIM = D_MODEL // (2 * C_HEADS)
C_V_DIM = 2 * C_HEAD_DIM
C_IN_COLS = 3 * C_HEADS * 2 * C_HEAD_DIM

N_GROUPS = 4
EXPERTS_PER_GROUP = 8
N_EXPERTS = N_GROUPS * EXPERTS_PER_GROUP
TOP_K = 2
D_EXPERT = 512
MOE_BLOCK = 128

N_A = len(range(0, DEPTH, N_MIXERS))
N_B = len(range(1, DEPTH, N_MIXERS))
N_C = len(range(2, DEPTH, N_MIXERS))

kernel_name = "hybrid_interleaved_diffusion_block"


def layer_norm(x, g, b):
    xf = x.astype(jnp.float32)
    mu = jnp.mean(xf, -1, keepdims=True)
    var = jnp.mean(jnp.square(xf - mu), -1, keepdims=True)
    y = (xf - mu) * lax.rsqrt(var + LN_EPS)
    return (y * g + b).astype(x.dtype)


def rms_norm(x, g):
    xf = x.astype(jnp.float32)
    y = xf * lax.rsqrt(jnp.mean(xf * xf, -1, keepdims=True) + RMS_EPS)
    return (y * g).astype(x.dtype)


def modulate(x, shift, scale):
    return x * (1 + scale) + shift


def axial_rope_tables(n_tokens, rot_dim):
    rows = n_tokens // GRID_W
    row = jnp.broadcast_to(jnp.arange(rows, dtype=jnp.float32)[:, None], (rows, GRID_W)).reshape(-1)
    col = jnp.broadcast_to(jnp.arange(GRID_W, dtype=jnp.float32)[None, :], (rows, GRID_W)).reshape(-1)
    axis_dim = rot_dim // 2
    inv_freq = ROPE_THETA ** (-jnp.arange(0, axis_dim, 2, dtype=jnp.float32) / axis_dim)
    ang_r = row[:, None] * inv_freq
    ang_c = col[:, None] * inv_freq
    return (jnp.cos(ang_r), jnp.sin(ang_r), jnp.cos(ang_c), jnp.sin(ang_c))


def _rotate(x, cos, sin):
    x1, x2 = jnp.split(x, 2, axis=-1)
    return jnp.concatenate([x1 * cos - x2 * sin, x2 * cos + x1 * sin], axis=-1)


def apply_axial_rope(x, tabs):
    cos_r, sin_r, cos_c, sin_c = [t.reshape((t.shape[0],) + (1,) * (x.ndim - 3) + (t.shape[1],)) for t in tabs]
    xr, xc = jnp.split(x.astype(jnp.float32), 2, axis=-1)
    return jnp.concatenate([_rotate(xr, cos_r, sin_r), _rotate(xc, cos_c, sin_c)], -1).astype(x.dtype)


def softmax_with_sink(s, sink):
    m = jnp.maximum(jnp.max(s, -1, keepdims=True), sink)
    p = jnp.exp(s - m)
    return p / (jnp.sum(p, -1, keepdims=True) + jnp.exp(sink - m))


def sweep_query_blocks(fn, q):
    B, S = q.shape[:2]
    qb = jnp.swapaxes(q.reshape((B, S // BLOCK, BLOCK) + q.shape[2:]), 0, 1)
    o = lax.map(fn, qb)
    return jnp.swapaxes(o, 0, 1).reshape(B, S, -1)


def window_gqa_mixer(h, hc, w_in, w_out, sink, rope, with_ctx_out):
    B, S, _ = h.shape
    L = hc.shape[1]
    scale = A_HEAD_DIM ** -0.5

    def project(t):
        n = t.shape[1]
        q, k, v = jnp.split(t @ w_in, [A_Q_COLS, A_Q_COLS + A_KV_COLS], axis=-1)
        return (q.reshape(B, n, A_KV_HEADS, A_GROUP, A_HEAD_DIM),
                k.reshape(B, n, A_KV_HEADS, A_HEAD_DIM),
                v.reshape(B, n, A_KV_HEADS, A_HEAD_DIM))

    q, k, v = project(h)
    qc, kc, vc = project(hc)
    q = apply_axial_rope(q, rope)
    k = apply_axial_rope(k, rope)
    sink_b = sink.astype(jnp.float32).reshape(1, A_KV_HEADS, A_GROUP, 1, 1)
    pad = ((0, 0), (BLOCK, BLOCK), (0, 0), (0, 0))
    k_pad = jnp.pad(k, pad)
    v_pad = jnp.pad(v, pad)
    q_off = jnp.arange(BLOCK)
    k_off = jnp.arange(3 * BLOCK)

    def attend_block(blk):
        start = blk * BLOCK
        qb = lax.dynamic_slice_in_dim(q, start, BLOCK, axis=1)
        kb = lax.dynamic_slice_in_dim(k_pad, start, 3 * BLOCK, axis=1)
        vb = lax.dynamic_slice_in_dim(v_pad, start, 3 * BLOCK, axis=1)
        q_pos = start + q_off
        k_pos = start - BLOCK + k_off
        valid = (jnp.abs(q_pos[:, None] - k_pos[None, :]) <= A_WINDOW) & (k_pos >= 0) & (k_pos < S)
        s_win = jnp.einsum('bqhgd,bkhd->bhgqk', qb, kb).astype(jnp.float32) * scale
        s_win = jnp.where(valid, s_win, -jnp.inf)
        s_ctx = jnp.einsum('bqhgd,bkhd->bhgqk', qb, kc).astype(jnp.float32) * scale
        p = softmax_with_sink(jnp.concatenate([s_win, s_ctx], -1), sink_b).astype(v.dtype)
        o = (jnp.einsum('bhgqk,bkhd->bqhgd', p[..., :3 * BLOCK], vb)
             + jnp.einsum('bhgqk,bkhd->bqhgd', p[..., 3 * BLOCK:], vc))
        return o.reshape(B, BLOCK, A_Q_COLS)

    o = lax.map(attend_block, jnp.arange(S // BLOCK))
    y = jnp.swapaxes(o, 0, 1).reshape(B, S, A_Q_COLS) @ w_out
    yc = None
    if with_ctx_out:
        s = jnp.einsum('bqhgd,bkhd->bhgqk', qc, kc).astype(jnp.float32) * scale
        p = softmax_with_sink(s, sink_b).astype(vc.dtype)
        yc = jnp.einsum('bhgqk,bkhd->bqhgd', p, vc).reshape(B, L, A_Q_COLS) @ w_out
    return y, yc


def mla_mixer(h, hc, w_in, q_norm, kv_norm, w_uq, w_ukv, w_out, rope, with_ctx_out):
    B = h.shape[0]
    scale = (B_NOPE + B_ROPE) ** -0.5

    def project(t, tabs):
        n = t.shape[1]
        c_q, c_kv, k_rope = jnp.split(t @ w_in, [B_Q_RANK, B_Q_RANK + B_KV_RANK], axis=-1)
        q = (rms_norm(c_q, q_norm) @ w_uq).reshape(B, n, B_HEADS, B_NOPE + B_ROPE)
        kv = (rms_norm(c_kv, kv_norm) @ w_ukv).reshape(B, n, B_HEADS, B_NOPE + B_V)
        q_nope, q_rope = jnp.split(q, [B_NOPE], axis=-1)
        k_nope, v = jnp.split(kv, [B_NOPE], axis=-1)
        k_rope = k_rope[:, :, None, :]
        if tabs is not None:
            q_rope = apply_axial_rope(q_rope, tabs)
            k_rope = apply_axial_rope(k_rope, tabs)
        k_rope = jnp.broadcast_to(k_rope, (B, n, B_HEADS, B_ROPE))
        return (jnp.concatenate([q_nope, q_rope], -1), jnp.concatenate([k_nope, k_rope], -1), v)

    def attend(qb, kk, vv):
        s = jnp.einsum('bqhd,bkhd->bhqk', qb, kk).astype(jnp.float32) * scale
        p = jax.nn.softmax(s, axis=-1).astype(vv.dtype)
        o = jnp.einsum('bhqk,bkhd->bqhd', p, vv)
        return o.reshape(o.shape[0], o.shape[1], B_HEADS * B_V)

    q, k, v = project(h, rope)
    qc, kc, vc = project(hc, None)
    k_all = jnp.concatenate([k, kc], axis=1)
    v_all = jnp.concatenate([v, vc], axis=1)
    y = sweep_query_blocks(lambda qb: attend(qb, k_all, v_all), q) @ w_out
    yc = attend(qc, kc, vc) @ w_out if with_ctx_out else None
    return y, yc


def diff_mixer(h, hc, w_in, lam_params, subln, w_out, rope, lambda_init, with_ctx_out):
    B = h.shape[0]
    scale = C_HEAD_DIM ** -0.5

    def project(t):
        n = t.shape[1]
        q, k, v = jnp.split(t @ w_in, 3, axis=-1)
        return (q.reshape(B, n, C_HEADS, 2, C_HEAD_DIM),
                k.reshape(B, n, C_HEADS, 2, C_HEAD_DIM),
                v.reshape(B, n, C_HEADS, C_V_DIM))

    q, k, v = project(h)
    qc, kc, vc = project(hc)
    q = apply_axial_rope(q, rope)
    k = apply_axial_rope(k, rope)
    lp = lam_params.astype(jnp.float32)
    lam = jnp.exp(jnp.sum(lp[0] * lp[1])) - jnp.exp(jnp.sum(lp[2] * lp[3])) + lambda_init

    def attend(qb, kk, vv):
        s = jnp.einsum('bqhid,bkhid->bhiqk', qb, kk).astype(jnp.float32) * scale
        p = jax.nn.softmax(s, axis=-1)
        a = (p[:, :, 0] - lam * p[:, :, 1]).astype(vv.dtype)
        o = jnp.einsum('bhqk,bkhe->bqhe', a, vv)
        o = rms_norm(o, subln) * (1.0 - lambda_init)
        return o.reshape(o.shape[0], o.shape[1], C_HEADS * C_V_DIM)

    k_all = jnp.concatenate([k, kc], axis=1)
    v_all = jnp.concatenate([v, vc], axis=1)
    y = sweep_query_blocks(lambda qb: attend(qb, k_all, v_all), q) @ w_out
    yc = attend(qc, kc, vc) @ w_out if with_ctx_out else None
    return y, yc


def hier_moe(h, w_grp, b_grp, w_rt, b_rt, w_gate, w_up, w_down):
    T, D = h.shape
    logits_g = (h @ w_grp).astype(jnp.float32) + b_grp.astype(jnp.float32)
    p_grp = jax.nn.softmax(logits_g, axis=-1)
    g_sel = jnp.argmax(logits_g, axis=-1).astype(jnp.int32)
    p_g = jnp.take_along_axis(p_grp, g_sel[:, None], axis=-1)
    logits_e = ((h @ w_rt).astype(jnp.float32) + b_rt.astype(jnp.float32)).reshape(T, N_GROUPS, EXPERTS_PER_GROUP)
    logits_in = jnp.take_along_axis(logits_e, g_sel[:, None, None], axis=1)[:, 0]
    top_v, top_i = lax.top_k(logits_in, TOP_K)
    weights = p_g * jax.nn.softmax(top_v, axis=-1)
    expert = g_sel[:, None] * EXPERTS_PER_GROUP + top_i.astype(jnp.int32)

    TK = T * TOP_K
    flat_e = expert.reshape(TK)
    flat_w = weights.reshape(TK)
    flat_t = jnp.repeat(jnp.arange(T, dtype=jnp.int32), TOP_K)
    order = jnp.argsort(flat_e)
    se, st, sw = flat_e[order], flat_t[order], flat_w[order]
    counts = jnp.bincount(flat_e, length=N_EXPERTS)
    padded = (counts + MOE_BLOCK - 1) // MOE_BLOCK * MOE_BLOCK
    pad_end = jnp.cumsum(padded)
    pad_start = pad_end - padded
    start = jnp.cumsum(counts) - counts
    dest = pad_start[se] + jnp.arange(TK, dtype=jnp.int32) - start[se]
    n_blocks = -(-TK // MOE_BLOCK) + N_EXPERTS
    buf_len = n_blocks * MOE_BLOCK
    buf_tok = jnp.full((buf_len,), T, jnp.int32).at[dest].set(st)
    buf_w = jnp.zeros((buf_len,), h.dtype).at[dest].set(sw.astype(h.dtype))
    block_e = jnp.minimum(jnp.searchsorted(pad_end, jnp.arange(n_blocks) * MOE_BLOCK, side='right'),
                          N_EXPERTS - 1).astype(jnp.int32)
    h_pad = jnp.concatenate([h, jnp.zeros((1, D), h.dtype)], axis=0)
    xb = h_pad[buf_tok].reshape(n_blocks, MOE_BLOCK, D)

    def expert_block(args):
        xblk, e = args
        return (jax.nn.silu(xblk @ w_gate[e]) * (xblk @ w_up[e])) @ w_down[e]

    yb = lax.map(expert_block, (xb, block_e)).reshape(buf_len, D)
    out = jnp.zeros((T + 1, D), h.dtype).at[buf_tok].add(yb * buf_w[:, None])
    return out[:T]


def setup_inputs(seed: int = 0) -> dict:
    key = jax.random.key(seed)
    counter = [0]

    def nrm(shape, scale):
        counter[0] += 1
        return jax.random.normal(jax.random.fold_in(key, counter[0]), shape, jnp.float32) * scale

    D = D_MODEL
    return {
        "x": nrm((BATCH, SEQ, D), 1.0),
        "c": nrm((BATCH, D), 1.0),
        "ctx": nrm((BATCH, CTX_LEN, D), 1.0),
        "c_ctx": nrm((D,), 1.0),
        "ada_w": nrm((DEPTH, D, 6 * D), 0.5 * D ** -0.5),
        "ada_b": nrm((DEPTH, 6 * D), 0.02),
        "ln_mix_g": 1.0 + nrm((DEPTH, D), 0.02),
        "ln_mix_b": nrm((DEPTH, D), 0.02),
        "ln_ffn_g": 1.0 + nrm((DEPTH, D), 0.02),
        "ln_ffn_b": nrm((DEPTH, D), 0.02),
        "win_w_in": nrm((N_A, D, A_IN_COLS), D ** -0.5),
        "win_w_out": nrm((N_A, A_Q_COLS, D), A_Q_COLS ** -0.5 * DN_BETA),
        "win_sink": nrm((N_A, A_HEADS), 0.5),
        "mla_w_in": nrm((N_B, D, B_IN_COLS), D ** -0.5),
        "mla_q_norm": 1.0 + nrm((N_B, B_Q_RANK), 0.02),
        "mla_kv_norm": 1.0 + nrm((N_B, B_KV_RANK), 0.02),
        "mla_w_uq": nrm((N_B, B_Q_RANK, B_HEADS * (B_NOPE + B_ROPE)), B_Q_RANK ** -0.5),
        "mla_w_ukv": nrm((N_B, B_KV_RANK, B_HEADS * (B_NOPE + B_V)), B_KV_RANK ** -0.5),
        "mla_w_out": nrm((N_B, B_HEADS * B_V, D), (B_HEADS * B_V) ** -0.5 * DN_BETA),
        "dif_w_in": nrm((N_C, D, C_IN_COLS), D ** -0.5),
        "dif_lambda": nrm((N_C, 4, C_HEAD_DIM), 0.1),
        "dif_subln": 1.0 + nrm((N_C, C_V_DIM), 0.02),
        "dif_w_out": nrm((N_C, C_HEADS * C_V_DIM, D), (C_HEADS * C_V_DIM) ** -0.5 * DN_BETA),
        "moe_w_grp": nrm((DEPTH, D, N_GROUPS), D ** -0.5),
        "moe_b_grp": nrm((DEPTH, N_GROUPS), 0.01),
        "moe_w_rt": nrm((DEPTH, D, N_EXPERTS), D ** -0.5),
        "moe_b_rt": nrm((DEPTH, N_EXPERTS), 0.01),
        "moe_w_gate": nrm((DEPTH, N_EXPERTS, D, D_EXPERT), D ** -0.5),
        "moe_w_up": nrm((DEPTH, N_EXPERTS, D, D_EXPERT), D ** -0.5),
        "moe_w_down": nrm((DEPTH, N_EXPERTS, D_EXPERT, D), D_EXPERT ** -0.5 * DN_BETA),
    }


def reference(x, c, ctx, c_ctx, ada_w, ada_b, ln_mix_g, ln_mix_b, ln_ffn_g, ln_ffn_b,
              win_w_in, win_w_out, win_sink,
              mla_w_in, mla_q_norm, mla_kv_norm, mla_w_uq, mla_w_ukv, mla_w_out,
              dif_w_in, dif_lambda, dif_subln, dif_w_out,
              moe_w_grp, moe_b_grp, moe_w_rt, moe_b_rt, moe_w_gate, moe_w_up, moe_w_down):
    B, S, D = x.shape
    L = ctx.shape[1]
    rope64 = axial_rope_tables(S, A_HEAD_DIM)
    rope32 = axial_rope_tables(S, B_ROPE)
    xc = ctx
    silu_c = jax.nn.silu(c)
    silu_cc = jax.nn.silu(c_ctx)
    for i in range(DEPTH):
        last = i == DEPTH - 1
        kind = i % N_MIXERS
        slot = i // N_MIXERS
        mod = silu_c @ ada_w[i] + ada_b[i]
        mod_c = silu_cc @ ada_w[i] + ada_b[i]
        sh_m, sc_m, g_m, sh_f, sc_f, g_f = jnp.split(mod[:, None, :], 6, axis=-1)
        csh_m, csc_m, cg_m, csh_f, csc_f, cg_f = jnp.split(mod_c, 6, axis=-1)

        h = modulate(x, sh_m, sc_m)
        hc = modulate(xc, csh_m, csc_m)
        if kind == 0:
            y, yc = window_gqa_mixer(h, hc, win_w_in[slot], win_w_out[slot], win_sink[slot], rope64, not last)
        elif kind == 1:
            y, yc = mla_mixer(h, hc, mla_w_in[slot], mla_q_norm[slot], mla_kv_norm[slot], mla_w_uq[slot],
                              mla_w_ukv[slot], mla_w_out[slot], rope32, not last)
        else:
            lambda_init = 0.8 - 0.6 * math.exp(-0.3 * i)
            y, yc = diff_mixer(h, hc, dif_w_in[slot], dif_lambda[slot], dif_subln[slot], dif_w_out[slot],
                               rope64, lambda_init, not last)
        x = layer_norm(DN_ALPHA * x + g_m * y, ln_mix_g[i], ln_mix_b[i])

        h = modulate(x, sh_f, sc_f)
        moe_args = (moe_w_grp[i], moe_b_grp[i], moe_w_rt[i], moe_b_rt[i], moe_w_gate[i], moe_w_up[i], moe_w_down[i])
        if not last:
            xc = layer_norm(DN_ALPHA * xc + cg_m * yc, ln_mix_g[i], ln_mix_b[i])
            hc = modulate(xc, csh_f, csc_f)
            y_all = hier_moe(jnp.concatenate([h.reshape(B * S, D), hc.reshape(B * L, D)], axis=0), *moe_args)
            y = y_all[:B * S].reshape(B, S, D)
            yc = y_all[B * S:].reshape(B, L, D)
            xc = layer_norm(DN_ALPHA * xc + cg_f * yc, ln_ffn_g[i], ln_ffn_b[i])
        else:
            y = hier_moe(h.reshape(B * S, D), *moe_args).reshape(B, S, D)
        x = layer_norm(DN_ALPHA * x + g_f * y, ln_ffn_g[i], ln_ffn_b[i])
    return x
```

```cpp
#include <hip/hip_runtime.h>
#include <stdint.h>
#include <math.h>

constexpr int D = 1024, NB = 8, S = 4096, L = 256, DEPTH = 4;
constexpr int TL = NB * S, TC = NB * L, T = TL + TC;
constexpr int NKEY = S + L;
constexpr int NE = 32, DE = 512;
constexpr float LN_EPS = 1e-5f, RMS_EPS = 1e-6f;
constexpr float DN_ALPHA = 1.6817928305074290861f;
constexpr float LOG2E = 1.4426950408889634f;
constexpr int NWAVES = 8, NTHREADS = 512;

#define LAS __attribute__((address_space(3)))
typedef unsigned short bf16_t;
typedef short bf16x8 __attribute__((ext_vector_type(8)));
typedef float f32x4 __attribute__((ext_vector_type(4)));
typedef float f32x2 __attribute__((ext_vector_type(2)));
typedef float f32x16 __attribute__((ext_vector_type(16)));
typedef unsigned u32x4 __attribute__((ext_vector_type(4)));
typedef unsigned u32x2 __attribute__((ext_vector_type(2)));

__device__ __forceinline__ unsigned cvt_pk_bf16(float lo, float hi) { unsigned r; asm volatile("v_cvt_pk_bf16_f32 %0, %1, %2" : "=v"(r) : "v"(lo), "v"(hi)); return r; }
__device__ __forceinline__ unsigned f2bf(float f) { unsigned u = __builtin_bit_cast(unsigned, f); return (u + 0x7fffu + ((u >> 16) & 1u)) >> 16; }
__device__ __forceinline__ float bf2f(unsigned h) { return __builtin_bit_cast(float, h << 16); }
__device__ __forceinline__ int mrow_of(int r) { return r < TL ? (r >> 12) : NB; }
__device__ __forceinline__ float dpp_add(float v, unsigned x, const int ctrl_unused) { return v; }
#define DPP_ADD_STEP(v, CTRL) v += __uint_as_float(__builtin_amdgcn_update_dpp(0u, __float_as_uint(v), CTRL, 0xF, 0xF, true))
__device__ __forceinline__ float xor16_sum(float v) { const unsigned x = __float_as_uint(v); auto r = __builtin_amdgcn_permlane16_swap(x, x, false, false); return __uint_as_float(r[0]) + __uint_as_float(r[1]); }
__device__ __forceinline__ float xor32_sum(float v) { const unsigned x = __float_as_uint(v); auto r = __builtin_amdgcn_permlane32_swap(x, x, false, false); return __uint_as_float(r[0]) + __uint_as_float(r[1]); }
typedef _Float16 f16x2 __attribute__((ext_vector_type(2)));
__device__ __forceinline__ unsigned pack_f16(float a, float b) { a = __builtin_fminf(__builtin_fmaxf(a, -65504.f), 65504.f); b = __builtin_fminf(__builtin_fmaxf(b, -65504.f), 65504.f);
    f16x2 h; h.x = (_Float16)a; h.y = (_Float16)b; return __builtin_bit_cast(unsigned, h); }
__device__ __forceinline__ float f16lo(unsigned u) { return (float)__builtin_bit_cast(f16x2, u).x; }
__device__ __forceinline__ float f16hi(unsigned u) { return (float)__builtin_bit_cast(f16x2, u).y; }
__device__ __forceinline__ float xor32_max(float v) { const unsigned x = __float_as_uint(v); auto r = __builtin_amdgcn_permlane32_swap(x, x, false, false); return fmaxf(__uint_as_float(r[0]), __uint_as_float(r[1])); }
__device__ __forceinline__ float wave_sum(float v) {
    DPP_ADD_STEP(v, 0xB1); DPP_ADD_STEP(v, 0x4E); DPP_ADD_STEP(v, 0x141); DPP_ADD_STEP(v, 0x140);
    return xor32_sum(xor16_sum(v));
}
__device__ __forceinline__ void wave_sum2(float& a, float& b) {
    DPP_ADD_STEP(a, 0xB1); DPP_ADD_STEP(b, 0xB1); DPP_ADD_STEP(a, 0x4E); DPP_ADD_STEP(b, 0x4E); DPP_ADD_STEP(a, 0x141); DPP_ADD_STEP(b, 0x141); DPP_ADD_STEP(a, 0x140); DPP_ADD_STEP(b, 0x140);
    a = xor16_sum(a); b = xor16_sum(b); a = xor32_sum(a); b = xor32_sum(b);
}

constexpr size_t MiB = 1u << 20;
constexpr size_t WS_CTL = 0, CTL_ZERO_BYTES = 128 * 1024;
constexpr int CW_Q = 512;
constexpr int CW_BAR = 1024;
constexpr int CW_CNT = 8192;
constexpr size_t WS_MOD = 1 * MiB;
constexpr size_t WS_TAB64 = 2 * MiB, WS_TAB32 = WS_TAB64 + 8192;
constexpr size_t WS_RTW = 3 * MiB;
constexpr size_t WS_TOKW = 4 * MiB;
constexpr size_t WS_SSQ = 5 * MiB;
constexpr size_t WS_STATS = 7 * MiB;
constexpr size_t WS_LIST = 8 * MiB;
constexpr size_t WS_WSMALL = 16 * MiB;
constexpr size_t W_A_IN = WS_WSMALL;
constexpr size_t W_A_OUT = W_A_IN + 2ull * 1536 * 1024 * 2;
constexpr size_t W_B_IN = W_A_OUT + 2ull * 1024 * 1024 * 2;
constexpr size_t W_B_UQ = W_B_IN + 1024ull * 1024 * 2;
constexpr size_t W_B_UKV = W_B_UQ + 1536ull * 512 * 2;
constexpr size_t W_B_OUT = W_B_UKV + 2048ull * 256 * 2;
constexpr size_t W_C_IN = W_B_OUT + 1024ull * 1024 * 2;
constexpr size_t W_C_OUT = W_C_IN + 3072ull * 1024 * 2;
constexpr size_t WS_WGU = 48 * MiB;
constexpr size_t WS_WD = WS_WGU + 4ull * 32 * 1024 * 1024 * 2;
constexpr size_t WS_X = WS_WD + 4ull * 32 * 1024 * 512 * 2;
constexpr size_t WS_H = WS_X + (size_t)T * 1024 * 4;
constexpr size_t WS_O = WS_H + (size_t)T * 1024 * 2;
constexpr size_t WS_R1 = WS_O + (size_t)T * 1024 * 2;
static_assert(W_C_OUT + 1024ull * 1024 * 2 <= WS_WGU, "small weights fit");
constexpr size_t R_QA = 0, R_KA = R_QA + (size_t)T * 1024 * 2, R_VTA = R_KA + (size_t)T * 256 * 2;
constexpr size_t R_CQ = 0, R_CKV = R_CQ + (size_t)T * 512 * 2, R_KR = R_CKV + (size_t)T * 256 * 2, R_QB = R_KR + (size_t)T * 32 * 2,
                 R_KN = R_QB + (size_t)T * 1536 * 2, R_VTB = R_KN + (size_t)T * 1024 * 2, R_ENDB = R_VTB + (size_t)NB * 16 * 64 * NKEY * 2;
constexpr size_t R_QC = 0, R_KC = R_QC + (size_t)T * 1024 * 2, R_VTC = R_KC + (size_t)T * 1024 * 2;
constexpr int NPOS = 2 * T + NE * 256;
constexpr size_t R_ACT = 0, R_Y2 = R_ACT + (size_t)NPOS * 512 * 2, R_ENDM = R_Y2 + (size_t)T * 2 * 1024 * 2;
constexpr size_t R_Y = R_ENDM, R_ENDY = R_Y + (size_t)T * 1024 * 2;
static_assert(R_ENDY <= R_ENDB, "MoE region + y inside R1");
constexpr size_t WS_END = WS_R1 + R_ENDB;

constexpr int LDS_BYTES = 147456;
constexpr int MISC_OFF = 146432;

#define XB_TMO      128
#define XB_XCNT(j)  (256  + 64 * (j))
#define XB_XSUB(j)  (1280 + 64 * (j))
#define XB_XGEN(j)  (2304 + 64 * (j))
#define XB_TOP      3328
#define XB_TOPGEN   3392
#define XCD_BAR_WORDS 3456
#define XB_SPIN_CAP (1u << 18)
__device__ __forceinline__ unsigned xb_ld(unsigned* p)              { return __hip_atomic_load(p, __ATOMIC_RELAXED, __HIP_MEMORY_SCOPE_AGENT); }
__device__ __forceinline__ unsigned xb_add(unsigned* p, unsigned v) { return __hip_atomic_fetch_add(p, v, __ATOMIC_RELAXED, __HIP_MEMORY_SCOPE_AGENT); }
__device__ __forceinline__ unsigned xb_xcc_id() { return (unsigned)__builtin_amdgcn_s_getreg((3 << 11) | 20) & 0xFu; }
#define XB_SPIN(cond, bar) do { unsigned _sp = 0; while (cond) { __builtin_amdgcn_s_sleep(1); \
    if ((++_sp & 255u) == 0u) { if (xb_ld(&(bar)[XB_TMO])) break; if (_sp > XB_SPIN_CAP) { atomicAdd(&(bar)[XB_TMO], 1u); break; } } } } while (0)
struct XcdBarrier { unsigned* bar; unsigned x; volatile LAS unsigned* st; };
__device__ __forceinline__ XcdBarrier xcd_barrier_post(unsigned* bar, volatile LAS unsigned* st) {
    XcdBarrier b; b.bar = bar; b.x = xb_xcc_id(); b.st = st;
    if (threadIdx.x == 0) (void)xb_add(&bar[XB_XCNT(b.x)], 1u);
    return b;
}
__device__ __forceinline__ void xcd_barrier_complete(unsigned* bar, unsigned x, unsigned& nloc, unsigned& nx) {
    const unsigned G = gridDim.x * gridDim.y * gridDim.z;
    unsigned sum, cnt, mine, sp = 0u;
    for (;;) {
        sum = 0u; cnt = 0u; mine = 0u;
#pragma unroll
        for (unsigned j = 0; j < 16; ++j) { const unsigned c = xb_ld(&bar[XB_XCNT(j)]); sum += c; cnt += (c > 0u) ? 1u : 0u; mine = (j == x) ? c : mine; }
        if (sum == G) break;
        __builtin_amdgcn_s_sleep(1);
        if ((++sp & 255u) == 0u) { if (xb_ld(&bar[XB_TMO])) break; if (sp > XB_SPIN_CAP) { atomicAdd(&bar[XB_TMO], 1u); break; } }
    }
    nloc = mine > 0u ? mine : 1u; nx = cnt > 0u ? cnt : 1u;
}
__device__ __forceinline__ void xcd_barrier(const XcdBarrier& b) {
    asm volatile("s_waitcnt vmcnt(0)" ::: "memory");
    __syncthreads();
    if (threadIdx.x == 0) {
        unsigned* bar = b.bar;
        __builtin_amdgcn_s_waitcnt(0);
        unsigned nloc = b.st[0], nx = b.st[1];
        if (nloc == 0u) { xcd_barrier_complete(bar, b.x, nloc, nx); b.st[0] = nloc; b.st[1] = nx; }
        const unsigned old = xb_add(&bar[XB_XSUB(b.x)], 1u);
        const unsigned gen = old / nloc;
        if (old + 1u == (gen + 1u) * nloc) {
            __builtin_amdgcn_fence(__ATOMIC_RELEASE, "agent");
            asm volatile("s_waitcnt vmcnt(0)" ::: "memory");
            const unsigned og = xb_add(&bar[XB_TOP], 1u);
            const unsigned tg = og / nx;
            if (og + 1u == (tg + 1u) * nx) xb_add(&bar[XB_TOPGEN], 1u);
            else XB_SPIN(xb_ld(&bar[XB_TOPGEN]) == tg, bar);
            __builtin_amdgcn_fence(__ATOMIC_ACQUIRE, "agent");
            xb_add(&bar[XB_XGEN(b.x)], 1u);
            asm volatile("s_waitcnt vmcnt(0)" ::: "memory");
        } else {
            XB_SPIN(xb_ld(&bar[XB_XGEN(b.x)]) == gen, bar);
            __builtin_amdgcn_fence(__ATOMIC_ACQUIRE, "agent");
            asm volatile("s_waitcnt vmcnt(0)" ::: "memory");
        }
    }
    __syncthreads();
}

namespace pg8 {
constexpr int BM = 256, BK = 64, HALF = 128, HTB = HALF * BK * 2, STAGE_BYTES = 8 * HTB, NXCD = 8, WGM = 2;
__host__ __device__ __forceinline__ int lds_byte(int r, int c) { const int st = (r >> 4) * 2 + (c >> 5), rr = r & 15, cc = c & 31, ob = rr * 64 + cc * 2; return st * 1024 + (ob ^ (((ob >> 9) & 1) << 5)); }
__host__ __device__ __forceinline__ void stage_rc(int b, int& R, int& C) { const int st = b / 1024, sb = b % 1024, swz = sb ^ (((sb >> 9) & 1) << 5); R = (st >> 1) * 16 + swz / 64; C = (st & 1) * 32 + (swz % 64) / 2; }
__host__ __device__ __forceinline__ int perm32(int rho) { const int n = rho >> 4, i = rho & 15; return 8 * (i >> 2) + 4 * n + (i & 3); }

struct Unit { int pm, pn, e, t, r0, nai; };
struct Gemm { const bf16_t* A; const bf16_t* Bt; int K; };

struct StaticOrder {
    static constexpr bool GATHER = false;
    int nM, nN, nwg, G, c;
    __device__ void init(int M, int N, int G_, int c_) { asm volatile("" : "+s"(G_), "+s"(c_));
        nM = M / BM; nN = N / BM; nwg = nM * nN; G = G_; c = c_; }
    __device__ bool next(int i, Unit& u) const {
        const int nfull = (nwg / G) * G, rem = nwg - nfull; const bool halves = rem > 0 && 2 * rem <= G;
        long Lx = (long)i * G + c; u.r0 = 0; u.nai = 2;
        if (Lx >= nfull && halves) { if (i * G != nfull || c >= 2 * rem) return false; Lx = nfull + (c >> 1); u.r0 = (c & 1) * HALF; u.nai = 1; }
        if (Lx >= nwg) return false;
        int wgid = (int)Lx; { const int q = nwg / NXCD, r = nwg % NXCD, xcd = wgid % NXCD, off = wgid / NXCD; wgid = (xcd < r ? xcd * (q + 1) : r * (q + 1) + (xcd - r) * q) + off; }
        const int nig = WGM * nN, gid = wgid / nig, fm = gid * WGM, gsz = (nM - fm) < WGM ? (nM - fm) : WGM;
        u.pm = fm + ((wgid % nig) % gsz); u.pn = (wgid % nig) / gsz; u.e = 0; u.t = 0; return true;
    }
    __device__ __forceinline__ int arow(const Unit& u, int r) const { return u.pm * BM + u.r0 + r; }
};

template <class Epi, class Sched, bool ALIGN_EPI>
__device__ __forceinline__ void gemm_phase(LAS unsigned char* lds, const Gemm g, const Sched& S, const Epi& E) {
    int tid_ = threadIdx.x; asm volatile("" : "+v"(tid_));
    const int tid = tid_, wid = __builtin_amdgcn_readfirstlane(tid >> 6), lane = tid & 63, wr = wid >> 2, wc = wid & 3, fr = lane & 15, fq = lane >> 4;
    const int K = g.K, nt = K / BK;
    unsigned voffB[2];
#pragma unroll
    for (int i = 0; i < 2; ++i) { int R, C; stage_rc(tid * 16 + i * 8192, R, C); const int Rb = Epi::PERM ? ((R & ~31) + perm32(R & 31)) : R;
        voffB[i] = (unsigned)(Rb * K + C) * 2u; }
    const size_t kstep = (size_t)(BK * 2);
    const size_t hstep = (size_t)HALF * K * 2;
    const size_t tstep = 2 * hstep;
    const unsigned ldsw = (unsigned)wid * 1024u;
    const int aoff = lds_byte(wr * 64 + fr, fq * 8), boff = lds_byte(wc * 32 + fr, fq * 8);
#define PG8_SA(b, h) (((b) * 2 + (h)) * HTB)
#define PG8_SB(b, h) ((4 + (b) * 2 + (h)) * HTB)
#define PG8_STAGE(bufoff, gbase, voff) do { _Pragma("unroll") for (int _i = 0; _i < 2; ++_i) \
        __builtin_amdgcn_global_load_lds((const unsigned*)((const char*)(gbase) + (voff)[_i]), (LAS unsigned*)(lds + (bufoff) + ldsw + _i * 8192), 16, 0, 0); } while (0)
#define PG8_LDA(dst, b, h) do { _Pragma("unroll") for (int m = 0; m < 4; ++m) _Pragma("unroll") for (int k = 0; k < 2; ++k) dst[m][k] = *(const LAS bf16x8*)(lds + PG8_SA(b, h) + aoff + m * 2048 + k * 1024); } while (0)
#define PG8_LDB(dst, b, h) do { _Pragma("unroll") for (int n = 0; n < 2; ++n) _Pragma("unroll") for (int k = 0; k < 2; ++k) dst[n][k] = *(const LAS bf16x8*)(lds + PG8_SB(b, h) + boff + n * 2048 + k * 1024); } while (0)
#define PG8_MMA(ai, bj, At, Bt) do { __builtin_amdgcn_s_setprio(1); _Pragma("unroll") for (int m = 0; m < 4; ++m) _Pragma("unroll") for (int n = 0; n < 2; ++n) _Pragma("unroll") for (int k = 0; k < 2; ++k) \
        acc[ai][bj][m][n] = __builtin_amdgcn_mfma_f32_16x16x32_bf16(Bt[n][k], At[m][k], acc[ai][bj][m][n], 0, 0, 0); __builtin_amdgcn_s_setprio(0); } while (0)
#define PG8_WAIT_V(n) asm volatile("s_waitcnt vmcnt(" #n ")" ::: "memory")
#define PG8_WAIT_L(n) asm volatile("s_waitcnt lgkmcnt(" #n ")" ::: "memory")
#define PG8_BAR __builtin_amdgcn_s_barrier()
#define PG8_SCHED __builtin_amdgcn_sched_barrier(0)
#define PG8_AOFF(dst, u) do { _Pragma("unroll") for (int _i = 0; _i < 2; ++_i) { int R_, C_; stage_rc(tid * 16 + _i * 8192, R_, C_); \
        _Pragma("unroll") for (int _h = 0; _h < 2; ++_h) dst[_h][_i] = (unsigned)(S.arow(u, _h * HALF + R_) * K + C_) * 2u; } } while (0)
    Unit cur, nxt; int ui = 0;
    if (!S.next(0, cur)) return;
    f32x4 acc[2][2][4][2];
#pragma unroll
    for (int a = 0; a < 2; ++a)
#pragma unroll
        for (int b = 0; b < 2; ++b)
#pragma unroll
            for (int m = 0; m < 4; ++m)
#pragma unroll
                for (int n = 0; n < 2; ++n) acc[a][b][m][n] = (f32x4){0.f, 0.f, 0.f, 0.f};
    bf16x8 At[4][2], B0[2][2], B1[2][2];
    unsigned voffA[2]; unsigned vA[2][2], nA_[2][2];
    const char* cA = (const char*)g.A; const char* nAp = cA;
    if constexpr (Sched::GATHER) { PG8_AOFF(vA, cur); }
    else {
#pragma unroll
        for (int i = 0; i < 2; ++i) { int R, C; stage_rc(tid * 16 + i * 8192, R, C); voffA[i] = (unsigned)(R * K + C) * 2u; }
        cA = (const char*)g.A + (size_t)cur.pm * tstep + (size_t)cur.r0 * K * 2;
    }
#define PG8_STA(bufoff, kptr, h, offs) do { if constexpr (Sched::GATHER) { PG8_STAGE(bufoff, kptr, offs[h]); } else { PG8_STAGE(bufoff, (kptr) + (h) * hstep, voffA); } } while (0)
    const char* cB = (const char*)g.Bt + (size_t)cur.pn * tstep;
    PG8_STAGE(PG8_SB(0, 0), cB, voffB); PG8_STAGE(PG8_SB(0, 1), cB + hstep, voffB); PG8_STA(PG8_SA(0, 0), cA, 0, vA); PG8_STA(PG8_SA(0, 1), cA, 1, vA);
    if (wr == 1) PG8_BAR;
    PG8_WAIT_V(2); PG8_BAR;
    PG8_STAGE(PG8_SB(1, 0), cB + kstep, voffB); PG8_STA(PG8_SA(1, 0), cA + kstep, 0, vA); PG8_STAGE(PG8_SB(1, 1), cB + hstep + kstep, voffB);
    PG8_WAIT_V(6); PG8_BAR;
    for (;;) {
        const bool has_next = S.next(ui + 1, nxt);
        if constexpr (Sched::GATHER) {
            if (has_next) { PG8_AOFF(nA_, nxt); } else {
#pragma unroll
                for (int _h = 0; _h < 2; ++_h)
#pragma unroll
                    for (int _i = 0; _i < 2; ++_i) nA_[_h][_i] = vA[_h][_i]; }
        } else { nAp = has_next ? (const char*)g.A + (size_t)nxt.pm * tstep + (size_t)nxt.r0 * K * 2 : cA; }
        const char* nB = has_next ? (const char*)g.Bt + (size_t)nxt.pn * tstep : cB;
        const bool full = cur.nai == 2;
#pragma unroll 1
        for (int t = 0; t < nt; t += 2) {
            const bool last = (t == nt - 2);
            const char* a1 = cA + (size_t)(t + 1) * kstep;
            const char* a2 = last ? nAp : cA + (size_t)(t + 2) * kstep; const char* b2 = last ? nB : cB + (size_t)(t + 2) * kstep;
            const char* a3 = a2 + kstep; const char* b3 = b2 + kstep;
            unsigned wq[2][2];
            if constexpr (Sched::GATHER) {
#pragma unroll
                for (int _h = 0; _h < 2; ++_h)
#pragma unroll
                    for (int _i = 0; _i < 2; ++_i) wq[_h][_i] = last ? nA_[_h][_i] : vA[_h][_i];
            }
            PG8_LDB(B0, 0, 0); PG8_LDB(B1, 0, 1); PG8_SCHED; PG8_LDA(At, 0, 0); PG8_STA(PG8_SA(1, 1), a1, 1, vA);
            PG8_WAIT_V(8); PG8_WAIT_L(0); PG8_BAR; PG8_MMA(0, 0, At, B0); PG8_MMA(0, 1, At, B1); PG8_BAR; PG8_SCHED;
            PG8_LDA(At, 0, 1); PG8_STAGE(PG8_SB(0, 0), b2, voffB); PG8_STAGE(PG8_SB(0, 1), b2 + hstep, voffB); PG8_STA(PG8_SA(0, 0), a2, 0, wq);
            PG8_WAIT_V(8); PG8_WAIT_L(0); PG8_BAR; if (full) { PG8_MMA(1, 0, At, B0); PG8_MMA(1, 1, At, B1); } PG8_BAR; PG8_SCHED;
            PG8_LDB(B0, 1, 0); PG8_LDB(B1, 1, 1); PG8_SCHED; PG8_LDA(At, 1, 0); PG8_STA(PG8_SA(0, 1), a2, 1, wq);
            PG8_WAIT_V(8); PG8_WAIT_L(0); PG8_BAR; PG8_MMA(0, 0, At, B0); PG8_MMA(0, 1, At, B1); PG8_BAR; PG8_SCHED;
            PG8_LDA(At, 1, 1); PG8_STAGE(PG8_SB(1, 0), b3, voffB); PG8_STAGE(PG8_SB(1, 1), b3 + hstep, voffB); PG8_STA(PG8_SA(1, 0), a3, 0, wq);
            PG8_WAIT_V(8); PG8_WAIT_L(0); PG8_BAR; if (full) { PG8_MMA(1, 0, At, B0); PG8_MMA(1, 1, At, B1); } PG8_BAR; PG8_SCHED;
        }
        if constexpr (ALIGN_EPI) { if (wr == 0) PG8_BAR; }
        E(acc, cur, wr, wc, fr, fq);
        if (!has_next) break;
#pragma unroll
        for (int a = 0; a < 2; ++a)
#pragma unroll
            for (int b = 0; b < 2; ++b)
#pragma unroll
                for (int m = 0; m < 4; ++m)
#pragma unroll
                    for (int n = 0; n < 2; ++n) acc[a][b][m][n] = (f32x4){0.f, 0.f, 0.f, 0.f};
        cur = nxt; cB = nB; ++ui;
        if constexpr (Sched::GATHER) {
#pragma unroll
            for (int _h = 0; _h < 2; ++_h)
#pragma unroll
                for (int _i = 0; _i < 2; ++_i) vA[_h][_i] = nA_[_h][_i];
        } else { cA = nAp; }
        if constexpr (ALIGN_EPI) { if (wr == 1) PG8_BAR; }
    }
    PG8_WAIT_V(0);
    if constexpr (!ALIGN_EPI) { if (wr == 0) PG8_BAR; }
    PG8_BAR;
#undef PG8_STA
#undef PG8_SA
#undef PG8_SB
#undef PG8_STAGE
#undef PG8_LDA
#undef PG8_LDB
#undef PG8_MMA
#undef PG8_WAIT_V
#undef PG8_WAIT_L
#undef PG8_BAR
#undef PG8_SCHED
#undef PG8_AOFF
}
}
namespace epi {
using pg8::Unit;
typedef float2 cs2;
__device__ __forceinline__ void rope8(f32x4& v0, f32x4& v1, const f32x4 c01, const f32x4 c23) {
    float a, b;
    a = v0[0]; b = v0[1]; v0[0] = a * c01[0] - b * c01[1]; v0[1] = b * c01[0] + a * c01[1];
    a = v0[2]; b = v0[3]; v0[2] = a * c01[2] - b * c01[3]; v0[3] = b * c01[2] + a * c01[3];
    a = v1[0]; b = v1[1]; v1[0] = a * c23[0] - b * c23[1]; v1[1] = b * c23[0] + a * c23[1];
    a = v1[2]; b = v1[3]; v1[2] = a * c23[2] - b * c23[3]; v1[3] = b * c23[2] + a * c23[3];
}
__device__ __forceinline__ u32x4 pack8(const f32x4 v0, const f32x4 v1) { u32x4 w; w.x = cvt_pk_bf16(v0[0], v0[1]); w.y = cvt_pk_bf16(v0[2], v0[3]); w.z = cvt_pk_bf16(v1[0], v1[1]); w.w = cvt_pk_bf16(v1[2], v1[3]); return w; }
__device__ __forceinline__ void store_vt(bf16_t* VT, int HV, int DV, int row, int vcol, const f32x4 v0, const f32x4 v1) {
    const int b = row < TL ? (row >> 12) : ((row - TL) >> 8), key = row < TL ? (row & 4095) : (S + ((row - TL) & 255));
    const int hv = vcol / DV, dv = vcol % DV;
    bf16_t* p = VT + ((size_t)(b * HV + hv) * DV + dv) * NKEY + key;
#pragma unroll
    for (int i = 0; i < 4; ++i) { p[(size_t)i * NKEY] = (bf16_t)f2bf(v0[i]); p[(size_t)(4 + i) * NKEY] = (bf16_t)f2bf(v1[i]); }
}

struct EpiQKV {
    static constexpr bool PERM = true;
    bf16_t* Q; int ldq; bf16_t* Kb; int ldk; bf16_t* VT; int HV, DV; int nQ, nK; float qscale; const float* tab64;
    __device__ __forceinline__ void operator()(const f32x4 (&acc)[2][2][4][2], const Unit& u, int wr, int wc, int fr, int fq) const {
        const int kindt = u.pn < nQ ? 0 : (u.pn < nQ + nK ? 1 : 2);
        const int tcol = (kindt == 0 ? u.pn : (kindt == 1 ? u.pn - nQ : u.pn - nQ - nK)) * 256 + wc * 32 + fq * 8;
#pragma unroll
        for (int ai = 0; ai < 2; ++ai) if (ai < u.nai)
#pragma unroll
            for (int m = 0; m < 4; ++m) {
                asm volatile("" ::: "memory");
                const int row = u.pm * 256 + u.r0 + ai * 128 + wr * 64 + m * 16 + fr;
                if (kindt == 2) {
#pragma unroll
                    for (int bj = 0; bj < 2; ++bj) store_vt(VT, HV, DV, row, tcol + bj * 128, acc[ai][bj][m][0], acc[ai][bj][m][1]);
                } else {
                    f32x4 c01 = (f32x4){1.f, 0.f, 1.f, 0.f}, c23 = c01;
                    if (row < TL) { const int s = row & 4095, pos = (wc & 1) ? (s & 63) : (s >> 6);
                        const f32x4* tp = (const f32x4*)(tab64 + ((size_t)pos * 16 + fq * 4) * 2); c01 = tp[0]; c23 = tp[1]; }
                    const float sc = kindt == 0 ? qscale : 1.f;
                    bf16_t* dst = (kindt == 0 ? Q + (size_t)row * ldq : Kb + (size_t)row * ldk) + tcol;
#pragma unroll
                    for (int bj = 0; bj < 2; ++bj) { f32x4 v0 = acc[ai][bj][m][0], v1 = acc[ai][bj][m][1]; rope8(v0, v1, c01, c23); v0 = v0 * sc; v1 = v1 * sc;
                        *(u32x4*)(dst + bj * 128) = pack8(v0, v1); }
                }
            }
    }
};
struct EpiB1 {
    static constexpr bool PERM = true;
    bf16_t* CQ; bf16_t* CKV; bf16_t* KR; float* SSQ; const float* tab32;
    __device__ __forceinline__ void operator()(const f32x4 (&acc)[2][2][4][2], const Unit& u, int wr, int wc, int fr, int fq) const {
#pragma unroll
        for (int ai = 0; ai < 2; ++ai) if (ai < u.nai)
#pragma unroll
            for (int m = 0; m < 4; ++m) {
                asm volatile("" ::: "memory");
                const int row = u.pm * 256 + u.r0 + ai * 128 + wr * 64 + m * 16 + fr;
                if (u.pn < 3) {
                    float ss = 0.f;
#pragma unroll
                    for (int bj = 0; bj < 2; ++bj)
#pragma unroll
                        for (int n = 0; n < 2; ++n) { const f32x4 v = acc[ai][bj][m][n]; ss += (v[0] * v[0] + v[1] * v[1]) + (v[2] * v[2] + v[3] * v[3]); }
                    ss = xor32_sum(xor16_sum(ss));
                    if (fq == 0) SSQ[(size_t)row * 12 + u.pn * 4 + wc] = ss;
                    bf16_t* dst = (u.pn < 2 ? CQ + (size_t)row * 512 + u.pn * 256 : CKV + (size_t)row * 256) + wc * 32 + fq * 8;
#pragma unroll
                    for (int bj = 0; bj < 2; ++bj) *(u32x4*)(dst + bj * 128) = pack8(acc[ai][bj][m][0], acc[ai][bj][m][1]);
                } else if (wc == 0) {
                    f32x4 v0 = acc[ai][0][m][0], v1 = acc[ai][0][m][1];
                    if (row < TL) { const int s = row & 4095, pos = (fq & 2) ? (s & 63) : (s >> 6);
                        const f32x4* tp = (const f32x4*)(tab32 + ((size_t)pos * 8 + (fq & 1) * 4) * 2); rope8(v0, v1, tp[0], tp[1]); }
                    *(u32x4*)(KR + (size_t)row * 32 + fq * 8) = pack8(v0, v1);
                }
            }
    }
};
struct EpiB2 {
    static constexpr bool PERM = true;
    bf16_t* QB; const float* SSQ; const float* tab32; float qscale;
    __device__ __forceinline__ void operator()(const f32x4 (&acc)[2][2][4][2], const Unit& u, int wr, int wc, int fr, int fq) const {
#pragma unroll
        for (int ai = 0; ai < 2; ++ai) if (ai < u.nai)
#pragma unroll
            for (int m = 0; m < 4; ++m) {
                asm volatile("" ::: "memory");
                const int row = u.pm * 256 + u.r0 + ai * 128 + wr * 64 + m * 16 + fr;
                const f32x4 s0 = *(const f32x4*)(SSQ + (size_t)row * 12), s1 = *(const f32x4*)(SSQ + (size_t)row * 12 + 4);
                const float ss = ((s0[0] + s0[1]) + (s0[2] + s0[3])) + ((s1[0] + s1[1]) + (s1[2] + s1[3]));
                const float sc = qscale / sqrtf(ss * (1.f / 512.f) + RMS_EPS);
#pragma unroll
                for (int bj = 0; bj < 2; ++bj) {
                    const int col = u.pn * 256 + bj * 128 + wc * 32 + fq * 8, w0 = col % 96;
                    f32x4 v0 = acc[ai][bj][m][0] * sc, v1 = acc[ai][bj][m][1] * sc;
                    if (w0 >= 64 && row < TL) { const int off = w0 - 64, s = row & 4095, pos = (off & 16) ? (s & 63) : (s >> 6);
                        const f32x4* tp = (const f32x4*)(tab32 + ((size_t)pos * 8 + ((off & 15) >> 1)) * 2); rope8(v0, v1, tp[0], tp[1]); }
                    *(u32x4*)(QB + (size_t)row * 1536 + col) = pack8(v0, v1);
                }
            }
    }
};
struct EpiB3 {
    static constexpr bool PERM = true;
    bf16_t* KN; bf16_t* VT; const float* SSQ;
    __device__ __forceinline__ void operator()(const f32x4 (&acc)[2][2][4][2], const Unit& u, int wr, int wc, int fr, int fq) const {
#pragma unroll
        for (int ai = 0; ai < 2; ++ai) if (ai < u.nai)
#pragma unroll
            for (int m = 0; m < 4; ++m) {
                asm volatile("" ::: "memory");
                const int row = u.pm * 256 + u.r0 + ai * 128 + wr * 64 + m * 16 + fr;
                const f32x4 s2 = *(const f32x4*)(SSQ + (size_t)row * 12 + 8);
                const float sc = 1.0f / sqrtf(((s2[0] + s2[1]) + (s2[2] + s2[3])) * (1.f / 256.f) + RMS_EPS);
#pragma unroll
                for (int bj = 0; bj < 2; ++bj) {
                    const f32x4 v0 = acc[ai][bj][m][0] * sc, v1 = acc[ai][bj][m][1] * sc;
                    const int tc = bj * 128 + wc * 32 + fq * 8;
                    if (u.pn < 4) *(u32x4*)(KN + (size_t)row * 1024 + u.pn * 256 + tc) = pack8(v0, v1);
                    else store_vt(VT, 16, 64, row, (u.pn - 4) * 256 + tc, v0, v1);
                }
            }
    }
};
struct EpiOut {
    static constexpr bool PERM = true;
    bf16_t* Y;
    __device__ __forceinline__ void operator()(const f32x4 (&acc)[2][2][4][2], const Unit& u, int wr, int wc, int fr, int fq) const {
#pragma unroll
        for (int ai = 0; ai < 2; ++ai) if (ai < u.nai)
#pragma unroll
            for (int m = 0; m < 4; ++m) {
                const int row = u.pm * 256 + u.r0 + ai * 128 + wr * 64 + m * 16 + fr;
#pragma unroll
                for (int bj = 0; bj < 2; ++bj)
                    *(u32x4*)(Y + (size_t)row * 1024 + u.pn * 256 + bj * 128 + wc * 32 + fq * 8) = pack8(acc[ai][bj][m][0], acc[ai][bj][m][1]);
            }
    }
};
struct EpiGU {
    static constexpr bool PERM = true;
    bf16_t* ACT;
    __device__ __forceinline__ void operator()(const f32x4 (&acc)[2][2][4][2], const Unit& u, int wr, int wc, int fr, int fq) const {
#pragma unroll
        for (int ai = 0; ai < 2; ++ai) if (ai < u.nai)
#pragma unroll
            for (int m = 0; m < 4; ++m) {
                asm volatile("" ::: "memory");
                const int row = u.pm * 256 + u.r0 + ai * 128 + wr * 64 + m * 16 + fr;
#pragma unroll
                for (int bj = 0; bj < 2; ++bj) {
                    const f32x4 g = acc[ai][bj][m][0], up = acc[ai][bj][m][1]; f32x4 a;
#pragma unroll
                    for (int i = 0; i < 4; ++i) a[i] = g[i] / (1.f + __expf(-g[i])) * up[i];
                    u32x2 w; w.x = cvt_pk_bf16(a[0], a[1]); w.y = cvt_pk_bf16(a[2], a[3]);
                    *(u32x2*)(ACT + (size_t)row * 512 + (u.pn & 3) * 128 + bj * 64 + wc * 16 + fq * 4) = w;
                }
            }
    }
};
struct EpiDown {
    static constexpr bool PERM = true;
    bf16_t* Y2; const int* list; const int* cnt; const float* tokw;
    __device__ __forceinline__ void operator()(const f32x4 (&acc)[2][2][4][2], const Unit& u, int wr, int wc, int fr, int fq) const {
        const int ne = cnt[u.e * 64];
#pragma unroll
        for (int ai = 0; ai < 2; ++ai) if (ai < u.nai)
#pragma unroll
            for (int m = 0; m < 4; ++m) {
                asm volatile("" ::: "memory");
                const int idx = u.t * 256 + u.r0 + ai * 128 + wr * 64 + m * 16 + fr;
                if (idx < ne) {
                    const int ent = list[(size_t)u.e * T + idx]; const float w = tokw[ent];
#pragma unroll
                    for (int bj = 0; bj < 2; ++bj)
                        *(u32x4*)(Y2 + (size_t)ent * 1024 + (u.pn & 3) * 256 + bj * 128 + wc * 32 + fq * 8) = pack8(acc[ai][bj][m][0] * w, acc[ai][bj][m][1] * w);
                }
            }
    }
};
}

template <bool GATHER_> struct MoeOrder {
    static constexpr bool GATHER = GATHER_;
    const LAS int* tp; const int* cnt; const int* list; int G, c;
    __device__ bool next(int i, pg8::Unit& u) const {
        const int nwg = tp[NE] * 4, nfull = (nwg / G) * G, rem = nwg - nfull; const bool halves = rem > 0 && 2 * rem <= G;
        int Lx = i * G + c; u.r0 = 0; u.nai = 2;
        if (Lx >= nfull && halves) { if (i * G != nfull || c >= 2 * rem) return false; Lx = nfull + (c >> 1); u.r0 = (c & 1) * 128; u.nai = 1; }
        if (Lx >= nwg) return false;
        const int tt = Lx >> 2;
        int e = 0;
#pragma unroll 1
        for (int k = 1; k < NE; ++k) e = (tp[k] <= tt) ? k : e;
        u.pm = tt; u.t = tt - tp[e]; u.e = e; u.pn = e * 4 + (Lx & 3); return true;
    }
    __device__ __forceinline__ int arow(const pg8::Unit& u, int r) const {
        if (!GATHER_) return u.pm * 256 + u.r0 + r;
        const int idx = u.t * 256 + u.r0 + r;
        return idx < cnt[u.e * 64] ? (list[(size_t)u.e * T + idx] >> 1) : 0;
    }
};
namespace attn {
struct Tensors {
    const bf16_t* Q; const bf16_t* K1; const bf16_t* K2; const bf16_t* VT; bf16_t* O;
    const float* sink; const float* lamp; const float* subln; float lambda_init;
};
__device__ __forceinline__ float max3f(float a, float b, float c) { float r; asm("v_max3_f32 %0, %1, %2, %3" : "=v"(r) : "v"(a), "v"(b), "v"(c)); return r; }
__device__ __forceinline__ float max32(const f32x16& a, const f32x16& b) {
    float r0 = max3f(a[0], a[1], a[2]), r1 = max3f(a[3], a[4], a[5]), r2 = max3f(a[6], a[7], a[8]), r3 = max3f(a[9], a[10], a[11]);
    r0 = max3f(r0, a[12], a[13]); r1 = max3f(r1, a[14], a[15]); r2 = max3f(r2, b[0], b[1]); r3 = max3f(r3, b[2], b[3]);
    r0 = max3f(r0, b[4], b[5]); r1 = max3f(r1, b[6], b[7]); r2 = max3f(r2, b[8], b[9]); r3 = max3f(r3, b[10], b[11]);
    r0 = max3f(r0, b[12], b[13]); r1 = max3f(r1, b[14], b[15]);
    return max3f(max3f(r0, r1, r2), r3, r3);
}
constexpr float ATT_THR = 10.f;
#define MFMA32(a, b, c) __builtin_amdgcn_mfma_f32_32x32x16_bf16((a), (b), (c), 0, 0, 0)

template <int KIND, bool PIPE = false, int VAR = 0>
__device__ __forceinline__ void phase(LAS unsigned char* lds, const Tensors P, int G, int cid, bool with_ctx) {
    asm volatile("" : "+s"(G), "+s"(cid));
    constexpr int NST = KIND == 1 ? 6 : 4, DV = KIND == 2 ? 128 : 64, NDV = DV / 32, KROWB = KIND == 0 ? 128 : 256, KCH = KIND == 0 ? 8 : (KIND == 1 ? 12 : 16);
    constexpr int KJ = (64 * KCH + 511) / 512, VJ = DV * 8 / 512, HV = KIND == 0 ? 4 : (KIND == 1 ? 16 : 8);
    constexpr int LDQ = KIND == 1 ? 1536 : 1024, LDK = KIND == 0 ? 256 : 1024;
    constexpr int KB0 = 0, VB0 = 32768, BUFSTEP = 16384, SCR = 65536;
    int tid_ = threadIdx.x; asm volatile("" : "+v"(tid_));
    const int tid = tid_, lane = tid & 63, w = __builtin_amdgcn_readfirstlane(tid >> 6), r = lane & 31, hh = lane >> 5;
    const int NU = 2048 + (with_ctx ? 128 : 0);
    constexpr int KPIECES = 64 * KROWB / 8192, VPIECES = DV * 128 / 8192;
    int ksrc[KPIECES], ksrb[KPIECES]; bool kpart2[KPIECES];
#pragma unroll
    for (int j = 0; j < KPIECES; ++j) {
        const int p = (j * 8 + w) * 1024 + lane * 16, kk = p / KROWB, pc = (p % KROWB) >> 4;
        int c = pc ^ (KROWB == 128 ? ((kk >> 1) & 7) : (kk & 15)); if (c >= KCH) c = 0;
        kpart2[j] = (KIND == 1) && c >= 8;
        ksrc[j] = kpart2[j] ? kk * 32 + (c - 8) * 8 : kk * LDK + c * 8;
        ksrb[j] = kpart2[j] ? 32 : LDK;
    }
    int vsrc[VPIECES];
#pragma unroll
    for (int j = 0; j < VPIECES; ++j) { const int p = (j * 8 + w) * 1024 + lane * 16, dv = p >> 7, pc = (p & 127) >> 4, c = pc ^ ((dv >> 1) & 7); vsrc[j] = dv * NKEY + c * 8; }
    const int rs = (r & ~12) | ((r & 4) << 1) | ((r & 8) >> 1);
    const int krow0 = rs * KROWB, krow1 = (32 + rs) * KROWB;
    const int ksw0 = KROWB == 128 ? ((rs >> 1) & 7) : (rs & 15), ksw1 = KROWB == 128 ? (((32 + rs) >> 1) & 7) : ((32 + rs) & 15);
    const int vsw = (r >> 1) & 7;
    float lam = 0.f;
    if (KIND == 2) { const float a = wave_sum(P.lamp[lane] * P.lamp[64 + lane]), b2 = wave_sum(P.lamp[128 + lane] * P.lamp[192 + lane]); lam = expf(a) - expf(b2) + P.lambda_init; }

#define ATT_DECL(X) int X##b = 0, X##hd = 0, X##qb = 0, X##qi = 0, X##wlo = 0, X##nwin = 0, X##nt = 0, X##ocol = 0, X##qcol = 0, X##kcol = 0, X##hv = 0, X##cmap = 0, X##qrow = 0, X##lat = 0
#define ATT_COPY(D_, S_) do { D_##b = S_##b; D_##hd = S_##hd; D_##qb = S_##qb; D_##qi = S_##qi; D_##wlo = S_##wlo; D_##nwin = S_##nwin; D_##nt = S_##nt; D_##ocol = S_##ocol; D_##qcol = S_##qcol; D_##kcol = S_##kcol; D_##hv = S_##hv; D_##cmap = S_##cmap; D_##qrow = S_##qrow; D_##lat = S_##lat; } while (0)
#define ATT_DECODE(U_, X) do { X##lat = (U_) < 2048; const int V_ = X##lat ? (U_) : (U_) - 2048; X##wlo = 0; X##nwin = 0; X##cmap = 0; int q0_; \
        if (KIND == 0) { \
            if (X##lat) { X##b = V_ >> 8; X##hd = (V_ >> 6) & 3; X##qb = V_ & 63; const int whi = X##qb + 2 > 63 ? 63 : X##qb + 2; X##wlo = X##qb - 2 < 0 ? 0 : X##qb - 2; X##nwin = whi - X##wlo + 1; } \
            else { X##b = V_ >> 4; X##hd = (V_ >> 2) & 3; X##qb = V_ & 3; } \
            q0_ = X##qb * 64; X##qi = q0_ + 32 * (w & 1) + r; const int hq = X##hd * 4 + (w >> 1); X##qcol = hq * 64; X##ocol = hq * 64; X##kcol = X##hd * 64; X##hv = X##hd; X##nt = X##nwin + 4; \
        } else if (KIND == 1) { \
            if (X##lat) { X##b = V_ >> 8; X##hd = (V_ >> 4) & 15; X##qb = V_ & 15; X##nt = 68; } else { X##b = V_ >> 4; X##hd = V_ & 15; X##qb = 0; X##nt = 4; } \
            q0_ = X##qb * 256; X##qi = q0_ + 32 * w + r; X##qcol = X##hd * 96; X##ocol = X##hd * 64; X##kcol = X##hd * 64; X##hv = X##hd; \
        } else { \
            if (X##lat) { X##b = V_ >> 8; X##hd = (V_ >> 5) & 7; X##qb = V_ & 31; X##nt = 68; } else { X##b = V_ >> 4; X##hd = (V_ >> 1) & 7; X##qb = V_ & 1; X##nt = 4; } \
            q0_ = X##qb * 128; X##qi = q0_ + 32 * (w & 3) + r; X##cmap = (w >> 2) * 8; X##qcol = (X##hd * 2 + (w >> 2)) * 64; X##ocol = X##hd * 128; X##kcol = X##hd * 128; X##hv = X##hd; \
        } \
        X##qrow = X##lat ? X##b * S + X##qi : TL + X##b * L + X##qi; } while (0)
#define ATT_TILE_KT(X, tt) ((KIND == 0) ? ((tt) < X##nwin ? X##wlo + (tt) : 64 + (tt) - X##nwin) : (X##lat ? (tt) : 64 + (tt)))
#define ATT_ISSUE(X, tt, buf_) do { const int kt_ = ATT_TILE_KT(X, tt); const int rb_ = kt_ < 64 ? X##b * S + 64 * kt_ : TL + X##b * L + 64 * (kt_ - 64); \
        const bf16_t* K1u_ = P.K1 + X##kcol; const bf16_t* VTu_ = P.VT + (size_t)(X##b * HV + X##hv) * DV * NKEY; \
        _Pragma("unroll") for (int j = 0; j < KPIECES; ++j) __builtin_amdgcn_global_load_lds((const unsigned*)((kpart2[j] ? P.K2 : K1u_) + (size_t)rb_ * ksrb[j] + ksrc[j]), (LAS unsigned*)(lds + KB0 + (buf_) * BUFSTEP + (j * 8 + w) * 1024), 16, 0, 0); \
        _Pragma("unroll") for (int j = 0; j < VPIECES; ++j) __builtin_amdgcn_global_load_lds((const unsigned*)(VTu_ + 64 * kt_ + vsrc[j]), (LAS unsigned*)(lds + VB0 + (buf_) * BUFSTEP + (j * 8 + w) * 1024), 16, 0, 0); } while (0)
#define ATT_QLOAD(dst, X) do { _Pragma("unroll") for (int st = 0; st < NST; ++st) dst[st] = *(const bf16x8*)(P.Q + (size_t)X##qrow * LDQ + X##qcol + 16 * st + 8 * hh); } while (0)
#define ATT_VFRAG(d, sub, sp) (*(const LAS bf16x8*)(vb + (32 * (d) + r) * 128 + 16 * ((4 * (sub) + 2 * (sp) + hh) ^ vsw)))
#define ATT_QX(SV, sp, lo, hi) do { _Pragma("unroll") for (int i_ = (lo); i_ < (hi); i_ += 2) { f32x2 t_; t_.x = __builtin_amdgcn_exp2f(SV[8 * (sp) + i_]); t_.y = __builtin_amdgcn_exp2f(SV[8 * (sp) + i_ + 1]); SV[8 * (sp) + i_] = t_.x; SV[8 * (sp) + i_ + 1] = t_.y; psv += t_; } } while (0)
#define ATT_QC(SV, sub, sp) do { u32x4 a_; a_.x = cvt_pk_bf16(SV[8 * (sp) + 0], SV[8 * (sp) + 1]); a_.y = cvt_pk_bf16(SV[8 * (sp) + 2], SV[8 * (sp) + 3]); a_.z = cvt_pk_bf16(SV[8 * (sp) + 4], SV[8 * (sp) + 5]); a_.w = cvt_pk_bf16(SV[8 * (sp) + 6], SV[8 * (sp) + 7]); pf[sub][sp] = __builtin_bit_cast(bf16x8, a_); } while (0)
#define ATT_TILE(tt, ISLAST) do { \
            const int buf = ((tt) + pb) & 1; \
            ATT_DECL(nx); if (ISLAST) { const int Un_ = U + G < NU ? U + G : U; ATT_DECODE(Un_, nx); ATT_ISSUE(nx, 0, buf ^ 1); } else { ATT_ISSUE(cu, (tt) + 1, buf ^ 1); } \
            const LAS unsigned char* kb = lds + KB0 + buf * BUFSTEP; const LAS unsigned char* vb = lds + VB0 + buf * BUFSTEP; \
            const float negm = -m; \
            f32x16 s0, s1; \
            _Pragma("unroll") for (int i = 0; i < 16; ++i) { s0[i] = negm; s1[i] = negm; } \
            { bf16x8 kf[NST][2]; \
              _Pragma("unroll") for (int st = 0; st < NST; ++st) { const int c = 2 * st + hh + cucmap; \
                  kf[st][0] = *(const LAS bf16x8*)(kb + krow0 + 16 * (c ^ ksw0)); kf[st][1] = *(const LAS bf16x8*)(kb + krow1 + 16 * (c ^ ksw1)); } \
              __builtin_amdgcn_sched_barrier(0); \
              __builtin_amdgcn_s_setprio(1); \
              _Pragma("unroll") for (int st = 0; st < NST; ++st) { s0 = MFMA32(kf[st][0], qf[st], s0); s1 = MFMA32(kf[st][1], qf[st], s1); } \
              __builtin_amdgcn_s_setprio(0); } \
            if (ISLAST) { __builtin_amdgcn_sched_barrier(0); ATT_QLOAD(qf, nx); }        \
            constexpr int NDVP = NDV < 2 ? NDV : 2; \
            bf16x8 vf[NDVP][2][2]; bf16x8 vq[2][4]; \
            if (NDV == 4) { _Pragma("unroll") for (int q = 0; q < 2; ++q) _Pragma("unroll") for (int d = 0; d < 4; ++d) vq[q][d] = ATT_VFRAG(d, 0, q); } \
            else { _Pragma("unroll") for (int d = 0; d < NDVP; ++d) _Pragma("unroll") for (int sub = 0; sub < 2; ++sub) _Pragma("unroll") for (int sp = 0; sp < 2; ++sp) vf[d][sub][sp] = ATT_VFRAG(d, sub, sp); } \
            __builtin_amdgcn_sched_barrier(0); \
            if (KIND == 0) { const int kt = ATT_TILE_KT(cu, tt); \
                if (kt < 64 && (kt == cuqb - 2 || kt == cuqb + 2)) { const int d0 = 64 * kt + 8 * hh - cuqi; \
                    _Pragma("unroll") for (int i = 0; i < 16; ++i) { const int da = d0 + (i & 7) + 16 * (i >> 3), db = da + 32; \
                        if (da < -128 || da > 128) s0[i] = -INFINITY; if (db < -128 || db > 128) s1[i] = -INFINITY; } } } \
            float mx = max32(s0, s1); \
            mx = xor32_max(mx); \
            const bool first = (KIND != 0) && (tt) == 0; \
            if (first || __any(mx > ATT_THR)) { \
                const float d = first ? mx : fmaxf(mx, 0.f), alpha = first ? 1.f : __builtin_amdgcn_exp2f(-d); \
                m += d; lsum *= alpha; \
                _Pragma("unroll") for (int dd = 0; dd < NDV; ++dd) o[dd] = o[dd] * alpha; \
                _Pragma("unroll") for (int i = 0; i < 16; ++i) { s0[i] -= d; s1[i] -= d; } } \
            f32x2 psv; psv.x = 0.f; psv.y = 0.f; \
            bf16x8 pf[2][2]; \
            ATT_QX(s0, 0, 0, 8); ATT_QC(s0, 0, 0); \
            __builtin_amdgcn_sched_barrier(0); \
            if (NDV == 4) { \
                  \
                o[0] = MFMA32(vq[0][0], pf[0][0], o[0]); o[1] = MFMA32(vq[0][1], pf[0][0], o[1]); __builtin_amdgcn_sched_barrier(0); ATT_QX(s0, 1, 0, 4); __builtin_amdgcn_sched_barrier(0); \
                o[2] = MFMA32(vq[0][2], pf[0][0], o[2]); o[3] = MFMA32(vq[0][3], pf[0][0], o[3]); __builtin_amdgcn_sched_barrier(0); ATT_QX(s0, 1, 4, 8); ATT_QC(s0, 0, 1); __builtin_amdgcn_sched_barrier(0); \
                _Pragma("unroll") for (int d = 0; d < 4; ++d) vq[0][d] = ATT_VFRAG(d, 1, 0); \
                __builtin_amdgcn_sched_barrier(0); \
                o[0] = MFMA32(vq[1][0], pf[0][1], o[0]); o[1] = MFMA32(vq[1][1], pf[0][1], o[1]); __builtin_amdgcn_sched_barrier(0); ATT_QX(s1, 0, 0, 4); __builtin_amdgcn_sched_barrier(0); \
                o[2] = MFMA32(vq[1][2], pf[0][1], o[2]); o[3] = MFMA32(vq[1][3], pf[0][1], o[3]); __builtin_amdgcn_sched_barrier(0); ATT_QX(s1, 0, 4, 8); ATT_QC(s1, 1, 0); __builtin_amdgcn_sched_barrier(0); \
                _Pragma("unroll") for (int d = 0; d < 4; ++d) vq[1][d] = ATT_VFRAG(d, 1, 1); \
                __builtin_amdgcn_sched_barrier(0); \
                o[0] = MFMA32(vq[0][0], pf[1][0], o[0]); o[1] = MFMA32(vq[0][1], pf[1][0], o[1]); __builtin_amdgcn_sched_barrier(0); ATT_QX(s1, 1, 0, 4); __builtin_amdgcn_sched_barrier(0); \
                o[2] = MFMA32(vq[0][2], pf[1][0], o[2]); o[3] = MFMA32(vq[0][3], pf[1][0], o[3]); __builtin_amdgcn_sched_barrier(0); ATT_QX(s1, 1, 4, 8); ATT_QC(s1, 1, 1); __builtin_amdgcn_sched_barrier(0); \
                o[0] = MFMA32(vq[1][0], pf[1][1], o[0]); o[1] = MFMA32(vq[1][1], pf[1][1], o[1]); o[2] = MFMA32(vq[1][2], pf[1][1], o[2]); o[3] = MFMA32(vq[1][3], pf[1][1], o[3]); \
            } else { \
                o[0] = MFMA32(vf[0][0][0], pf[0][0], o[0]); __builtin_amdgcn_sched_barrier(0); ATT_QX(s0, 1, 0, 4); __builtin_amdgcn_sched_barrier(0); \
                o[1] = MFMA32(vf[1][0][0], pf[0][0], o[1]); __builtin_amdgcn_sched_barrier(0); ATT_QX(s0, 1, 4, 8); ATT_QC(s0, 0, 1); __builtin_amdgcn_sched_barrier(0); \
                o[0] = MFMA32(vf[0][0][1], pf[0][1], o[0]); __builtin_amdgcn_sched_barrier(0); ATT_QX(s1, 0, 0, 4); __builtin_amdgcn_sched_barrier(0); \
                o[1] = MFMA32(vf[1][0][1], pf[0][1], o[1]); __builtin_amdgcn_sched_barrier(0); ATT_QX(s1, 0, 4, 8); ATT_QC(s1, 1, 0); __builtin_amdgcn_sched_barrier(0); \
                o[0] = MFMA32(vf[0][1][0], pf[1][0], o[0]); __builtin_amdgcn_sched_barrier(0); ATT_QX(s1, 1, 0, 4); __builtin_amdgcn_sched_barrier(0); \
                o[1] = MFMA32(vf[1][1][0], pf[1][0], o[1]); __builtin_amdgcn_sched_barrier(0); ATT_QX(s1, 1, 4, 8); ATT_QC(s1, 1, 1); __builtin_amdgcn_sched_barrier(0); \
                o[0] = MFMA32(vf[0][1][1], pf[1][1], o[0]); o[1] = MFMA32(vf[1][1][1], pf[1][1], o[1]); \
            } \
            lsum += psv.x + psv.y; \
            __syncthreads(); } while (0)

    int pb = 0;
    bf16x8 qf[NST];
    if (cid < NU) { ATT_DECL(cu); ATT_DECODE(cid, cu); ATT_QLOAD(qf, cu); ATT_ISSUE(cu, 0, 0); __syncthreads(); }
    for (int U = cid; U < NU; U += G) {
        ATT_DECL(cu); ATT_DECODE(U, cu);
        const int nt = cunt, qrow = cuqrow, ocol = cuocol;
        float m = 0.f, lsum = 0.f;
        if (KIND == 0) { m = P.sink[cuhd * 4 + (w >> 1)] * LOG2E; lsum = hh == 0 ? 1.f : 0.f; }
        f32x16 o[NDV];
#pragma unroll
        for (int d = 0; d < NDV; ++d)
#pragma unroll
            for (int i = 0; i < 16; ++i) o[d][i] = 0.f;
        for (int tt = 0; tt < nt - 1; ++tt) ATT_TILE(tt, 0);
        ATT_TILE(nt - 1, 1);
        pb = (nt + pb) & 1;
        const float inv = 1.f / (xor32_sum(lsum));
        if (KIND != 2) {
#pragma unroll
            for (int d = 0; d < NDV; ++d)
#pragma unroll
                for (int g4 = 0; g4 < 4; ++g4) {
                    u32x2 wv; wv.x = cvt_pk_bf16(o[d][4 * g4] * inv, o[d][4 * g4 + 1] * inv); wv.y = cvt_pk_bf16(o[d][4 * g4 + 2] * inv, o[d][4 * g4 + 3] * inv);
                    *(u32x2*)(P.O + (size_t)qrow * 1024 + ocol + 32 * d + 8 * g4 + 4 * hh) = wv;
                }
        } else {
            LAS float* scr = (LAS float*)(lds + SCR) + (size_t)(w & 3) * 64 * 64 + lane;
            if (w >= 4) {
#pragma unroll
                for (int d = 0; d < NDV; ++d)
#pragma unroll
                    for (int i = 0; i < 16; ++i) scr[(d * 16 + i) * 64] = o[d][i] * inv;
            }
            __syncthreads();
            if (w < 4) {
                float ss = 0.f;
#pragma unroll
                for (int d = 0; d < NDV; ++d)
#pragma unroll
                    for (int i = 0; i < 16; ++i) { const float v = o[d][i] * inv - lam * scr[(d * 16 + i) * 64]; o[d][i] = v; ss += v * v; }
                ss = xor32_sum(ss);
                const float rsn = (1.f - P.lambda_init) / sqrtf(ss * (1.f / 128.f) + RMS_EPS);
#pragma unroll
                for (int d = 0; d < NDV; ++d)
#pragma unroll
                    for (int g4 = 0; g4 < 4; ++g4) {
                        const int dv0 = 32 * d + 8 * g4 + 4 * hh; const f32x4 gv = *(const f32x4*)(P.subln + dv0);
                        u32x2 wv; wv.x = cvt_pk_bf16(o[d][4 * g4] * rsn * gv[0], o[d][4 * g4 + 1] * rsn * gv[1]); wv.y = cvt_pk_bf16(o[d][4 * g4 + 2] * rsn * gv[2], o[d][4 * g4 + 3] * rsn * gv[3]);
                        *(u32x2*)(P.O + (size_t)qrow * 1024 + ocol + dv0) = wv;
                    }
            }
        }
    }
#undef ATT_DECL
#undef ATT_COPY
#undef ATT_DECODE
#undef ATT_TILE_KT
#undef ATT_ISSUE
#undef ATT_QLOAD
#undef ATT_TILE
}
}
namespace thin {
__device__ __forceinline__ int sig64(int p) { return (p >> 5) * 32 + ((p & 31) >> 1) + 16 * (p & 1); }
__device__ __forceinline__ int sig32(int p) { return (p >> 4) * 16 + ((p & 15) >> 1) + 8 * (p & 1); }
__device__ __forceinline__ int src_col(int mode, int lim, int n, bool& second) {
    second = false;
    switch (mode) {
        case 1: return n < lim ? (n & ~63) + sig64(n & 63) : n;
        case 2: return n < 768 ? n : (n < 800 ? 768 + sig32(n - 768) : -1);
        case 3: { const int hq = n / 96, w = n % 96; return w < 64 ? n : hq * 96 + 64 + sig32(w - 64); }
        case 4: return n < 1024 ? (n >> 6) * 128 + (n & 63) : ((n - 1024) >> 6) * 128 + 64 + (n & 63);
        case 5: second = (n & 7) >= 4; return 4 * (n >> 3) + (n & 3);
        default: return n;
    }
}
__device__ __forceinline__ void conv_item(const float* src, const float* src2, const float* gain, int Nsrc, int K, int N, int mode, int lim, bf16_t* WT, int item, LAS float* scr, int lane) {
    const int nblk = N >> 6, kb = item / nblk, nb = item % nblk, k0 = kb * 64, n0 = nb * 64;
    bool second; const int col = src_col(mode, lim, n0 + lane, second);
    const float* sp = (second ? src2 : src) + (col < 0 ? 0 : col);
    float vv[64];
#pragma unroll
    for (int kk = 0; kk < 64; ++kk) vv[kk] = col < 0 ? 0.f : __builtin_nontemporal_load(sp + (size_t)(k0 + kk) * Nsrc);
    if (gain) {
#pragma unroll
        for (int kk = 0; kk < 64; ++kk) vv[kk] *= gain[k0 + kk];
    }
#pragma unroll
    for (int kk = 0; kk < 64; ++kk) scr[kk * 65 + lane] = vv[kk];
    asm volatile("s_waitcnt lgkmcnt(0)" ::: "memory");
    const int c = lane & 7;
#pragma unroll
    for (int j = 0; j < 8; ++j) { const int n = (lane >> 3) + 8 * j; const LAS float* s = scr + (8 * c) * 65 + n;
        u32x4 o; o.x = cvt_pk_bf16(s[0 * 65], s[1 * 65]); o.y = cvt_pk_bf16(s[2 * 65], s[3 * 65]); o.z = cvt_pk_bf16(s[4 * 65], s[5 * 65]); o.w = cvt_pk_bf16(s[6 * 65], s[7 * 65]);
        __builtin_nontemporal_store(o, (u32x4*)(WT + (size_t)(n0 + n) * K + k0 + 8 * c)); }
    asm volatile("s_waitcnt lgkmcnt(0)" ::: "memory");
}
constexpr int MOE_ITEMS = NE * 256 + NE * 128;
__device__ __forceinline__ void moe_fill(LAS unsigned char* lds, const float* w_gate, const float* w_up, const float* w_down, unsigned char* ws, int layer, int max_items, int* qctr) {
    int tid_ = threadIdx.x; asm volatile("" : "+v"(tid_));
    const int lane = tid_ & 63, w = __builtin_amdgcn_readfirstlane(tid_ >> 6);
    LAS float* scr = (LAS float*)lds + w * (64 * 65);
    for (int n = 0; n < max_items; ++n) {
        int it = 0; if (lane == 0) it = atomicAdd(qctr, 1);
        it = __builtin_amdgcn_readfirstlane(it);
        if (it >= MOE_ITEMS) break;
        if (it < NE * 256) { const int mi = layer * NE + (it >> 8), ii = it & 255;
            conv_item(w_gate + (size_t)mi * 1024 * 512, w_up + (size_t)mi * 1024 * 512, nullptr, 512, 1024, 1024, 5, 0, (bf16_t*)(ws + WS_WGU) + (size_t)mi * 1024 * 1024, ii, scr, lane); }
        else { const int r = it - NE * 256, mi = layer * NE + (r >> 7), ii = r & 127;
            conv_item(w_down + (size_t)mi * 512 * 1024, nullptr, nullptr, 1024, 512, 1024, 0, 0, (bf16_t*)(ws + WS_WD) + (size_t)mi * 1024 * 512, ii, scr, lane); }
    }
}
struct ProIn {
    const float *c, *c_ctx, *ada_w, *ada_b, *win_w_in, *win_w_out, *mla_w_in, *mla_q_norm, *mla_kv_norm, *mla_w_uq, *mla_w_ukv, *mla_w_out, *dif_w_in, *dif_w_out,
                *moe_w_grp, *moe_w_rt, *moe_w_gate, *moe_w_up, *moe_w_down;
    unsigned char* ws;
};
__device__ __forceinline__ void prologue(LAS unsigned char* lds, const ProIn& I, int G, int cid) {
    const int tid = threadIdx.x, lane = tid & 63, w = __builtin_amdgcn_readfirstlane(tid >> 6);
    unsigned char* ws = I.ws;
    {
        LAS float* scr = (LAS float*)lds + w * (64 * 65);
        const int gw = cid * NWAVES + w, NGW = G * NWAVES;
        constexpr int I_AIN = 16 * 24, I_SQ = 16 * 16, I_BUQ = 8 * 24, I_BUKV = 4 * 32, I_CIN = 16 * 48, I_GU = 16 * 16, I_D = 8 * 16;
        constexpr int NSMALL = 2 * I_AIN + 2 * I_SQ + I_SQ + I_BUQ + I_BUKV + I_SQ + I_CIN + I_SQ;
        constexpr int NITEMS = NSMALL + 128 * I_GU + 128 * I_D;
        for (int it = gw; it < NITEMS; it += NGW) {
            int r = it;
            if (r >= NSMALL) {
                r -= NSMALL;
                if (r < 128 * I_GU) { const int mi = r / I_GU, ii = r % I_GU;
                    conv_item(I.moe_w_gate + (size_t)mi * 1024 * 512, I.moe_w_up + (size_t)mi * 1024 * 512, nullptr, 512, 1024, 1024, 5, 0, (bf16_t*)(ws + WS_WGU) + (size_t)mi * 1024 * 1024, ii, scr, lane); }
                else { r -= 128 * I_GU; const int mi = r / I_D, ii = r % I_D;
                    conv_item(I.moe_w_down + (size_t)mi * 512 * 1024, nullptr, nullptr, 1024, 512, 1024, 0, 0, (bf16_t*)(ws + WS_WD) + (size_t)mi * 1024 * 512, ii, scr, lane); }
                continue;
            }
            if (r < 2 * I_AIN) { const int s = r / I_AIN; conv_item(I.win_w_in + (size_t)s * 1024 * 1536, nullptr, nullptr, 1536, 1024, 1536, 1, 1280, (bf16_t*)(ws + W_A_IN) + (size_t)s * 1536 * 1024, r % I_AIN, scr, lane); continue; } r -= 2 * I_AIN;
            if (r < 2 * I_SQ) { const int s = r / I_SQ; conv_item(I.win_w_out + (size_t)s * 1024 * 1024, nullptr, nullptr, 1024, 1024, 1024, 0, 0, (bf16_t*)(ws + W_A_OUT) + (size_t)s * 1024 * 1024, r % I_SQ, scr, lane); continue; } r -= 2 * I_SQ;
            if (r < I_SQ) { conv_item(I.mla_w_in, nullptr, nullptr, 800, 1024, 1024, 2, 0, (bf16_t*)(ws + W_B_IN), r, scr, lane); continue; } r -= I_SQ;
            if (r < I_BUQ) { conv_item(I.mla_w_uq, nullptr, I.mla_q_norm, 1536, 512, 1536, 3, 0, (bf16_t*)(ws + W_B_UQ), r, scr, lane); continue; } r -= I_BUQ;
            if (r < I_BUKV) { conv_item(I.mla_w_ukv, nullptr, I.mla_kv_norm, 2048, 256, 2048, 4, 0, (bf16_t*)(ws + W_B_UKV), r, scr, lane); continue; } r -= I_BUKV;
            if (r < I_SQ) { conv_item(I.mla_w_out, nullptr, nullptr, 1024, 1024, 1024, 0, 0, (bf16_t*)(ws + W_B_OUT), r, scr, lane); continue; } r -= I_SQ;
            if (r < I_CIN) { conv_item(I.dif_w_in, nullptr, nullptr, 3072, 1024, 3072, 1, 2048, (bf16_t*)(ws + W_C_IN), r, scr, lane); continue; } r -= I_CIN;
            conv_item(I.dif_w_out, nullptr, nullptr, 1024, 1024, 1024, 0, 0, (bf16_t*)(ws + W_C_OUT), r, scr, lane);
        }
    }
    __syncthreads();
    {
        LAS float* sc = (LAS float*)lds;
        LAS float* red = sc + 9 * 1024;
        for (int idx = tid; idx < 9 * 1024; idx += NTHREADS) { const int m = idx >> 10, k = idx & 1023; const float v = m < 8 ? I.c[m * 1024 + k] : I.c_ctx[k]; sc[idx] = v / (1.f + expf(-v)); }
        __syncthreads();
        float* mod = (float*)(ws + WS_MOD);
        for (int task = cid; task < DEPTH * 96; task += G) {
            const int layer = task / 96, j = (task % 96) * 64 + lane;
            float acc[9];
#pragma unroll
            for (int m = 0; m < 9; ++m) acc[m] = 0.f;
            const float* wp = I.ada_w + ((size_t)layer * 1024 + w * 128) * 6144 + j;
#pragma unroll 32
            for (int k = 0; k < 128; ++k) { const float wv = wp[(size_t)k * 6144];
#pragma unroll
                for (int m = 0; m < 9; ++m) acc[m] = fmaf(sc[m * 1024 + w * 128 + k], wv, acc[m]); }
#pragma unroll
            for (int m = 0; m < 9; ++m) red[(w * 9 + m) * 64 + lane] = acc[m];
            __syncthreads();
            for (int o = tid; o < 9 * 64; o += NTHREADS) { const int m = o >> 6, jl = o & 63; float s = 0.f;
#pragma unroll
                for (int ww = 0; ww < 8; ++ww) s += red[(ww * 9 + m) * 64 + jl];
                const int jj = (task % 96) * 64 + jl; mod[((size_t)layer * 9 + m) * 6144 + jj] = s + I.ada_b[layer * 6144 + jj]; }
            __syncthreads();
        }
    }
    {
        const int gt = cid * NTHREADS + tid, NGT = G * NTHREADS;
        float2* tab64 = (float2*)(ws + WS_TAB64); float2* tab32 = (float2*)(ws + WS_TAB32);
        for (int t = gt; t < 64 * 16 + 64 * 8; t += NGT) {
            if (t < 1024) { const int pos = t >> 4, j = t & 15; const float inv = (float)pow(10000.0, -(double)(2 * j) / 32.0), ang = (float)pos * inv;
                tab64[t] = make_float2((float)cos((double)ang), (float)sin((double)ang)); }
            else { const int u = t - 1024, pos = u >> 3, j = u & 7; const float inv = (float)pow(10000.0, -(double)(2 * j) / 16.0), ang = (float)pos * inv;
                tab32[u] = make_float2((float)cos((double)ang), (float)sin((double)ang)); }
        }
        bf16_t* rtw = (bf16_t*)(ws + WS_RTW);
        for (int t = gt; t < DEPTH * 64 * 1024; t += NGT) {
            const int layer = t >> 16, n = (t >> 10) & 63, k = t & 1023;
            float v = 0.f;
            if (n < 4) v = I.moe_w_grp[((size_t)layer * 1024 + k) * 4 + n]; else if (n < 36) v = I.moe_w_rt[((size_t)layer * 1024 + k) * 32 + (n - 4)];
            const unsigned hi = f2bf(v); const unsigned lo = f2bf(v - bf2f(hi));
            rtw[((size_t)layer * 2 + 0) * 65536 + n * 1024 + k] = (bf16_t)hi; rtw[((size_t)layer * 2 + 1) * 65536 + n * 1024 + k] = (bf16_t)lo;
        }
    }
}
__device__ __forceinline__ void phase_h0(const float* x, const float* ctx, const float* mod0, bf16_t* H, int G, int cid) {
    const int lane = threadIdx.x & 63, gw = cid * NWAVES + (threadIdx.x >> 6), NGW = G * NWAVES;
    for (int row0 = gw * 2; row0 < T; row0 += NGW * 2) {
        const float* src = row0 < TL ? x + (size_t)row0 * 1024 : ctx + (size_t)(row0 - TL) * 1024; const float* mp = mod0 + (size_t)mrow_of(row0) * 6144;
        f32x4 v[2][4];
#pragma unroll
        for (int rr = 0; rr < 2; ++rr)
#pragma unroll
            for (int i = 0; i < 4; ++i) v[rr][i] = *(const f32x4*)(src + rr * 1024 + i * 256 + lane * 4);
#pragma unroll
        for (int rr = 0; rr < 2; ++rr)
#pragma unroll
            for (int i = 0; i < 4; ++i) { const int c = i * 256 + lane * 4;
                const f32x4 sh = *(const f32x4*)(mp + c), sc = *(const f32x4*)(mp + 1024 + c);
                const f32x4 h = v[rr][i] * (sc + 1.f) + sh; u32x2 wv; wv.x = cvt_pk_bf16(h[0], h[1]); wv.y = cvt_pk_bf16(h[2], h[3]);
                *(u32x2*)(H + (size_t)(row0 + rr) * 1024 + c) = wv; }
    }
}
constexpr int CNT_STRIDE = 64;
struct LnrArgs { const float* Xl; const float* Xc; const bf16_t* Y; float* STATS; bf16_t* H; const float* modl; const float* gam; const float* bet; const bf16_t* rtw; const float* b_grp; const float* b_rt; int* cnt; int* list; float* tokw; int nrows; };
#define LBAR() do { asm volatile("s_waitcnt lgkmcnt(0)" ::: "memory"); __builtin_amdgcn_s_barrier(); asm volatile("" ::: "memory"); } while (0)
template <int VAR = 0, bool XBF = false>
__device__ __forceinline__ void phase_lnr(LAS unsigned char* lds, const LnrArgs A, int G, int cid) {
    asm volatile("" : "+s"(G), "+s"(cid));
    constexpr int TSTR = 2064;
    int tid_ = threadIdx.x; asm volatile("" : "+v"(tid_));
    const int tid = tid_, lane = tid & 63, w = __builtin_amdgcn_readfirstlane(tid >> 6), r = lane & 31, hh = lane >> 5;
    LAS unsigned char* THI = lds; LAS unsigned char* TLO = lds + 32 * TSTR;
    LAS float* PART = (LAS float*)lds;

    LAS int* bcnt = (LAS int*)(lds + 2 * 32 * TSTR);
    LAS int* bbase = bcnt + 32;
    LAS float* bias = (LAS float*)(bbase + 32);
    LAS int* ents = (LAS int*)(bias + 40);
    LAS float* LOG = (LAS float*)(ents + 16 * 64 * 2);
    const int ngroups = A.nrows >> 5;
    const int nfull = (ngroups / G) * G, rem = ngroups - nfull; const bool halves = rem > 0 && 2 * rem <= G;
    const int nitems = halves ? nfull + 2 * rem : ngroups;
#define LNR_ITEM(j, grp_, h_, nr_) const int grp_ = (j) < nfull || !halves ? (j) : nfull + (((j) - nfull) >> 1); const int h_ = (j) < nfull || !halves ? 0 : (((j) - nfull) & 1); const int nr_ = (j) < nfull || !halves ? 32 : 16
    if (tid < 32) bcnt[tid] = 0;
    if (tid < 36) bias[tid] = tid < 4 ? A.b_grp[tid] : A.b_rt[tid - 4];
    f32x4 z[4][4]; u32x2 zr[4][4]; u32x2 yv[4][4];
#define LNR_LOAD(j_) do { LNR_ITEM(j_, g__, h__, n__); _Pragma("unroll") for (int t4 = 0; t4 < 4; ++t4) { const int tl_ = 4 * w + t4; const int row_ = g__ * 32 + h__ * 16 + (tl_ < n__ ? tl_ : tl_ - 16); \
        const float* xs_ = row_ < TL ? A.Xl + (size_t)row_ * 1024 : A.Xc + (size_t)(row_ - TL) * 1024; \
        const bf16_t* xb_ = row_ < TL ? (const bf16_t*)A.Xl + (size_t)row_ * 1024 : (const bf16_t*)A.Xc + (size_t)(row_ - TL) * 1024; \
        _Pragma("unroll") for (int i = 0; i < 4; ++i) { if (XBF) zr[t4][i] = *(const u32x2*)(xb_ + i * 256 + lane * 4); else z[t4][i] = *(const f32x4*)(xs_ + i * 256 + lane * 4); \
            yv[t4][i] = *(const u32x2*)(A.Y + (size_t)row_ * 1024 + i * 256 + lane * 4); } } } while (0)
    if (cid < nitems) LNR_LOAD(cid);
    int gi = 0;
    for (int item = cid; item < nitems; item += G, ++gi) {
        LNR_ITEM(item, grp, hsel, nrow);
#pragma unroll
        for (int t4 = 0; t4 < 4; ++t4) {
            const int tl = 4 * w + t4, row = grp * 32 + hsel * 16 + (tl < nrow ? tl : tl - 16); const bool rvalid = tl < nrow; const float* mp = A.modl + (size_t)mrow_of(row) * 6144;
            float s = 0.f, q = 0.f;
            if (XBF) {
#pragma unroll
                for (int i = 0; i < 4; ++i) { const u32x2 xr = zr[t4][i]; z[t4][i][0] = f16lo(xr.x); z[t4][i][1] = f16hi(xr.x); z[t4][i][2] = f16lo(xr.y); z[t4][i][3] = f16hi(xr.y); }
            }
#pragma unroll
            for (int i = 0; i < 4; ++i) { const int c = i * 256 + lane * 4; const f32x4 gv = *(const f32x4*)(mp + 2 * 1024 + c); const u32x2 yb = yv[t4][i];
                f32x4 y; y[0] = bf2f(yb.x & 0xffffu); y[1] = bf2f(yb.x >> 16); y[2] = bf2f(yb.y & 0xffffu); y[3] = bf2f(yb.y >> 16);
                const f32x4 v = z[t4][i] * DN_ALPHA + gv * y; z[t4][i] = v; s += (v[0] + v[1]) + (v[2] + v[3]); q += (v[0] * v[0] + v[1] * v[1]) + (v[2] * v[2] + v[3] * v[3]); }
            wave_sum2(s, q);
            const float mean = s * (1.f / 1024.f); const float var = fmaxf(q * (1.f / 1024.f) - mean * mean, 0.f);
            const float rstd = 1.0f / sqrtf(var + LN_EPS);
            if (lane == 0 && rvalid) *(f32x2*)(A.STATS + (size_t)row * 2) = (f32x2){mean, rstd};
#pragma unroll
            for (int i = 0; i < 4; ++i) { const int c = i * 256 + lane * 4;
                const f32x4 xo = (z[t4][i] - mean) * rstd * *(const f32x4*)(A.gam + c) + *(const f32x4*)(A.bet + c);
                const f32x4 h = xo * (*(const f32x4*)(mp + 4 * 1024 + c) + 1.f) + *(const f32x4*)(mp + 3 * 1024 + c);
                u32x2 hi; hi.x = cvt_pk_bf16(h[0], h[1]); hi.y = cvt_pk_bf16(h[2], h[3]);
                if (rvalid) *(u32x2*)(A.H + (size_t)row * 1024 + c) = hi;
                f32x4 rem; rem[0] = h[0] - bf2f(hi.x & 0xffffu); rem[1] = h[1] - bf2f(hi.x >> 16); rem[2] = h[2] - bf2f(hi.y & 0xffffu); rem[3] = h[3] - bf2f(hi.y >> 16);
                u32x2 lo; lo.x = cvt_pk_bf16(rem[0], rem[1]); lo.y = cvt_pk_bf16(rem[2], rem[3]);
                *(LAS u32x2*)(THI + tl * TSTR + c * 2) = hi; *(LAS u32x2*)(TLO + tl * TSTR + c * 2) = lo; }
        }
        LBAR();
        if (VAR == 1) { if (item + G < nitems) LNR_LOAD(item + G); continue; }
        f32x16 acc, acc2, acc3;
#pragma unroll
        for (int i = 0; i < 16; ++i) { acc[i] = 0.f; acc2[i] = 0.f; acc3[i] = 0.f; }
        { const int ct = w & 1, ks = w >> 1; const bf16_t* bh = A.rtw + (size_t)(ct * 32 + r) * 1024 + ks * 256 + 8 * hh; const bf16_t* bl = bh + 65536;
          bf16x8 wh[16], wl[16];
#pragma unroll
          for (int st = 0; st < 16; ++st) { wh[st] = *(const bf16x8*)(bh + 16 * st); wl[st] = *(const bf16x8*)(bl + 16 * st); }
#pragma unroll
          for (int st = 0; st < 16; ++st) {
              const bf16x8 ah = *(const LAS bf16x8*)(THI + r * TSTR + (ks * 256 + 16 * st + 8 * hh) * 2), al = *(const LAS bf16x8*)(TLO + r * TSTR + (ks * 256 + 16 * st + 8 * hh) * 2);
              acc = MFMA32(ah, wh[st], acc); acc2 = MFMA32(ah, wl[st], acc2); acc3 = MFMA32(al, wh[st], acc3);
          }
          acc = acc + acc2 + acc3; }
        if (item + G < nitems) LNR_LOAD(item + G);
        LBAR();
#pragma unroll
        for (int i = 0; i < 16; ++i) PART[(w * 32 + (i & 3) + 8 * (i >> 2) + 4 * hh) * 33 + r] = acc[i];
        LBAR();
        for (int o = tid; o < 32 * 36; o += NTHREADS) { const int tk = o / 36, n = o % 36, ct = n >> 5, nl = n & 31;
            float s = 0.f;
#pragma unroll
            for (int ks = 0; ks < 4; ++ks) s += PART[((ks * 2 + ct) * 32 + tk) * 33 + nl];
            LOG[tk * 40 + n] = s + bias[n]; }
        LBAR();
        if (VAR != 2 && tid < nrow) {
            const LAS float* lg = LOG + tid * 40; const int row = grp * 32 + hsel * 16 + tid;
            const float g0 = lg[0], g1 = lg[1], g2 = lg[2], g3 = lg[3];
            int gs = 0; float gm = g0;
            if (g1 > gm) { gm = g1; gs = 1; } if (g2 > gm) { gm = g2; gs = 2; } if (g3 > gm) { gm = g3; gs = 3; }
            const float pg = 1.f / (expf(g0 - gm) + expf(g1 - gm) + expf(g2 - gm) + expf(g3 - gm));
            int i1 = 0; float v1 = lg[4 + gs * 8];
            for (int j = 1; j < 8; ++j) { const float v = lg[4 + gs * 8 + j]; if (v > v1) { v1 = v; i1 = j; } }
            int i2 = -1; float v2 = -INFINITY;
            for (int j = 0; j < 8; ++j) { const float v = lg[4 + gs * 8 + j]; if (j != i1 && v > v2) { v2 = v; i2 = j; } }
            const int ea = gs * 8 + i1, eb = gs * 8 + i2;
            const int ra = __hip_atomic_fetch_add(bcnt + ea, 1, __ATOMIC_RELAXED, __HIP_MEMORY_SCOPE_WORKGROUP), rb = __hip_atomic_fetch_add(bcnt + eb, 1, __ATOMIC_RELAXED, __HIP_MEMORY_SCOPE_WORKGROUP);
            const float e2 = expf(v2 - v1), w1 = pg / (1.f + e2), w2 = pg * e2 / (1.f + e2);
            *(f32x2*)(A.tokw + (size_t)row * 2) = (f32x2){w1, w2};
            LAS int* ep = ents + (gi * 64 + tid * 2) * 2;
            ep[0] = (ea << 16) | ra; ep[1] = row * 2; ep[2] = (eb << 16) | rb; ep[3] = row * 2 + 1;
        } else if (VAR != 2 && tid < 32) {
            LAS int* ep = ents + (gi * 64 + tid * 2) * 2; ep[0] = -1; ep[2] = -1;
        }
    }
#undef LNR_LOAD
#undef LNR_ITEM
    if (tid < 32) { const int n = bcnt[tid]; bbase[tid] = n ? atomicAdd(&A.cnt[tid * CNT_STRIDE], n) : 0; }
    __syncthreads();
    if (VAR == 0) for (int i = tid; i < gi * 64; i += NTHREADS) { const int key = ents[2 * i], val = ents[2 * i + 1], e = key >> 16; if (key >= 0) A.list[(size_t)e * T + bbase[e] + (key & 0xffff)] = val; }
    __syncthreads();
}
struct LnfArgs { const float* Xl; const float* Xc; const bf16_t* Y; const float* STATS; const bf16_t* Y2; const float* modl; const float* gam1; const float* bet1; const float* gam; const float* bet; float* Xout; bf16_t* H; const float* modn; int nrows; };
template <bool XINBF = false, bool XOUTBF = false>
__device__ __forceinline__ void phase_lnf(const LnfArgs A, int G, int cid) {
    asm volatile("" : "+s"(G), "+s"(cid));
    int tid_ = threadIdx.x; asm volatile("" : "+v"(tid_));
    const int lane = tid_ & 63, gw = cid * NWAVES + (tid_ >> 6), NGW = G * NWAVES;
    for (int row0 = gw * 2; row0 < A.nrows; row0 += NGW * 2) {
        const int mr = mrow_of(row0); const float* gm = A.modl + (size_t)mr * 6144 + 2 * 1024; const float* gf = A.modl + (size_t)mr * 6144 + 5 * 1024;
        const float* xs = row0 < TL ? A.Xl + (size_t)row0 * 1024 : A.Xc + (size_t)(row0 - TL) * 1024;
        const bf16_t* xb = row0 < TL ? (const bf16_t*)A.Xl + (size_t)row0 * 1024 : (const bf16_t*)A.Xc + (size_t)(row0 - TL) * 1024;
        f32x4 z[2][4]; u32x2 zr[2][4]; u32x2 yv[2][4], ya[2][4], yb[2][4]; f32x2 st[2];
#pragma unroll
        for (int rr = 0; rr < 2; ++rr) {
            st[rr] = *(const f32x2*)(A.STATS + (size_t)(row0 + rr) * 2);
#pragma unroll
            for (int i = 0; i < 4; ++i) { const int c = i * 256 + lane * 4; const size_t row = (size_t)(row0 + rr);
                if (XINBF) zr[rr][i] = *(const u32x2*)(xb + rr * 1024 + c); else z[rr][i] = *(const f32x4*)(xs + rr * 1024 + c);
                yv[rr][i] = *(const u32x2*)(A.Y + row * 1024 + c);
                ya[rr][i] = *(const u32x2*)(A.Y2 + row * 2048 + c); yb[rr][i] = *(const u32x2*)(A.Y2 + row * 2048 + 1024 + c); }
        }
#pragma unroll
        for (int rr = 0; rr < 2; ++rr) {
            const size_t row = (size_t)(row0 + rr);
            float s = 0.f, q = 0.f;
#pragma unroll
            for (int i = 0; i < 4; ++i) { const int c = i * 256 + lane * 4;
                const f32x4 g1 = *(const f32x4*)(gm + c), g2 = *(const f32x4*)(gf + c); const u32x2 y1 = yv[rr][i], a = ya[rr][i], b = yb[rr][i];
                if (XINBF) { const u32x2 xr = zr[rr][i]; z[rr][i][0] = f16lo(xr.x); z[rr][i][1] = f16hi(xr.x); z[rr][i][2] = f16lo(xr.y); z[rr][i][3] = f16hi(xr.y); }
                f32x4 ym; ym[0] = bf2f(y1.x & 0xffffu); ym[1] = bf2f(y1.x >> 16); ym[2] = bf2f(y1.y & 0xffffu); ym[3] = bf2f(y1.y >> 16);
                const f32x4 x1 = ((z[rr][i] * DN_ALPHA + g1 * ym) - st[rr][0]) * st[rr][1] * *(const f32x4*)(A.gam1 + c) + *(const f32x4*)(A.bet1 + c);
                f32x4 y; y[0] = bf2f(a.x & 0xffffu) + bf2f(b.x & 0xffffu); y[1] = bf2f(a.x >> 16) + bf2f(b.x >> 16); y[2] = bf2f(a.y & 0xffffu) + bf2f(b.y & 0xffffu); y[3] = bf2f(a.y >> 16) + bf2f(b.y >> 16);
                const f32x4 v = x1 * DN_ALPHA + g2 * y; z[rr][i] = v; s += (v[0] + v[1]) + (v[2] + v[3]); q += (v[0] * v[0] + v[1] * v[1]) + (v[2] * v[2] + v[3] * v[3]); }
            wave_sum2(s, q);
            const float mean = s * (1.f / 1024.f); const float var = fmaxf(q * (1.f / 1024.f) - mean * mean, 0.f);
            const float rstd = 1.0f / sqrtf(var + LN_EPS);
#pragma unroll
            for (int i = 0; i < 4; ++i) { const int c = i * 256 + lane * 4;
                const f32x4 xo = (z[rr][i] - mean) * rstd * *(const f32x4*)(A.gam + c) + *(const f32x4*)(A.bet + c);
                if (XOUTBF) { u32x2 xw; xw.x = pack_f16(xo[0], xo[1]); xw.y = pack_f16(xo[2], xo[3]); *(u32x2*)((bf16_t*)A.Xout + row * 1024 + c) = xw; }
                else *(f32x4*)(A.Xout + row * 1024 + c) = xo;
                if (A.H) { const float* mp = A.modn + (size_t)mr * 6144; const f32x4 h = xo * (*(const f32x4*)(mp + 1024 + c) + 1.f) + *(const f32x4*)(mp + c);
                    u32x2 wv; wv.x = cvt_pk_bf16(h[0], h[1]); wv.y = cvt_pk_bf16(h[2], h[3]); *(u32x2*)(A.H + row * 1024 + c) = wv; } }
        }
    }
}
}
#ifndef PH_MASK
#define PH_MASK 0xFFFF
#endif
#define PH_EN(k) ((PH_MASK >> (k)) & 1)
#ifndef PH_REPM
#define PH_REPM 0
#endif
#define NREP(k) (((PH_REPM >> (k)) & 1) ? 2 : 1)
#ifndef ATT_PIPE_A
#define ATT_PIPE_A false
#endif
#ifndef ATT_PIPE_B
#define ATT_PIPE_B false
#endif
#ifndef ATT_PIPE_C
#define ATT_PIPE_C false
#endif
#ifndef ONE_LAUNCH
#define ONE_LAUNCH 1
#endif
constexpr int NPH = 2 + 8 * DEPTH;
struct Params { const float* in[30]; float* out; unsigned char* ws; int ph_lo, ph_hi; };

__global__ void __launch_bounds__(NTHREADS, 2) k_run(Params p) {
    extern __shared__ __attribute__((aligned(16))) unsigned char lds_raw[];
    LAS unsigned char* lds = (LAS unsigned char*)lds_raw;
    volatile LAS unsigned* MISC = (volatile LAS unsigned*)(lds + MISC_OFF);
    const int G = gridDim.x;
    const int cid = (G % 8 == 0) ? ((int)blockIdx.x % 8) * (G / 8) + (int)blockIdx.x / 8 : (int)blockIdx.x;
    typedef const __attribute__((address_space(4))) Params* KP;
    KP pp = (KP)__builtin_amdgcn_kernarg_segment_ptr();
    unsigned char* ws = p.ws;
    for (int u = threadIdx.x; u < 256; u += NTHREADS) MISC[u] = 0u;
    __syncthreads();
    const int lo = p.ph_lo, hi = p.ph_hi;
    XcdBarrier bar; bar.bar = (unsigned*)(ws + WS_CTL) + CW_BAR; bar.x = 0; bar.st = nullptr;
    if (hi - lo > 1) bar = xcd_barrier_post((unsigned*)(ws + WS_CTL) + CW_BAR, MISC + 8);
#define IN(k) (lo <= (k) && (k) < hi)
#define SEAM(k) do { if (IN(k) && IN((k) + 1)) { xcd_barrier(bar); if (NREP(15) == 2) xcd_barrier(bar); } } while (0)

    if (PH_EN(0) && IN(0)) {
        thin::ProIn I; I.c = p.in[1]; I.c_ctx = p.in[3]; I.ada_w = p.in[4]; I.ada_b = p.in[5]; I.win_w_in = p.in[10]; I.win_w_out = p.in[11];
        I.mla_w_in = p.in[13]; I.mla_q_norm = p.in[14]; I.mla_kv_norm = p.in[15]; I.mla_w_uq = p.in[16]; I.mla_w_ukv = p.in[17]; I.mla_w_out = p.in[18];
        I.dif_w_in = p.in[19]; I.dif_w_out = p.in[22]; I.moe_w_grp = p.in[23]; I.moe_w_rt = p.in[25]; I.moe_w_gate = p.in[27]; I.moe_w_up = p.in[28]; I.moe_w_down = p.in[29]; I.ws = ws;
        for (int rep = 0; rep < NREP(0); ++rep) { thin::prologue(lds, I, G, cid); __syncthreads(); }
    }
    SEAM(0);
    if (PH_EN(1) && IN(1)) for (int rep = 0; rep < NREP(1); ++rep) thin::phase_h0(p.in[0], p.in[2], (const float*)(ws + WS_MOD), (bf16_t*)(ws + WS_H), G, cid);
    SEAM(1);

#pragma unroll 1
    for (int li = 0; li < DEPTH; ++li) {
        asm volatile("" : "+s"(pp));
        { size_t zoff = 0; asm volatile("" : "+s"(zoff)); ws = pp->ws + zoff; }
        const int base = 2 + 8 * li, kind = li % 3, slot = li / 3; const bool last = li == DEPTH - 1;
        float* mod = (float*)(ws + WS_MOD);
        const float* tab64 = (const float*)(ws + WS_TAB64); const float* tab32 = (const float*)(ws + WS_TAB32);
        float* X = (float*)(ws + WS_X); bf16_t* H = (bf16_t*)(ws + WS_H); bf16_t* O = (bf16_t*)(ws + WS_O);
        unsigned char* R1 = ws + WS_R1;
        int* list = (int*)(ws + WS_LIST); float* tokw = (float*)(ws + WS_TOKW); float* SSQ = (float*)(ws + WS_SSQ);
        const float* modl = mod + (size_t)li * 9 * 6144;
        const int Mpost = last ? TL : T;
        int* cnt = (int*)(ws + WS_CTL) + CW_CNT + li * NE * 64;
#define IDLE_FILL(nunits, myid, budget) do { if (li + 1 < DEPTH) { const int nu_ = (nunits), R_ = (nu_ + G - 1) / G - 1; if (R_ * G + (myid) >= nu_) { \
            thin::moe_fill(lds, pp->in[27], pp->in[28], pp->in[29], ws, li + 1, (budget), (int*)(ws + WS_CTL) + CW_Q + 64 * (li + 1)); __syncthreads(); } } } while (0)
        if (IN(base + 0)) {
            if (PH_EN(2) && kind == 0) {
                pg8::Gemm g{H, (const bf16_t*)(ws + W_A_IN) + (size_t)slot * 1536 * 1024, 1024}; pg8::StaticOrder So; So.init(T, 1536, G, (int)blockIdx.x);
                epi::EpiQKV E{(bf16_t*)(R1 + R_QA), 1024, (bf16_t*)(R1 + R_KA), 256, (bf16_t*)(R1 + R_VTA), 4, 64, 4, 1, 0.125f * LOG2E, tab64};
                for (int rep = 0; rep < NREP(2); ++rep) pg8::gemm_phase<epi::EpiQKV, pg8::StaticOrder, true>(lds, g, So, E);
            } else if (PH_EN(3) && kind == 1) {
                pg8::Gemm g{H, (const bf16_t*)(ws + W_B_IN), 1024}; pg8::StaticOrder So; So.init(T, 1024, G, (int)blockIdx.x);
                epi::EpiB1 E{(bf16_t*)(R1 + R_CQ), (bf16_t*)(R1 + R_CKV), (bf16_t*)(R1 + R_KR), SSQ, tab32};
                for (int rep = 0; rep < NREP(3); ++rep) pg8::gemm_phase<epi::EpiB1, pg8::StaticOrder, true>(lds, g, So, E);
            } else if (PH_EN(4) && kind == 2) {
                pg8::Gemm g{H, (const bf16_t*)(ws + W_C_IN), 1024}; pg8::StaticOrder So; So.init(T, 3072, G, (int)blockIdx.x);
                epi::EpiQKV E{(bf16_t*)(R1 + R_QC), 1024, (bf16_t*)(R1 + R_KC), 1024, (bf16_t*)(R1 + R_VTC), 8, 128, 4, 4, 0.125f * LOG2E, tab64};
                for (int rep = 0; rep < NREP(4); ++rep) pg8::gemm_phase<epi::EpiQKV, pg8::StaticOrder, true>(lds, g, So, E);
            }
        }
        SEAM(base + 0);
        if (PH_EN(5) && IN(base + 1) && kind == 1) {
            { pg8::Gemm g{(const bf16_t*)(R1 + R_CQ), (const bf16_t*)(ws + W_B_UQ), 512}; pg8::StaticOrder So; So.init(T, 1536, G, (int)blockIdx.x);
              epi::EpiB2 E{(bf16_t*)(R1 + R_QB), SSQ, tab32, 0.10206207261596575f * LOG2E};
              for (int rep = 0; rep < NREP(5); ++rep) pg8::gemm_phase<epi::EpiB2, pg8::StaticOrder, true>(lds, g, So, E); }
            { pg8::Gemm g{(const bf16_t*)(R1 + R_CKV), (const bf16_t*)(ws + W_B_UKV), 256}; pg8::StaticOrder So; So.init(T, 2048, G, (int)blockIdx.x);
              epi::EpiB3 E{(bf16_t*)(R1 + R_KN), (bf16_t*)(R1 + R_VTB), SSQ};
              for (int rep = 0; rep < NREP(5); ++rep) pg8::gemm_phase<epi::EpiB3, pg8::StaticOrder, true>(lds, g, So, E); }
        }
        if (kind == 1) SEAM(base + 1);
#ifdef CLK_PROBE
        if (li == 1 && IN(base + 2)) {
            f32x16 c0; bf16x8 fa, fb;
#pragma unroll
            for (int i = 0; i < 16; ++i) c0[i] = 0.f;
#pragma unroll
            for (int i = 0; i < 8; ++i) { fa[i] = (short)(0x3c00 + tid + i); fb[i] = (short)(0x3d00 + i); }
#pragma unroll 1
            for (int it = 0; it < 16384 / 8; ++it) {
#pragma unroll
                for (int u = 0; u < 8; ++u) c0 = MFMA32(fa, fb, c0);
            }
            float sres = 0.f;
#pragma unroll
            for (int i = 0; i < 16; ++i) sres += c0[i];
            ((float*)pp->out)[blockIdx.x * NTHREADS + tid] = sres;
        }
#endif
        if (IN(base + 2)) {
            attn::Tensors At; At.O = O; At.sink = nullptr; At.lamp = nullptr; At.subln = nullptr; At.lambda_init = 0.f; At.K2 = nullptr;
            if (PH_EN(6) && kind == 0) { At.Q = (const bf16_t*)(R1 + R_QA); At.K1 = (const bf16_t*)(R1 + R_KA); At.VT = (const bf16_t*)(R1 + R_VTA); At.sink = pp->in[12] + slot * 16;
                for (int rep = 0; rep < NREP(6); ++rep) attn::phase<0, ATT_PIPE_A>(lds, At, G, cid, !last); }
            else if (PH_EN(7) && kind == 1) { At.Q = (const bf16_t*)(R1 + R_QB); At.K1 = (const bf16_t*)(R1 + R_KN); At.K2 = (const bf16_t*)(R1 + R_KR); At.VT = (const bf16_t*)(R1 + R_VTB);
#ifdef ATT_PROBE
                { attn::Tensors At2 = At; At2.O = (bf16_t*)pp->out; attn::phase<1, ATT_PIPE_B, ATT_PROBE>(lds, At2, G, cid, !last); }
#endif
                for (int rep = 0; rep < NREP(7); ++rep) attn::phase<1, ATT_PIPE_B>(lds, At, G, cid, !last); }
            else if (PH_EN(8) && kind == 2) { At.Q = (const bf16_t*)(R1 + R_QC); At.K1 = (const bf16_t*)(R1 + R_KC); At.VT = (const bf16_t*)(R1 + R_VTC); At.lamp = pp->in[20] + slot * 256; At.subln = pp->in[21] + slot * 128;
                At.lambda_init = 0.8f - 0.6f * expf(-0.3f * (float)li);
                for (int rep = 0; rep < NREP(8); ++rep) attn::phase<2, ATT_PIPE_C>(lds, At, G, cid, !last); }
        }
        SEAM(base + 2);
        if (PH_EN(9) && IN(base + 3)) {
            const bf16_t* Wt = kind == 0 ? (const bf16_t*)(ws + W_A_OUT) + (size_t)slot * 1024 * 1024 : (kind == 1 ? (const bf16_t*)(ws + W_B_OUT) : (const bf16_t*)(ws + W_C_OUT));
            pg8::Gemm g{O, Wt, 1024}; pg8::StaticOrder So; So.init(Mpost, 1024, G, (int)blockIdx.x);
            epi::EpiOut E{(bf16_t*)(R1 + R_Y)};
            if (NREP(9) == 2) pg8::gemm_phase<epi::EpiOut, pg8::StaticOrder, true>(lds, g, So, E);
            pg8::gemm_phase<epi::EpiOut, pg8::StaticOrder, true>(lds, g, So, E);
        }
        SEAM(base + 3);
        if (PH_EN(10) && IN(base + 4)) {
            const float* Xl = li == 0 ? pp->in[0] : X; const float* Xc = li == 0 ? pp->in[2] : (const float*)((const bf16_t*)X + (size_t)TL * 1024);
            thin::LnrArgs A{Xl, Xc, (const bf16_t*)(R1 + R_Y), (float*)(ws + WS_STATS), H, modl, pp->in[6] + li * 1024, pp->in[7] + li * 1024, (const bf16_t*)(ws + WS_RTW) + (size_t)li * 2 * 65536, pp->in[24] + li * 4, pp->in[26] + li * 32, cnt, list, tokw, Mpost};
            if (NREP(10) == 2) { thin::LnrArgs A2 = A; A2.STATS = (float*)R1; A2.H = (bf16_t*)(R1 + (size_t)T * 4096); A2.cnt = (int*)(ws + WS_CTL) + CW_CNT + 4 * NE * 64; A2.list = (int*)(R1 + (size_t)T * 6144); A2.tokw = (float*)(R1 + (size_t)T * 6144 + (size_t)NE * T * 4);
#ifdef LNR_PROBE
            thin::phase_lnr<LNR_PROBE>(lds, A2, G, cid);
#else
            thin::phase_lnr(lds, A2, G, cid);
#endif
            }
            if (li == 0) thin::phase_lnr<0, false>(lds, A, G, cid); else thin::phase_lnr<0, true>(lds, A, G, cid);
        }
        SEAM(base + 4);
        if (IN(base + 5) || IN(base + 6)) {
            if (threadIdx.x == 0) { int a = 0; for (int e = 0; e < NE; ++e) { MISC[16 + e] = (unsigned)a; a += (cnt[e * 64] + 255) >> 8; } MISC[16 + NE] = (unsigned)a; }
            __syncthreads();
        }
        if (PH_EN(11) && IN(base + 5)) {
            pg8::Gemm g{H, (const bf16_t*)(ws + WS_WGU) + (size_t)li * NE * 1024 * 1024, 1024};
            MoeOrder<true> So{(const LAS int*)(lds + MISC_OFF + 64), cnt, list, G, cid};
            epi::EpiGU E{(bf16_t*)(R1 + R_ACT)};
            for (int rep = 0; rep < NREP(11); ++rep) pg8::gemm_phase<epi::EpiGU, MoeOrder<true>, true>(lds, g, So, E);
        }
        SEAM(base + 5);
        if (PH_EN(12) && IN(base + 6)) {
            pg8::Gemm g{(const bf16_t*)(R1 + R_ACT), (const bf16_t*)(ws + WS_WD) + (size_t)li * NE * 1024 * 512, 512};
            MoeOrder<false> So{(const LAS int*)(lds + MISC_OFF + 64), cnt, list, G, cid};
            epi::EpiDown E{(bf16_t*)(R1 + R_Y2), list, cnt, tokw};
            for (int rep = 0; rep < NREP(12); ++rep) pg8::gemm_phase<epi::EpiDown, MoeOrder<false>, true>(lds, g, So, E);
        }
        SEAM(base + 6);
        if (PH_EN(13) && IN(base + 7)) {
            const float* Xl = li == 0 ? pp->in[0] : X; const float* Xc = li == 0 ? pp->in[2] : (const float*)((const bf16_t*)X + (size_t)TL * 1024);
            thin::LnfArgs A{Xl, Xc, (const bf16_t*)(R1 + R_Y), (const float*)(ws + WS_STATS), (const bf16_t*)(R1 + R_Y2), modl, pp->in[6] + li * 1024, pp->in[7] + li * 1024, pp->in[8] + li * 1024, pp->in[9] + li * 1024, last ? pp->out : X, last ? nullptr : H, last ? nullptr : mod + (size_t)(li + 1) * 9 * 6144, Mpost};
            if (NREP(13) == 2 && !last) { thin::LnfArgs A2 = A; A2.Xout = pp->out; A2.H = O; A2.nrows = TL; thin::phase_lnf(A2, G, cid); }
            if (li == 0) thin::phase_lnf<false, true>(A, G, cid); else if (!last) thin::phase_lnf<true, true>(A, G, cid); else thin::phase_lnf<true, false>(A, G, cid);
        }
        if (!last) SEAM(base + 7);
    }
#undef IN
#undef SEAM
}

extern "C" void kernel_launch(void* const* d_in, const int* in_sizes, int n_in, void* d_out, int out_size, void* d_ws, size_t ws_size, hipStream_t stream) {
    static int grid = 0;
    if (grid == 0) {
        if (n_in != 30 || ws_size < WS_END) { grid = -1; return; }
        int dev = 0, cus = 0;
        if (hipGetDevice(&dev) != hipSuccess || hipDeviceGetAttribute(&cus, hipDeviceAttributeMultiprocessorCount, dev) != hipSuccess) { grid = -1; return; }
        if (hipFuncSetAttribute((const void*)k_run, hipFuncAttributeMaxDynamicSharedMemorySize, LDS_BYTES) != hipSuccess) { grid = -1; return; }
        int per_cu = 0;
        if (hipOccupancyMaxActiveBlocksPerMultiprocessor(&per_cu, (const void*)k_run, NTHREADS, LDS_BYTES) != hipSuccess || per_cu < 1) { (void)hipGetLastError(); grid = -1; return; }
        grid = cus;
    }
    if (grid < 0) return;
    (void)hipMemsetAsync((char*)d_ws + WS_CTL, 0, CTL_ZERO_BYTES, stream);
    Params p{};
    for (int i = 0; i < 30; ++i) p.in[i] = (const float*)d_in[i];
    p.out = (float*)d_out; p.ws = (unsigned char*)d_ws;
#if ONE_LAUNCH
    p.ph_lo = 0; p.ph_hi = NPH;
    k_run<<<dim3(grid), dim3(NTHREADS), LDS_BYTES, stream>>>(p);
#else
    for (int ph = 0; ph < NPH; ++ph) {
        if (ph >= 2 && ((ph - 2) % 8) == 1 && (((ph - 2) / 8) % 3) != 1) continue;
        p.ph_lo = ph; p.ph_hi = ph + 1;
        k_run<<<dim3(grid), dim3(NTHREADS), LDS_BYTES, stream>>>(p);
    }
#endif
}
```

```cpp
#include <hip/hip_runtime.h>
#include <stdint.h>
#include <math.h>

constexpr int D = 1024, NB = 8, S = 4096, L = 256, DEPTH = 4;
constexpr int TL = NB * S, TC = NB * L, T = TL + TC;
constexpr int NKEY = S + L;
constexpr int NE = 32, DE = 512;
constexpr float LN_EPS = 1e-5f, RMS_EPS = 1e-6f;
constexpr float DN_ALPHA = 1.6817928305074290861f;
constexpr float LOG2E = 1.4426950408889634f;
constexpr int NWAVES = 8, NTHREADS = 512;

#define LAS __attribute__((address_space(3)))
typedef unsigned short bf16_t;
typedef short bf16x8 __attribute__((ext_vector_type(8)));
typedef float f32x4 __attribute__((ext_vector_type(4)));
typedef float f32x2 __attribute__((ext_vector_type(2)));
typedef float f32x16 __attribute__((ext_vector_type(16)));
typedef unsigned u32x4 __attribute__((ext_vector_type(4)));
typedef unsigned u32x2 __attribute__((ext_vector_type(2)));

__device__ __forceinline__ unsigned cvt_pk_bf16(float lo, float hi) { unsigned r; asm volatile("v_cvt_pk_bf16_f32 %0, %1, %2" : "=v"(r) : "v"(lo), "v"(hi)); return r; }
__device__ __forceinline__ unsigned f2bf(float f) { unsigned u = __builtin_bit_cast(unsigned, f); return (u + 0x7fffu + ((u >> 16) & 1u)) >> 16; }
__device__ __forceinline__ float bf2f(unsigned h) { return __builtin_bit_cast(float, h << 16); }
__device__ __forceinline__ int mrow_of(int r) { return r < TL ? (r >> 12) : NB; }
__device__ __forceinline__ float dpp_add(float v, unsigned x, const int ctrl_unused) { return v; }
#define DPP_ADD_STEP(v, CTRL) v += __uint_as_float(__builtin_amdgcn_update_dpp(0u, __float_as_uint(v), CTRL, 0xF, 0xF, true))
__device__ __forceinline__ float xor16_sum(float v) { const unsigned x = __float_as_uint(v); auto r = __builtin_amdgcn_permlane16_swap(x, x, false, false); return __uint_as_float(r[0]) + __uint_as_float(r[1]); }
__device__ __forceinline__ float xor32_sum(float v) { const unsigned x = __float_as_uint(v); auto r = __builtin_amdgcn_permlane32_swap(x, x, false, false); return __uint_as_float(r[0]) + __uint_as_float(r[1]); }
typedef _Float16 f16x2 __attribute__((ext_vector_type(2)));
__device__ __forceinline__ unsigned pack_f16(float a, float b) { a = __builtin_fminf(__builtin_fmaxf(a, -65504.f), 65504.f); b = __builtin_fminf(__builtin_fmaxf(b, -65504.f), 65504.f);
    f16x2 h; h.x = (_Float16)a; h.y = (_Float16)b; return __builtin_bit_cast(unsigned, h); }
__device__ __forceinline__ float f16lo(unsigned u) { return (float)__builtin_bit_cast(f16x2, u).x; }
__device__ __forceinline__ float f16hi(unsigned u) { return (float)__builtin_bit_cast(f16x2, u).y; }
__device__ __forceinline__ float xor32_max(float v) { const unsigned x = __float_as_uint(v); auto r = __builtin_amdgcn_permlane32_swap(x, x, false, false); return fmaxf(__uint_as_float(r[0]), __uint_as_float(r[1])); }
__device__ __forceinline__ float wave_sum(float v) {
    DPP_ADD_STEP(v, 0xB1); DPP_ADD_STEP(v, 0x4E); DPP_ADD_STEP(v, 0x141); DPP_ADD_STEP(v, 0x140);
    return xor32_sum(xor16_sum(v));
}
__device__ __forceinline__ void wave_sum2(float& a, float& b) {
    DPP_ADD_STEP(a, 0xB1); DPP_ADD_STEP(b, 0xB1); DPP_ADD_STEP(a, 0x4E); DPP_ADD_STEP(b, 0x4E); DPP_ADD_STEP(a, 0x141); DPP_ADD_STEP(b, 0x141); DPP_ADD_STEP(a, 0x140); DPP_ADD_STEP(b, 0x140);
    a = xor16_sum(a); b = xor16_sum(b); a = xor32_sum(a); b = xor32_sum(b);
}

constexpr size_t MiB = 1u << 20;
constexpr size_t WS_CTL = 0, CTL_ZERO_BYTES = 128 * 1024;
constexpr int CW_Q = 512;
constexpr int CW_BAR = 1024;
constexpr int CW_CNT = 8192;
constexpr size_t WS_MOD = 1 * MiB;
constexpr size_t WS_TAB64 = 2 * MiB, WS_TAB32 = WS_TAB64 + 8192;
constexpr size_t WS_RTW = 3 * MiB;
constexpr size_t WS_TOKW = 4 * MiB;
constexpr size_t WS_SSQ = 5 * MiB;
constexpr size_t WS_STATS = 7 * MiB;
constexpr size_t WS_LIST = 8 * MiB;
constexpr size_t WS_WSMALL = 16 * MiB;
constexpr size_t W_A_IN = WS_WSMALL;
constexpr size_t W_A_OUT = W_A_IN + 2ull * 1536 * 1024 * 2;
constexpr size_t W_B_IN = W_A_OUT + 2ull * 1024 * 1024 * 2;
constexpr size_t W_B_UQ = W_B_IN + 1024ull * 1024 * 2;
constexpr size_t W_B_UKV = W_B_UQ + 1536ull * 512 * 2;
constexpr size_t W_B_OUT = W_B_UKV + 2048ull * 256 * 2;
constexpr size_t W_C_IN = W_B_OUT + 1024ull * 1024 * 2;
constexpr size_t W_C_OUT = W_C_IN + 3072ull * 1024 * 2;
constexpr size_t WS_WGU = 48 * MiB;
constexpr size_t WS_WD = WS_WGU + 4ull * 32 * 1024 * 1024 * 2;
constexpr size_t WS_X = WS_WD + 4ull * 32 * 1024 * 512 * 2;
constexpr size_t WS_H = WS_X + (size_t)T * 1024 * 4;
constexpr size_t WS_O = WS_H + (size_t)T * 1024 * 2;
constexpr size_t WS_R1 = WS_O + (size_t)T * 1024 * 2;
static_assert(W_C_OUT + 1024ull * 1024 * 2 <= WS_WGU, "small weights fit");
constexpr size_t R_QA = 0, R_KA = R_QA + (size_t)T * 1024 * 2, R_VTA = R_KA + (size_t)T * 256 * 2;
constexpr size_t R_CQ = 0, R_CKV = R_CQ + (size_t)T * 512 * 2, R_KR = R_CKV + (size_t)T * 256 * 2, R_QB = R_KR + (size_t)T * 32 * 2,
                 R_KN = R_QB + (size_t)T * 1536 * 2, R_VTB = R_KN + (size_t)T * 1024 * 2, R_ENDB = R_VTB + (size_t)NB * 16 * 64 * NKEY * 2;
constexpr size_t R_QC = 0, R_KC = R_QC + (size_t)T * 1024 * 2, R_VTC = R_KC + (size_t)T * 1024 * 2;
constexpr int NPOS = 2 * T + NE * 256;
constexpr size_t R_ACT = 0, R_Y2 = R_ACT + (size_t)NPOS * 512 * 2, R_ENDM = R_Y2 + (size_t)T * 2 * 1024 * 2;
constexpr size_t R_Y = R_ENDM, R_ENDY = R_Y + (size_t)T * 1024 * 2;
static_assert(R_ENDY <= R_ENDB, "MoE region + y inside R1");
constexpr size_t WS_END = WS_R1 + R_ENDB;

constexpr int LDS_BYTES = 147456;
constexpr int MISC_OFF = 146432;

#define XB_TMO      128
#define XB_XCNT(j)  (256  + 64 * (j))
#define XB_XSUB(j)  (1280 + 64 * (j))
#define XB_XGEN(j)  (2304 + 64 * (j))
#define XB_TOP      3328
#define XB_TOPGEN   3392
#define XCD_BAR_WORDS 3456
#define XB_SPIN_CAP (1u << 18)
__device__ __forceinline__ unsigned xb_ld(unsigned* p)              { return __hip_atomic_load(p, __ATOMIC_RELAXED, __HIP_MEMORY_SCOPE_AGENT); }
__device__ __forceinline__ unsigned xb_add(unsigned* p, unsigned v) { return __hip_atomic_fetch_add(p, v, __ATOMIC_RELAXED, __HIP_MEMORY_SCOPE_AGENT); }
__device__ __forceinline__ unsigned xb_xcc_id() { return (unsigned)__builtin_amdgcn_s_getreg((3 << 11) | 20) & 0xFu; }
#define XB_SPIN(cond, bar) do { unsigned _sp = 0; while (cond) { __builtin_amdgcn_s_sleep(1); \
    if ((++_sp & 255u) == 0u) { if (xb_ld(&(bar)[XB_TMO])) break; if (_sp > XB_SPIN_CAP) { atomicAdd(&(bar)[XB_TMO], 1u); break; } } } } while (0)
struct XcdBarrier { unsigned* bar; unsigned x; volatile LAS unsigned* st; };
__device__ __forceinline__ XcdBarrier xcd_barrier_post(unsigned* bar, volatile LAS unsigned* st) {
    XcdBarrier b; b.bar = bar; b.x = xb_xcc_id(); b.st = st;
    if (threadIdx.x == 0) (void)xb_add(&bar[XB_XCNT(b.x)], 1u);
    return b;
}
__device__ __forceinline__ void xcd_barrier_complete(unsigned* bar, unsigned x, unsigned& nloc, unsigned& nx) {
    const unsigned G = gridDim.x * gridDim.y * gridDim.z;
    unsigned sum, cnt, mine, sp = 0u;
    for (;;) {
        sum = 0u; cnt = 0u; mine = 0u;
#pragma unroll
        for (unsigned j = 0; j < 16; ++j) { const unsigned c = xb_ld(&bar[XB_XCNT(j)]); sum += c; cnt += (c > 0u) ? 1u : 0u; mine = (j == x) ? c : mine; }
        if (sum == G) break;
        __builtin_amdgcn_s_sleep(1);
        if ((++sp & 255u) == 0u) { if (xb_ld(&bar[XB_TMO])) break; if (sp > XB_SPIN_CAP) { atomicAdd(&bar[XB_TMO], 1u); break; } }
    }
    nloc = mine > 0u ? mine : 1u; nx = cnt > 0u ? cnt : 1u;
}
__device__ __forceinline__ void xcd_barrier(const XcdBarrier& b) {
    asm volatile("s_waitcnt vmcnt(0)" ::: "memory");
    __syncthreads();
    if (threadIdx.x == 0) {
        unsigned* bar = b.bar;
        __builtin_amdgcn_s_waitcnt(0);
        unsigned nloc = b.st[0], nx = b.st[1];
        if (nloc == 0u) { xcd_barrier_complete(bar, b.x, nloc, nx); b.st[0] = nloc; b.st[1] = nx; }
        const unsigned old = xb_add(&bar[XB_XSUB(b.x)], 1u);
        const unsigned gen = old / nloc;
        if (old + 1u == (gen + 1u) * nloc) {
            __builtin_amdgcn_fence(__ATOMIC_RELEASE, "agent");
            asm volatile("s_waitcnt vmcnt(0)" ::: "memory");
            const unsigned og = xb_add(&bar[XB_TOP], 1u);
            const unsigned tg = og / nx;
            if (og + 1u == (tg + 1u) * nx) xb_add(&bar[XB_TOPGEN], 1u);
            else XB_SPIN(xb_ld(&bar[XB_TOPGEN]) == tg, bar);
            __builtin_amdgcn_fence(__ATOMIC_ACQUIRE, "agent");
            xb_add(&bar[XB_XGEN(b.x)], 1u);
            asm volatile("s_waitcnt vmcnt(0)" ::: "memory");
        } else {
            XB_SPIN(xb_ld(&bar[XB_XGEN(b.x)]) == gen, bar);
            __builtin_amdgcn_fence(__ATOMIC_ACQUIRE, "agent");
            asm volatile("s_waitcnt vmcnt(0)" ::: "memory");
        }
    }
    __syncthreads();
}

namespace pg8 {
constexpr int BM = 256, BK = 64, HALF = 128, HTB = HALF * BK * 2, STAGE_BYTES = 8 * HTB, NXCD = 8, WGM = 2;
__host__ __device__ __forceinline__ int lds_byte(int r, int c) { const int st = (r >> 4) * 2 + (c >> 5), rr = r & 15, cc = c & 31, ob = rr * 64 + cc * 2; return st * 1024 + (ob ^ (((ob >> 9) & 1) << 5)); }
__host__ __device__ __forceinline__ void stage_rc(int b, int& R, int& C) { const int st = b / 1024, sb = b % 1024, swz = sb ^ (((sb >> 9) & 1) << 5); R = (st >> 1) * 16 + swz / 64; C = (st & 1) * 32 + (swz % 64) / 2; }
__host__ __device__ __forceinline__ int perm32(int rho) { const int n = rho >> 4, i = rho & 15; return 8 * (i >> 2) + 4 * n + (i & 3); }

struct Unit { int pm, pn, e, t, r0, nai; };
struct Gemm { const bf16_t* A; const bf16_t* Bt; int K; };

struct StaticOrder {
    static constexpr bool GATHER = false;
    int nM, nN, nwg, G, c;
    __device__ void init(int M, int N, int G_, int c_) { asm volatile("" : "+s"(G_), "+s"(c_));
        nM = M / BM; nN = N / BM; nwg = nM * nN; G = G_; c = c_; }
    __device__ bool next(int i, Unit& u) const {
        const int nfull = (nwg / G) * G, rem = nwg - nfull; const bool halves = rem > 0 && 2 * rem <= G;
        long Lx = (long)i * G + c; u.r0 = 0; u.nai = 2;
        if (Lx >= nfull && halves) { if (i * G != nfull || c >= 2 * rem) return false; Lx = nfull + (c >> 1); u.r0 = (c & 1) * HALF; u.nai = 1; }
        if (Lx >= nwg) return false;
        int wgid = (int)Lx; { const int q = nwg / NXCD, r = nwg % NXCD, xcd = wgid % NXCD, off = wgid / NXCD; wgid = (xcd < r ? xcd * (q + 1) : r * (q + 1) + (xcd - r) * q) + off; }
        const int nig = WGM * nN, gid = wgid / nig, fm = gid * WGM, gsz = (nM - fm) < WGM ? (nM - fm) : WGM;
        u.pm = fm + ((wgid % nig) % gsz); u.pn = (wgid % nig) / gsz; u.e = 0; u.t = 0; return true;
    }
    __device__ __forceinline__ int arow(const Unit& u, int r) const { return u.pm * BM + u.r0 + r; }
};

template <class Epi, class Sched, bool ALIGN_EPI>
__device__ __forceinline__ void gemm_phase(LAS unsigned char* lds, const Gemm g, const Sched& S, const Epi& E) {
    int tid_ = threadIdx.x; asm volatile("" : "+v"(tid_));
    const int tid = tid_, wid = __builtin_amdgcn_readfirstlane(tid >> 6), lane = tid & 63, wr = wid >> 2, wc = wid & 3, fr = lane & 15, fq = lane >> 4;
    const int K = g.K, nt = K / BK;
    unsigned voffB[2];
#pragma unroll
    for (int i = 0; i < 2; ++i) { int R, C; stage_rc(tid * 16 + i * 8192, R, C); const int Rb = Epi::PERM ? ((R & ~31) + perm32(R & 31)) : R;
        voffB[i] = (unsigned)(Rb * K + C) * 2u; }
    const size_t kstep = (size_t)(BK * 2);
    const size_t hstep = (size_t)HALF * K * 2;
    const size_t tstep = 2 * hstep;
    const unsigned ldsw = (unsigned)wid * 1024u;
    const int aoff = lds_byte(wr * 64 + fr, fq * 8), boff = lds_byte(wc * 32 + fr, fq * 8);
#define PG8_SA(b, h) (((b) * 2 + (h)) * HTB)
#define PG8_SB(b, h) ((4 + (b) * 2 + (h)) * HTB)
#define PG8_STAGE(bufoff, gbase, voff) do { _Pragma("unroll") for (int _i = 0; _i < 2; ++_i) \
        __builtin_amdgcn_global_load_lds((const unsigned*)((const char*)(gbase) + (voff)[_i]), (LAS unsigned*)(lds + (bufoff) + ldsw + _i * 8192), 16, 0, 0); } while (0)
#define PG8_LDA(dst, b, h) do { _Pragma("unroll") for (int m = 0; m < 4; ++m) _Pragma("unroll") for (int k = 0; k < 2; ++k) dst[m][k] = *(const LAS bf16x8*)(lds + PG8_SA(b, h) + aoff + m * 2048 + k * 1024); } while (0)
#define PG8_LDB(dst, b, h) do { _Pragma("unroll") for (int n = 0; n < 2; ++n) _Pragma("unroll") for (int k = 0; k < 2; ++k) dst[n][k] = *(const LAS bf16x8*)(lds + PG8_SB(b, h) + boff + n * 2048 + k * 1024); } while (0)
#define PG8_MMA(ai, bj, At, Bt) do { __builtin_amdgcn_s_setprio(1); _Pragma("unroll") for (int m = 0; m < 4; ++m) _Pragma("unroll") for (int n = 0; n < 2; ++n) _Pragma("unroll") for (int k = 0; k < 2; ++k) \
        acc[ai][bj][m][n] = __builtin_amdgcn_mfma_f32_16x16x32_bf16(Bt[n][k], At[m][k], acc[ai][bj][m][n], 0, 0, 0); __builtin_amdgcn_s_setprio(0); } while (0)
#define PG8_WAIT_V(n) asm volatile("s_waitcnt vmcnt(" #n ")" ::: "memory")
#define PG8_WAIT_L(n) asm volatile("s_waitcnt lgkmcnt(" #n ")" ::: "memory")
#define PG8_BAR __builtin_amdgcn_s_barrier()
#define PG8_SCHED __builtin_amdgcn_sched_barrier(0)
#define PG8_AOFF(dst, u) do { _Pragma("unroll") for (int _i = 0; _i < 2; ++_i) { int R_, C_; stage_rc(tid * 16 + _i * 8192, R_, C_); \
        _Pragma("unroll") for (int _h = 0; _h < 2; ++_h) dst[_h][_i] = (unsigned)(S.arow(u, _h * HALF + R_) * K + C_) * 2u; } } while (0)
    Unit cur, nxt; int ui = 0;
    if (!S.next(0, cur)) return;
    f32x4 acc[2][2][4][2];
#pragma unroll
    for (int a = 0; a < 2; ++a)
#pragma unroll
        for (int b = 0; b < 2; ++b)
#pragma unroll
            for (int m = 0; m < 4; ++m)
#pragma unroll
                for (int n = 0; n < 2; ++n) acc[a][b][m][n] = (f32x4){0.f, 0.f, 0.f, 0.f};
    bf16x8 At[4][2], B0[2][2], B1[2][2];
    unsigned voffA[2]; unsigned vA[2][2], nA_[2][2];
    const char* cA = (const char*)g.A; const char* nAp = cA;
    if constexpr (Sched::GATHER) { PG8_AOFF(vA, cur); }
    else {
#pragma unroll
        for (int i = 0; i < 2; ++i) { int R, C; stage_rc(tid * 16 + i * 8192, R, C); voffA[i] = (unsigned)(R * K + C) * 2u; }
        cA = (const char*)g.A + (size_t)cur.pm * tstep + (size_t)cur.r0 * K * 2;
    }
#define PG8_STA(bufoff, kptr, h, offs) do { if constexpr (Sched::GATHER) { PG8_STAGE(bufoff, kptr, offs[h]); } else { PG8_STAGE(bufoff, (kptr) + (h) * hstep, voffA); } } while (0)
    const char* cB = (const char*)g.Bt + (size_t)cur.pn * tstep;
    PG8_STAGE(PG8_SB(0, 0), cB, voffB); PG8_STAGE(PG8_SB(0, 1), cB + hstep, voffB); PG8_STA(PG8_SA(0, 0), cA, 0, vA); PG8_STA(PG8_SA(0, 1), cA, 1, vA);
    if (wr == 1) PG8_BAR;
    PG8_WAIT_V(2); PG8_BAR;
    PG8_STAGE(PG8_SB(1, 0), cB + kstep, voffB); PG8_STA(PG8_SA(1, 0), cA + kstep, 0, vA); PG8_STAGE(PG8_SB(1, 1), cB + hstep + kstep, voffB);
    PG8_WAIT_V(6); PG8_BAR;
    for (;;) {
        const bool has_next = S.next(ui + 1, nxt);
        if constexpr (Sched::GATHER) {
            if (has_next) { PG8_AOFF(nA_, nxt); } else {
#pragma unroll
                for (int _h = 0; _h < 2; ++_h)
#pragma unroll
                    for (int _i = 0; _i < 2; ++_i) nA_[_h][_i] = vA[_h][_i]; }
        } else { nAp = has_next ? (const char*)g.A + (size_t)nxt.pm * tstep + (size_t)nxt.r0 * K * 2 : cA; }
        const char* nB = has_next ? (const char*)g.Bt + (size_t)nxt.pn * tstep : cB;
        const bool full = cur.nai == 2;
#pragma unroll 1
        for (int t = 0; t < nt; t += 2) {
            const bool last = (t == nt - 2);
            const char* a1 = cA + (size_t)(t + 1) * kstep;
            const char* a2 = last ? nAp : cA + (size_t)(t + 2) * kstep; const char* b2 = last ? nB : cB + (size_t)(t + 2) * kstep;
            const char* a3 = a2 + kstep; const char* b3 = b2 + kstep;
            unsigned wq[2][2];
            if constexpr (Sched::GATHER) {
#pragma unroll
                for (int _h = 0; _h < 2; ++_h)
#pragma unroll
                    for (int _i = 0; _i < 2; ++_i) wq[_h][_i] = last ? nA_[_h][_i] : vA[_h][_i];
            }
            PG8_LDB(B0, 0, 0); PG8_LDB(B1, 0, 1); PG8_SCHED; PG8_LDA(At, 0, 0); PG8_STA(PG8_SA(1, 1), a1, 1, vA);
            PG8_WAIT_V(8); PG8_WAIT_L(0); PG8_BAR; PG8_MMA(0, 0, At, B0); PG8_MMA(0, 1, At, B1); PG8_BAR; PG8_SCHED;
            PG8_LDA(At, 0, 1); PG8_STAGE(PG8_SB(0, 0), b2, voffB); PG8_STAGE(PG8_SB(0, 1), b2 + hstep, voffB); PG8_STA(PG8_SA(0, 0), a2, 0, wq);
            PG8_WAIT_V(8); PG8_WAIT_L(0); PG8_BAR; if (full) { PG8_MMA(1, 0, At, B0); PG8_MMA(1, 1, At, B1); } PG8_BAR; PG8_SCHED;
            PG8_LDB(B0, 1, 0); PG8_LDB(B1, 1, 1); PG8_SCHED; PG8_LDA(At, 1, 0); PG8_STA(PG8_SA(0, 1), a2, 1, wq);
            PG8_WAIT_V(8); PG8_WAIT_L(0); PG8_BAR; PG8_MMA(0, 0, At, B0); PG8_MMA(0, 1, At, B1); PG8_BAR; PG8_SCHED;
            PG8_LDA(At, 1, 1); PG8_STAGE(PG8_SB(1, 0), b3, voffB); PG8_STAGE(PG8_SB(1, 1), b3 + hstep, voffB); PG8_STA(PG8_SA(1, 0), a3, 0, wq);
            PG8_WAIT_V(8); PG8_WAIT_L(0); PG8_BAR; if (full) { PG8_MMA(1, 0, At, B0); PG8_MMA(1, 1, At, B1); } PG8_BAR; PG8_SCHED;
        }
        if constexpr (ALIGN_EPI) { if (wr == 0) PG8_BAR; }
        E(acc, cur, wr, wc, fr, fq);
        if (!has_next) break;
#pragma unroll
        for (int a = 0; a < 2; ++a)
#pragma unroll
            for (int b = 0; b < 2; ++b)
#pragma unroll
                for (int m = 0; m < 4; ++m)
#pragma unroll
                    for (int n = 0; n < 2; ++n) acc[a][b][m][n] = (f32x4){0.f, 0.f, 0.f, 0.f};
        cur = nxt; cB = nB; ++ui;
        if constexpr (Sched::GATHER) {
#pragma unroll
            for (int _h = 0; _h < 2; ++_h)
#pragma unroll
                for (int _i = 0; _i < 2; ++_i) vA[_h][_i] = nA_[_h][_i];
        } else { cA = nAp; }
        if constexpr (ALIGN_EPI) { if (wr == 1) PG8_BAR; }
    }
    PG8_WAIT_V(0);
    if constexpr (!ALIGN_EPI) { if (wr == 0) PG8_BAR; }
    PG8_BAR;
#undef PG8_STA
#undef PG8_SA
#undef PG8_SB
#undef PG8_STAGE
#undef PG8_LDA
#undef PG8_LDB
#undef PG8_MMA
#undef PG8_WAIT_V
#undef PG8_WAIT_L
#undef PG8_BAR
#undef PG8_SCHED
#undef PG8_AOFF
}
}
namespace epi {
using pg8::Unit;
typedef float2 cs2;
__device__ __forceinline__ void rope8(f32x4& v0, f32x4& v1, const f32x4 c01, const f32x4 c23) {
    float a, b;
    a = v0[0]; b = v0[1]; v0[0] = a * c01[0] - b * c01[1]; v0[1] = b * c01[0] + a * c01[1];
    a = v0[2]; b = v0[3]; v0[2] = a * c01[2] - b * c01[3]; v0[3] = b * c01[2] + a * c01[3];
    a = v1[0]; b = v1[1]; v1[0] = a * c23[0] - b * c23[1]; v1[1] = b * c23[0] + a * c23[1];
    a = v1[2]; b = v1[3]; v1[2] = a * c23[2] - b * c23[3]; v1[3] = b * c23[2] + a * c23[3];
}
__device__ __forceinline__ u32x4 pack8(const f32x4 v0, const f32x4 v1) { u32x4 w; w.x = cvt_pk_bf16(v0[0], v0[1]); w.y = cvt_pk_bf16(v0[2], v0[3]); w.z = cvt_pk_bf16(v1[0], v1[1]); w.w = cvt_pk_bf16(v1[2], v1[3]); return w; }
__device__ __forceinline__ void store_vt(bf16_t* VT, int HV, int DV, int row, int vcol, const f32x4 v0, const f32x4 v1) {
    const int b = row < TL ? (row >> 12) : ((row - TL) >> 8), key = row < TL ? (row & 4095) : (S + ((row - TL) & 255));
    const int hv = vcol / DV, dv = vcol % DV;
    bf16_t* p = VT + ((size_t)(b * HV + hv) * DV + dv) * NKEY + key;
#pragma unroll
    for (int i = 0; i < 4; ++i) { p[(size_t)i * NKEY] = (bf16_t)f2bf(v0[i]); p[(size_t)(4 + i) * NKEY] = (bf16_t)f2bf(v1[i]); }
}

struct EpiQKV {
    static constexpr bool PERM = true;
    bf16_t* Q; int ldq; bf16_t* Kb; int ldk; bf16_t* VT; int HV, DV; int nQ, nK; float qscale; const float* tab64;
    __device__ __forceinline__ void operator()(const f32x4 (&acc)[2][2][4][2], const Unit& u, int wr, int wc, int fr, int fq) const {
        const int kindt = u.pn < nQ ? 0 : (u.pn < nQ + nK ? 1 : 2);
        const int tcol = (kindt == 0 ? u.pn : (kindt == 1 ? u.pn - nQ : u.pn - nQ - nK)) * 256 + wc * 32 + fq * 8;
#pragma unroll
        for (int ai = 0; ai < 2; ++ai) if (ai < u.nai)
#pragma unroll
            for (int m = 0; m < 4; ++m) {
                asm volatile("" ::: "memory");
                const int row = u.pm * 256 + u.r0 + ai * 128 + wr * 64 + m * 16 + fr;
                if (kindt == 2) {
#pragma unroll
                    for (int bj = 0; bj < 2; ++bj) store_vt(VT, HV, DV, row, tcol + bj * 128, acc[ai][bj][m][0], acc[ai][bj][m][1]);
                } else {
                    f32x4 c01 = (f32x4){1.f, 0.f, 1.f, 0.f}, c23 = c01;
                    if (row < TL) { const int s = row & 4095, pos = (wc & 1) ? (s & 63) : (s >> 6);
                        const f32x4* tp = (const f32x4*)(tab64 + ((size_t)pos * 16 + fq * 4) * 2); c01 = tp[0]; c23 = tp[1]; }
                    const float sc = kindt == 0 ? qscale : 1.f;
                    bf16_t* dst = (kindt == 0 ? Q + (size_t)row * ldq : Kb + (size_t)row * ldk) + tcol;
#pragma unroll
                    for (int bj = 0; bj < 2; ++bj) { f32x4 v0 = acc[ai][bj][m][0], v1 = acc[ai][bj][m][1]; rope8(v0, v1, c01, c23); v0 = v0 * sc; v1 = v1 * sc;
                        *(u32x4*)(dst + bj * 128) = pack8(v0, v1); }
                }
            }
    }
};
struct EpiB1 {
    static constexpr bool PERM = true;
    bf16_t* CQ; bf16_t* CKV; bf16_t* KR; float* SSQ; const float* tab32;
    __device__ __forceinline__ void operator()(const f32x4 (&acc)[2][2][4][2], const Unit& u, int wr, int wc, int fr, int fq) const {
#pragma unroll
        for (int ai = 0; ai < 2; ++ai) if (ai < u.nai)
#pragma unroll
            for (int m = 0; m < 4; ++m) {
                asm volatile("" ::: "memory");
                const int row = u.pm * 256 + u.r0 + ai * 128 + wr * 64 + m * 16 + fr;
                if (u.pn < 3) {
                    float ss = 0.f;
#pragma unroll
                    for (int bj = 0; bj < 2; ++bj)
#pragma unroll
                        for (int n = 0; n < 2; ++n) { const f32x4 v = acc[ai][bj][m][n]; ss += (v[0] * v[0] + v[1] * v[1]) + (v[2] * v[2] + v[3] * v[3]); }
                    ss = xor32_sum(xor16_sum(ss));
                    if (fq == 0) SSQ[(size_t)row * 12 + u.pn * 4 + wc] = ss;
                    bf16_t* dst = (u.pn < 2 ? CQ + (size_t)row * 512 + u.pn * 256 : CKV + (size_t)row * 256) + wc * 32 + fq * 8;
#pragma unroll
                    for (int bj = 0; bj < 2; ++bj) *(u32x4*)(dst + bj * 128) = pack8(acc[ai][bj][m][0], acc[ai][bj][m][1]);
                } else if (wc == 0) {
                    f32x4 v0 = acc[ai][0][m][0], v1 = acc[ai][0][m][1];
                    if (row < TL) { const int s = row & 4095, pos = (fq & 2) ? (s & 63) : (s >> 6);
                        const f32x4* tp = (const f32x4*)(tab32 + ((size_t)pos * 8 + (fq & 1) * 4) * 2); rope8(v0, v1, tp[0], tp[1]); }
                    *(u32x4*)(KR + (size_t)row * 32 + fq * 8) = pack8(v0, v1);
                }
            }
    }
};
struct EpiB2 {
    static constexpr bool PERM = true;
    bf16_t* QB; const float* SSQ; const float* tab32; float qscale;
    __device__ __forceinline__ void operator()(const f32x4 (&acc)[2][2][4][2], const Unit& u, int wr, int wc, int fr, int fq) const {
#pragma unroll
        for (int ai = 0; ai < 2; ++ai) if (ai < u.nai)
#pragma unroll
            for (int m = 0; m < 4; ++m) {
                asm volatile("" ::: "memory");
                const int row = u.pm * 256 + u.r0 + ai * 128 + wr * 64 + m * 16 + fr;
                const f32x4 s0 = *(const f32x4*)(SSQ + (size_t)row * 12), s1 = *(const f32x4*)(SSQ + (size_t)row * 12 + 4);
                const float ss = ((s0[0] + s0[1]) + (s0[2] + s0[3])) + ((s1[0] + s1[1]) + (s1[2] + s1[3]));
                const float sc = qscale / sqrtf(ss * (1.f / 512.f) + RMS_EPS);
#pragma unroll
                for (int bj = 0; bj < 2; ++bj) {
                    const int col = u.pn * 256 + bj * 128 + wc * 32 + fq * 8, w0 = col % 96;
                    f32x4 v0 = acc[ai][bj][m][0] * sc, v1 = acc[ai][bj][m][1] * sc;
                    if (w0 >= 64 && row < TL) { const int off = w0 - 64, s = row & 4095, pos = (off & 16) ? (s & 63) : (s >> 6);
                        const f32x4* tp = (const f32x4*)(tab32 + ((size_t)pos * 8 + ((off & 15) >> 1)) * 2); rope8(v0, v1, tp[0], tp[1]); }
                    *(u32x4*)(QB + (size_t)row * 1536 + col) = pack8(v0, v1);
                }
            }
    }
};
struct EpiB3 {
    static constexpr bool PERM = true;
    bf16_t* KN; bf16_t* VT; const float* SSQ;
    __device__ __forceinline__ void operator()(const f32x4 (&acc)[2][2][4][2], const Unit& u, int wr, int wc, int fr, int fq) const {
#pragma unroll
        for (int ai = 0; ai < 2; ++ai) if (ai < u.nai)
#pragma unroll
            for (int m = 0; m < 4; ++m) {
                asm volatile("" ::: "memory");
                const int row = u.pm * 256 + u.r0 + ai * 128 + wr * 64 + m * 16 + fr;
                const f32x4 s2 = *(const f32x4*)(SSQ + (size_t)row * 12 + 8);
                const float sc = 1.0f / sqrtf(((s2[0] + s2[1]) + (s2[2] + s2[3])) * (1.f / 256.f) + RMS_EPS);
#pragma unroll
                for (int bj = 0; bj < 2; ++bj) {
                    const f32x4 v0 = acc[ai][bj][m][0] * sc, v1 = acc[ai][bj][m][1] * sc;
                    const int tc = bj * 128 + wc * 32 + fq * 8;
                    if (u.pn < 4) *(u32x4*)(KN + (size_t)row * 1024 + u.pn * 256 + tc) = pack8(v0, v1);
                    else store_vt(VT, 16, 64, row, (u.pn - 4) * 256 + tc, v0, v1);
                }
            }
    }
};
struct EpiOut {
    static constexpr bool PERM = true;
    bf16_t* Y;
    __device__ __forceinline__ void operator()(const f32x4 (&acc)[2][2][4][2], const Unit& u, int wr, int wc, int fr, int fq) const {
#pragma unroll
        for (int ai = 0; ai < 2; ++ai) if (ai < u.nai)
#pragma unroll
            for (int m = 0; m < 4; ++m) {
                const int row = u.pm * 256 + u.r0 + ai * 128 + wr * 64 + m * 16 + fr;
#pragma unroll
                for (int bj = 0; bj < 2; ++bj)
                    *(u32x4*)(Y + (size_t)row * 1024 + u.pn * 256 + bj * 128 + wc * 32 + fq * 8) = pack8(acc[ai][bj][m][0], acc[ai][bj][m][1]);
            }
    }
};
struct EpiGU {
    static constexpr bool PERM = true;
    bf16_t* ACT;
    __device__ __forceinline__ void operator()(const f32x4 (&acc)[2][2][4][2], const Unit& u, int wr, int wc, int fr, int fq) const {
#pragma unroll
        for (int ai = 0; ai < 2; ++ai) if (ai < u.nai)
#pragma unroll
            for (int m = 0; m < 4; ++m) {
                asm volatile("" ::: "memory");
                const int row = u.pm * 256 + u.r0 + ai * 128 + wr * 64 + m * 16 + fr;
#pragma unroll
                for (int bj = 0; bj < 2; ++bj) {
                    const f32x4 g = acc[ai][bj][m][0], up = acc[ai][bj][m][1]; f32x4 a;
#pragma unroll
                    for (int i = 0; i < 4; ++i) a[i] = g[i] / (1.f + __expf(-g[i])) * up[i];
                    u32x2 w; w.x = cvt_pk_bf16(a[0], a[1]); w.y = cvt_pk_bf16(a[2], a[3]);
                    *(u32x2*)(ACT + (size_t)row * 512 + (u.pn & 3) * 128 + bj * 64 + wc * 16 + fq * 4) = w;
                }
            }
    }
};
struct EpiDown {
    static constexpr bool PERM = true;
    bf16_t* Y2; const int* list; const int* cnt; const float* tokw;
    __device__ __forceinline__ void operator()(const f32x4 (&acc)[2][2][4][2], const Unit& u, int wr, int wc, int fr, int fq) const {
        const int ne = cnt[u.e * 64];
#pragma unroll
        for (int ai = 0; ai < 2; ++ai) if (ai < u.nai)
#pragma unroll
            for (int m = 0; m < 4; ++m) {
                asm volatile("" ::: "memory");
                const int idx = u.t * 256 + u.r0 + ai * 128 + wr * 64 + m * 16 + fr;
                if (idx < ne) {
                    const int ent = list[(size_t)u.e * T + idx]; const float w = tokw[ent];
#pragma unroll
                    for (int bj = 0; bj < 2; ++bj)
                        *(u32x4*)(Y2 + (size_t)ent * 1024 + (u.pn & 3) * 256 + bj * 128 + wc * 32 + fq * 8) = pack8(acc[ai][bj][m][0] * w, acc[ai][bj][m][1] * w);
                }
            }
    }
};
}

template <bool GATHER_> struct MoeOrder {
    static constexpr bool GATHER = GATHER_;
    const LAS int* tp; const int* cnt; const int* list; int G, c;
    __device__ bool next(int i, pg8::Unit& u) const {
        const int nwg = tp[NE] * 4, nfull = (nwg / G) * G, rem = nwg - nfull; const bool halves = rem > 0 && 2 * rem <= G;
        int Lx = i * G + c; u.r0 = 0; u.nai = 2;
        if (Lx >= nfull && halves) { if (i * G != nfull || c >= 2 * rem) return false; Lx = nfull + (c >> 1); u.r0 = (c & 1) * 128; u.nai = 1; }
        if (Lx >= nwg) return false;
        const int tt = Lx >> 2;
        int e = 0;
#pragma unroll 1
        for (int k = 1; k < NE; ++k) e = (tp[k] <= tt) ? k : e;
        u.pm = tt; u.t = tt - tp[e]; u.e = e; u.pn = e * 4 + (Lx & 3); return true;
    }
    __device__ __forceinline__ int arow(const pg8::Unit& u, int r) const {
        if (!GATHER_) return u.pm * 256 + u.r0 + r;
        const int idx = u.t * 256 + u.r0 + r;
        return idx < cnt[u.e * 64] ? (list[(size_t)u.e * T + idx] >> 1) : 0;
    }
};
namespace attn {
struct Tensors {
    const bf16_t* Q; const bf16_t* K1; const bf16_t* K2; const bf16_t* VT; bf16_t* O;
    const float* sink; const float* lamp; const float* subln; float lambda_init;
};
__device__ __forceinline__ float max3f(float a, float b, float c) { float r; asm("v_max3_f32 %0, %1, %2, %3" : "=v"(r) : "v"(a), "v"(b), "v"(c)); return r; }
__device__ __forceinline__ float max32(const f32x16& a, const f32x16& b) {
    float r0 = max3f(a[0], a[1], a[2]), r1 = max3f(a[3], a[4], a[5]), r2 = max3f(a[6], a[7], a[8]), r3 = max3f(a[9], a[10], a[11]);
    r0 = max3f(r0, a[12], a[13]); r1 = max3f(r1, a[14], a[15]); r2 = max3f(r2, b[0], b[1]); r3 = max3f(r3, b[2], b[3]);
    r0 = max3f(r0, b[4], b[5]); r1 = max3f(r1, b[6], b[7]); r2 = max3f(r2, b[8], b[9]); r3 = max3f(r3, b[10], b[11]);
    r0 = max3f(r0, b[12], b[13]); r1 = max3f(r1, b[14], b[15]);
    return max3f(max3f(r0, r1, r2), r3, r3);
}
constexpr float ATT_THR = 10.f;
#define MFMA32(a, b, c) __builtin_amdgcn_mfma_f32_32x32x16_bf16((a), (b), (c), 0, 0, 0)

template <int KIND, bool PIPE = false, int VAR = 0>
__device__ __forceinline__ void phase(LAS unsigned char* lds, const Tensors P, int G, int cid, bool with_ctx) {
    asm volatile("" : "+s"(G), "+s"(cid));
    constexpr int NST = KIND == 1 ? 6 : 4, DV = KIND == 2 ? 128 : 64, NDV = DV / 32, KROWB = KIND == 0 ? 128 : 256, KCH = KIND == 0 ? 8 : (KIND == 1 ? 12 : 16);
    constexpr int KJ = (64 * KCH + 511) / 512, VJ = DV * 8 / 512, HV = KIND == 0 ? 4 : (KIND == 1 ? 16 : 8);
    constexpr int LDQ = KIND == 1 ? 1536 : 1024, LDK = KIND == 0 ? 256 : 1024;
    constexpr int KB0 = 0, VB0 = 32768, BUFSTEP = 16384, SCR = 65536;
    int tid_ = threadIdx.x; asm volatile("" : "+v"(tid_));
    const int tid = tid_, lane = tid & 63, w = __builtin_amdgcn_readfirstlane(tid >> 6), r = lane & 31, hh = lane >> 5;
    const int NU = 2048 + (with_ctx ? 128 : 0);
    constexpr int KPIECES = 64 * KROWB / 8192, VPIECES = DV * 128 / 8192;
    int ksrc[KPIECES], ksrb[KPIECES]; bool kpart2[KPIECES];
#pragma unroll
    for (int j = 0; j < KPIECES; ++j) {
        const int p = (j * 8 + w) * 1024 + lane * 16, kk = p / KROWB, pc = (p % KROWB) >> 4;
        int c = pc ^ (KROWB == 128 ? ((kk >> 1) & 7) : (kk & 15)); if (c >= KCH) c = 0;
        kpart2[j] = (KIND == 1) && c >= 8;
        ksrc[j] = kpart2[j] ? kk * 32 + (c - 8) * 8 : kk * LDK + c * 8;
        ksrb[j] = kpart2[j] ? 32 : LDK;
    }
    int vsrc[VPIECES];
#pragma unroll
    for (int j = 0; j < VPIECES; ++j) { const int p = (j * 8 + w) * 1024 + lane * 16, dv = p >> 7, pc = (p & 127) >> 4, c = pc ^ ((dv >> 1) & 7); vsrc[j] = dv * NKEY + c * 8; }
    const int rs = (r & ~12) | ((r & 4) << 1) | ((r & 8) >> 1);
    const int krow0 = rs * KROWB, krow1 = (32 + rs) * KROWB;
    const int ksw0 = KROWB == 128 ? ((rs >> 1) & 7) : (rs & 15), ksw1 = KROWB == 128 ? (((32 + rs) >> 1) & 7) : ((32 + rs) & 15);
    const int vsw = (r >> 1) & 7;
    float lam = 0.f;
    if (KIND == 2) { const float a = wave_sum(P.lamp[lane] * P.lamp[64 + lane]), b2 = wave_sum(P.lamp[128 + lane] * P.lamp[192 + lane]); lam = expf(a) - expf(b2) + P.lambda_init; }

#define ATT_DECL(X) int X##b = 0, X##hd = 0, X##qb = 0, X##qi = 0, X##wlo = 0, X##nwin = 0, X##nt = 0, X##ocol = 0, X##qcol = 0, X##kcol = 0, X##hv = 0, X##cmap = 0, X##qrow = 0, X##lat = 0
#define ATT_COPY(D_, S_) do { D_##b = S_##b; D_##hd = S_##hd; D_##qb = S_##qb; D_##qi = S_##qi; D_##wlo = S_##wlo; D_##nwin = S_##nwin; D_##nt = S_##nt; D_##ocol = S_##ocol; D_##qcol = S_##qcol; D_##kcol = S_##kcol; D_##hv = S_##hv; D_##cmap = S_##cmap; D_##qrow = S_##qrow; D_##lat = S_##lat; } while (0)
#define ATT_DECODE(U_, X) do { X##lat = (U_) < 2048; const int V_ = X##lat ? (U_) : (U_) - 2048; X##wlo = 0; X##nwin = 0; X##cmap = 0; int q0_; \
        if (KIND == 0) { \
            if (X##lat) { X##b = V_ >> 8; X##hd = (V_ >> 6) & 3; X##qb = V_ & 63; const int whi = X##qb + 2 > 63 ? 63 : X##qb + 2; X##wlo = X##qb - 2 < 0 ? 0 : X##qb - 2; X##nwin = whi - X##wlo + 1; } \
            else { X##b = V_ >> 4; X##hd = (V_ >> 2) & 3; X##qb = V_ & 3; } \
            q0_ = X##qb * 64; X##qi = q0_ + 32 * (w & 1) + r; const int hq = X##hd * 4 + (w >> 1); X##qcol = hq * 64; X##ocol = hq * 64; X##kcol = X##hd * 64; X##hv = X##hd; X##nt = X##nwin + 4; \
        } else if (KIND == 1) { \
            if (X##lat) { X##b = V_ >> 8; X##hd = (V_ >> 4) & 15; X##qb = V_ & 15; X##nt = 68; } else { X##b = V_ >> 4; X##hd = V_ & 15; X##qb = 0; X##nt = 4; } \
            q0_ = X##qb * 256; X##qi = q0_ + 32 * w + r; X##qcol = X##hd * 96; X##ocol = X##hd * 64; X##kcol = X##hd * 64; X##hv = X##hd; \
        } else { \
            if (X##lat) { X##b = V_ >> 8; X##hd = (V_ >> 5) & 7; X##qb = V_ & 31; X##nt = 68; } else { X##b = V_ >> 4; X##hd = (V_ >> 1) & 7; X##qb = V_ & 1; X##nt = 4; } \
            q0_ = X##qb * 128; X##qi = q0_ + 32 * (w & 3) + r; X##cmap = (w >> 2) * 8; X##qcol = (X##hd * 2 + (w >> 2)) * 64; X##ocol = X##hd * 128; X##kcol = X##hd * 128; X##hv = X##hd; \
        } \
        X##qrow = X##lat ? X##b * S + X##qi : TL + X##b * L + X##qi; } while (0)
#define ATT_TILE_KT(X, tt) ((KIND == 0) ? ((tt) < X##nwin ? X##wlo + (tt) : 64 + (tt) - X##nwin) : (X##lat ? (tt) : 64 + (tt)))
#define ATT_ISSUE(X, tt, buf_) do { const int kt_ = ATT_TILE_KT(X, tt); const int rb_ = kt_ < 64 ? X##b * S + 64 * kt_ : TL + X##b * L + 64 * (kt_ - 64); \
        const bf16_t* K1u_ = P.K1 + X##kcol; const bf16_t* VTu_ = P.VT + (size_t)(X##b * HV + X##hv) * DV * NKEY; \
        _Pragma("unroll") for (int j = 0; j < KPIECES; ++j) __builtin_amdgcn_global_load_lds((const unsigned*)((kpart2[j] ? P.K2 : K1u_) + (size_t)rb_ * ksrb[j] + ksrc[j]), (LAS unsigned*)(lds + KB0 + (buf_) * BUFSTEP + (j * 8 + w) * 1024), 16, 0, 0); \
        _Pragma("unroll") for (int j = 0; j < VPIECES; ++j) __builtin_amdgcn_global_load_lds((const unsigned*)(VTu_ + 64 * kt_ + vsrc[j]), (LAS unsigned*)(lds + VB0 + (buf_) * BUFSTEP + (j * 8 + w) * 1024), 16, 0, 0); } while (0)
#define ATT_QLOAD(dst, X) do { _Pragma("unroll") for (int st = 0; st < NST; ++st) dst[st] = *(const bf16x8*)(P.Q + (size_t)X##qrow * LDQ + X##qcol + 16 * st + 8 * hh); } while (0)
#define ATT_VFRAG(d, sub, sp) (*(const LAS bf16x8*)(vb + (32 * (d) + r) * 128 + 16 * ((4 * (sub) + 2 * (sp) + hh) ^ vsw)))
#define ATT_QX(SV, sp, lo, hi) do { _Pragma("unroll") for (int i_ = (lo); i_ < (hi); i_ += 2) { f32x2 t_; t_.x = __builtin_amdgcn_exp2f(SV[8 * (sp) + i_]); t_.y = __builtin_amdgcn_exp2f(SV[8 * (sp) + i_ + 1]); SV[8 * (sp) + i_] = t_.x; SV[8 * (sp) + i_ + 1] = t_.y; psv += t_; } } while (0)
#define ATT_QC(SV, sub, sp) do { u32x4 a_; a_.x = cvt_pk_bf16(SV[8 * (sp) + 0], SV[8 * (sp) + 1]); a_.y = cvt_pk_bf16(SV[8 * (sp) + 2], SV[8 * (sp) + 3]); a_.z = cvt_pk_bf16(SV[8 * (sp) + 4], SV[8 * (sp) + 5]); a_.w = cvt_pk_bf16(SV[8 * (sp) + 6], SV[8 * (sp) + 7]); pf[sub][sp] = __builtin_bit_cast(bf16x8, a_); } while (0)
#define ATT_TILE(tt, ISLAST) do { \
            const int buf = ((tt) + pb) & 1; \
            ATT_DECL(nx); if (ISLAST) { const int Un_ = U + G < NU ? U + G : U; ATT_DECODE(Un_, nx); ATT_ISSUE(nx, 0, buf ^ 1); } else { ATT_ISSUE(cu, (tt) + 1, buf ^ 1); } \
            const LAS unsigned char* kb = lds + KB0 + buf * BUFSTEP; const LAS unsigned char* vb = lds + VB0 + buf * BUFSTEP; \
            const float negm = -m; \
            f32x16 s0, s1; \
            _Pragma("unroll") for (int i = 0; i < 16; ++i) { s0[i] = negm; s1[i] = negm; } \
            { bf16x8 kf[NST][2]; \
              _Pragma("unroll") for (int st = 0; st < NST; ++st) { const int c = 2 * st + hh + cucmap; \
                  kf[st][0] = *(const LAS bf16x8*)(kb + krow0 + 16 * (c ^ ksw0)); kf[st][1] = *(const LAS bf16x8*)(kb + krow1 + 16 * (c ^ ksw1)); } \
              __builtin_amdgcn_sched_barrier(0); \
              __builtin_amdgcn_s_setprio(1); \
              _Pragma("unroll") for (int st = 0; st < NST; ++st) { s0 = MFMA32(kf[st][0], qf[st], s0); s1 = MFMA32(kf[st][1], qf[st], s1); } \
              __builtin_amdgcn_s_setprio(0); } \
            if (ISLAST) { __builtin_amdgcn_sched_barrier(0); ATT_QLOAD(qf, nx); }        \
            constexpr int NDVP = NDV < 2 ? NDV : 2; \
            bf16x8 vf[NDVP][2][2]; bf16x8 vq[2][4]; \
            if (NDV == 4) { _Pragma("unroll") for (int q = 0; q < 2; ++q) _Pragma("unroll") for (int d = 0; d < 4; ++d) vq[q][d] = ATT_VFRAG(d, 0, q); } \
            else { _Pragma("unroll") for (int d = 0; d < NDVP; ++d) _Pragma("unroll") for (int sub = 0; sub < 2; ++sub) _Pragma("unroll") for (int sp = 0; sp < 2; ++sp) vf[d][sub][sp] = ATT_VFRAG(d, sub, sp); } \
            __builtin_amdgcn_sched_barrier(0); \
            if (KIND == 0) { const int kt = ATT_TILE_KT(cu, tt); \
                if (kt < 64 && (kt == cuqb - 2 || kt == cuqb + 2)) { const int d0 = 64 * kt + 8 * hh - cuqi; \
                    _Pragma("unroll") for (int i = 0; i < 16; ++i) { const int da = d0 + (i & 7) + 16 * (i >> 3), db = da + 32; \
                        if (da < -128 || da > 128) s0[i] = -INFINITY; if (db < -128 || db > 128) s1[i] = -INFINITY; } } } \
            float mx = max32(s0, s1); \
            mx = xor32_max(mx); \
            const bool first = (KIND != 0) && (tt) == 0; \
            if (first || __any(mx > ATT_THR)) { \
                const float d = first ? mx : fmaxf(mx, 0.f), alpha = first ? 1.f : __builtin_amdgcn_exp2f(-d); \
                m += d; lsum *= alpha; \
                _Pragma("unroll") for (int dd = 0; dd < NDV; ++dd) o[dd] = o[dd] * alpha; \
                _Pragma("unroll") for (int i = 0; i < 16; ++i) { s0[i] -= d; s1[i] -= d; } } \
            f32x2 psv; psv.x = 0.f; psv.y = 0.f; \
            bf16x8 pf[2][2]; \
            ATT_QX(s0, 0, 0, 8); ATT_QC(s0, 0, 0); \
            __builtin_amdgcn_sched_barrier(0); \
            if (NDV == 4) { \
                  \
                o[0] = MFMA32(vq[0][0], pf[0][0], o[0]); o[1] = MFMA32(vq[0][1], pf[0][0], o[1]); __builtin_amdgcn_sched_barrier(0); ATT_QX(s0, 1, 0, 4); __builtin_amdgcn_sched_barrier(0); \
                o[2] = MFMA32(vq[0][2], pf[0][0], o[2]); o[3] = MFMA32(vq[0][3], pf[0][0], o[3]); __builtin_amdgcn_sched_barrier(0); ATT_QX(s0, 1, 4, 8); ATT_QC(s0, 0, 1); __builtin_amdgcn_sched_barrier(0); \
                _Pragma("unroll") for (int d = 0; d < 4; ++d) vq[0][d] = ATT_VFRAG(d, 1, 0); \
                __builtin_amdgcn_sched_barrier(0); \
                o[0] = MFMA32(vq[1][0], pf[0][1], o[0]); o[1] = MFMA32(vq[1][1], pf[0][1], o[1]); __builtin_amdgcn_sched_barrier(0); ATT_QX(s1, 0, 0, 4); __builtin_amdgcn_sched_barrier(0); \
                o[2] = MFMA32(vq[1][2], pf[0][1], o[2]); o[3] = MFMA32(vq[1][3], pf[0][1], o[3]); __builtin_amdgcn_sched_barrier(0); ATT_QX(s1, 0, 4, 8); ATT_QC(s1, 1, 0); __builtin_amdgcn_sched_barrier(0); \
                _Pragma("unroll") for (int d = 0; d < 4; ++d) vq[1][d] = ATT_VFRAG(d, 1, 1); \
                __builtin_amdgcn_sched_barrier(0); \
                o[0] = MFMA32(vq[0][0], pf[1][0], o[0]); o[1] = MFMA32(vq[0][1], pf[1][0], o[1]); __builtin_amdgcn_sched_barrier(0); ATT_QX(s1, 1, 0, 4); __builtin_amdgcn_sched_barrier(0); \
                o[2] = MFMA32(vq[0][2], pf[1][0], o[2]); o[3] = MFMA32(vq[0][3], pf[1][0], o[3]); __builtin_amdgcn_sched_barrier(0); ATT_QX(s1, 1, 4, 8); ATT_QC(s1, 1, 1); __builtin_amdgcn_sched_barrier(0); \
                o[0] = MFMA32(vq[1][0], pf[1][1], o[0]); o[1] = MFMA32(vq[1][1], pf[1][1], o[1]); o[2] = MFMA32(vq[1][2], pf[1][1], o[2]); o[3] = MFMA32(vq[1][3], pf[1][1], o[3]); \
            } else { \
                o[0] = MFMA32(vf[0][0][0], pf[0][0], o[0]); __builtin_amdgcn_sched_barrier(0); ATT_QX(s0, 1, 0, 4); __builtin_amdgcn_sched_barrier(0); \
                o[1] = MFMA32(vf[1][0][0], pf[0][0], o[1]); __builtin_amdgcn_sched_barrier(0); ATT_QX(s0, 1, 4, 8); ATT_QC(s0, 0, 1); __builtin_amdgcn_sched_barrier(0); \
                o[0] = MFMA32(vf[0][0][1], pf[0][1], o[0]); __builtin_amdgcn_sched_barrier(0); ATT_QX(s1, 0, 0, 4); __builtin_amdgcn_sched_barrier(0); \
                o[1] = MFMA32(vf[1][0][1], pf[0][1], o[1]); __builtin_amdgcn_sched_barrier(0); ATT_QX(s1, 0, 4, 8); ATT_QC(s1, 1, 0); __builtin_amdgcn_sched_barrier(0); \
                o[0] = MFMA32(vf[0][1][0], pf[1][0], o[0]); __builtin_amdgcn_sched_barrier(0); ATT_QX(s1, 1, 0, 4); __builtin_amdgcn_sched_barrier(0); \
                o[1] = MFMA32(vf[1][1][0], pf[1][0], o[1]); __builtin_amdgcn_sched_barrier(0); ATT_QX(s1, 1, 4, 8); ATT_QC(s1, 1, 1); __builtin_amdgcn_sched_barrier(0); \
                o[0] = MFMA32(vf[0][1][1], pf[1][1], o[0]); o[1] = MFMA32(vf[1][1][1], pf[1][1], o[1]); \
            } \
            lsum += psv.x + psv.y; \
            __syncthreads(); } while (0)

    int pb = 0;
    bf16x8 qf[NST];
    if (cid < NU) { ATT_DECL(cu); ATT_DECODE(cid, cu); ATT_QLOAD(qf, cu); ATT_ISSUE(cu, 0, 0); __syncthreads(); }
    for (int U = cid; U < NU; U += G) {
        ATT_DECL(cu); ATT_DECODE(U, cu);
        const int nt = cunt, qrow = cuqrow, ocol = cuocol;
        float m = 0.f, lsum = 0.f;
        if (KIND == 0) { m = P.sink[cuhd * 4 + (w >> 1)] * LOG2E; lsum = hh == 0 ? 1.f : 0.f; }
        f32x16 o[NDV];
#pragma unroll
        for (int d = 0; d < NDV; ++d)
#pragma unroll
            for (int i = 0; i < 16; ++i) o[d][i] = 0.f;
        for (int tt = 0; tt < nt - 1; ++tt) ATT_TILE(tt, 0);
        ATT_TILE(nt - 1, 1);
        pb = (nt + pb) & 1;
        const float inv = 1.f / (xor32_sum(lsum));
        if (KIND != 2) {
#pragma unroll
            for (int d = 0; d < NDV; ++d)
#pragma unroll
                for (int g4 = 0; g4 < 4; ++g4) {
                    u32x2 wv; wv.x = cvt_pk_bf16(o[d][4 * g4] * inv, o[d][4 * g4 + 1] * inv); wv.y = cvt_pk_bf16(o[d][4 * g4 + 2] * inv, o[d][4 * g4 + 3] * inv);
                    *(u32x2*)(P.O + (size_t)qrow * 1024 + ocol + 32 * d + 8 * g4 + 4 * hh) = wv;
                }
        } else {
            LAS float* scr = (LAS float*)(lds + SCR) + (size_t)(w & 3) * 64 * 64 + lane;
            if (w >= 4) {
#pragma unroll
                for (int d = 0; d < NDV; ++d)
#pragma unroll
                    for (int i = 0; i < 16; ++i) scr[(d * 16 + i) * 64] = o[d][i] * inv;
            }
            __syncthreads();
            if (w < 4) {
                float ss = 0.f;
#pragma unroll
                for (int d = 0; d < NDV; ++d)
#pragma unroll
                    for (int i = 0; i < 16; ++i) { const float v = o[d][i] * inv - lam * scr[(d * 16 + i) * 64]; o[d][i] = v; ss += v * v; }
                ss = xor32_sum(ss);
                const float rsn = (1.f - P.lambda_init) / sqrtf(ss * (1.f / 128.f) + RMS_EPS);
#pragma unroll
                for (int d = 0; d < NDV; ++d)
#pragma unroll
                    for (int g4 = 0; g4 < 4; ++g4) {
                        const int dv0 = 32 * d + 8 * g4 + 4 * hh; const f32x4 gv = *(const f32x4*)(P.subln + dv0);
                        u32x2 wv; wv.x = cvt_pk_bf16(o[d][4 * g4] * rsn * gv[0], o[d][4 * g4 + 1] * rsn * gv[1]); wv.y = cvt_pk_bf16(o[d][4 * g4 + 2] * rsn * gv[2], o[d][4 * g4 + 3] * rsn * gv[3]);
                        *(u32x2*)(P.O + (size_t)qrow * 1024 + ocol + dv0) = wv;
                    }
            }
        }
    }
#undef ATT_DECL
#undef ATT_COPY
#undef ATT_DECODE
#undef ATT_TILE_KT
#undef ATT_ISSUE
#undef ATT_QLOAD
#undef ATT_TILE
}
}
namespace thin {
__device__ __forceinline__ int sig64(int p) { return (p >> 5) * 32 + ((p & 31) >> 1) + 16 * (p & 1); }
__device__ __forceinline__ int sig32(int p) { return (p >> 4) * 16 + ((p & 15) >> 1) + 8 * (p & 1); }
__device__ __forceinline__ int src_col(int mode, int lim, int n, bool& second) {
    second = false;
    switch (mode) {
        case 1: return n < lim ? (n & ~63) + sig64(n & 63) : n;
        case 2: return n < 768 ? n : (n < 800 ? 768 + sig32(n - 768) : -1);
        case 3: { const int hq = n / 96, w = n % 96; return w < 64 ? n : hq * 96 + 64 + sig32(w - 64); }
        case 4: return n < 1024 ? (n >> 6) * 128 + (n & 63) : ((n - 1024) >> 6) * 128 + 64 + (n & 63);
        case 5: second = (n & 7) >= 4; return 4 * (n >> 3) + (n & 3);
        default: return n;
    }
}
__device__ __forceinline__ void conv_item(const float* src, const float* src2, const float* gain, int Nsrc, int K, int N, int mode, int lim, bf16_t* WT, int item, LAS float* scr, int lane) {
    const int nblk = N >> 6, kb = item / nblk, nb = item % nblk, k0 = kb * 64, n0 = nb * 64;
    bool second; const int col = src_col(mode, lim, n0 + lane, second);
    const float* sp = (second ? src2 : src) + (col < 0 ? 0 : col);
    float vv[64];
#pragma unroll
    for (int kk = 0; kk < 64; ++kk) vv[kk] = col < 0 ? 0.f : __builtin_nontemporal_load(sp + (size_t)(k0 + kk) * Nsrc);
    if (gain) {
#pragma unroll
        for (int kk = 0; kk < 64; ++kk) vv[kk] *= gain[k0 + kk];
    }
#pragma unroll
    for (int kk = 0; kk < 64; ++kk) scr[kk * 65 + lane] = vv[kk];
    asm volatile("s_waitcnt lgkmcnt(0)" ::: "memory");
    const int c = lane & 7;
#pragma unroll
    for (int j = 0; j < 8; ++j) { const int n = (lane >> 3) + 8 * j; const LAS float* s = scr + (8 * c) * 65 + n;
        u32x4 o; o.x = cvt_pk_bf16(s[0 * 65], s[1 * 65]); o.y = cvt_pk_bf16(s[2 * 65], s[3 * 65]); o.z = cvt_pk_bf16(s[4 * 65], s[5 * 65]); o.w = cvt_pk_bf16(s[6 * 65], s[7 * 65]);
        __builtin_nontemporal_store(o, (u32x4*)(WT + (size_t)(n0 + n) * K + k0 + 8 * c)); }
    asm volatile("s_waitcnt lgkmcnt(0)" ::: "memory");
}
constexpr int MOE_ITEMS = NE * 256 + NE * 128;
__device__ __forceinline__ void moe_fill(LAS unsigned char* lds, const float* w_gate, const float* w_up, const float* w_down, unsigned char* ws, int layer, int max_items, int* qctr) {
    int tid_ = threadIdx.x; asm volatile("" : "+v"(tid_));
    const int lane = tid_ & 63, w = __builtin_amdgcn_readfirstlane(tid_ >> 6);
    LAS float* scr = (LAS float*)lds + w * (64 * 65);
    for (int n = 0; n < max_items; ++n) {
        int it = 0; if (lane == 0) it = atomicAdd(qctr, 1);
        it = __builtin_amdgcn_readfirstlane(it);
        if (it >= MOE_ITEMS) break;
        if (it < NE * 256) { const int mi = layer * NE + (it >> 8), ii = it & 255;
            conv_item(w_gate + (size_t)mi * 1024 * 512, w_up + (size_t)mi * 1024 * 512, nullptr, 512, 1024, 1024, 5, 0, (bf16_t*)(ws + WS_WGU) + (size_t)mi * 1024 * 1024, ii, scr, lane); }
        else { const int r = it - NE * 256, mi = layer * NE + (r >> 7), ii = r & 127;
            conv_item(w_down + (size_t)mi * 512 * 1024, nullptr, nullptr, 1024, 512, 1024, 0, 0, (bf16_t*)(ws + WS_WD) + (size_t)mi * 1024 * 512, ii, scr, lane); }
    }
}
struct ProIn {
    const float *c, *c_ctx, *ada_w, *ada_b, *win_w_in, *win_w_out, *mla_w_in, *mla_q_norm, *mla_kv_norm, *mla_w_uq, *mla_w_ukv, *mla_w_out, *dif_w_in, *dif_w_out,
                *moe_w_grp, *moe_w_rt, *moe_w_gate, *moe_w_up, *moe_w_down;
    unsigned char* ws;
};
__device__ __forceinline__ void prologue(LAS unsigned char* lds, const ProIn& I, int G, int cid) {
    const int tid = threadIdx.x, lane = tid & 63, w = __builtin_amdgcn_readfirstlane(tid >> 6);
    unsigned char* ws = I.ws;
    {
        LAS float* scr = (LAS float*)lds + w * (64 * 65);
        const int gw = cid * NWAVES + w, NGW = G * NWAVES;
        constexpr int I_AIN = 16 * 24, I_SQ = 16 * 16, I_BUQ = 8 * 24, I_BUKV = 4 * 32, I_CIN = 16 * 48, I_GU = 16 * 16, I_D = 8 * 16;
        constexpr int NSMALL = 2 * I_AIN + 2 * I_SQ + I_SQ + I_BUQ + I_BUKV + I_SQ + I_CIN + I_SQ;
        constexpr int NITEMS = NSMALL + 128 * I_GU + 128 * I_D;
        for (int it = gw; it < NITEMS; it += NGW) {
            int r = it;
            if (r >= NSMALL) {
                r -= NSMALL;
                if (r < 128 * I_GU) { const int mi = r / I_GU, ii = r % I_GU;
                    conv_item(I.moe_w_gate + (size_t)mi * 1024 * 512, I.moe_w_up + (size_t)mi * 1024 * 512, nullptr, 512, 1024, 1024, 5, 0, (bf16_t*)(ws + WS_WGU) + (size_t)mi * 1024 * 1024, ii, scr, lane); }
                else { r -= 128 * I_GU; const int mi = r / I_D, ii = r % I_D;
                    conv_item(I.moe_w_down + (size_t)mi * 512 * 1024, nullptr, nullptr, 1024, 512, 1024, 0, 0, (bf16_t*)(ws + WS_WD) + (size_t)mi * 1024 * 512, ii, scr, lane); }
                continue;
            }
            if (r < 2 * I_AIN) { const int s = r / I_AIN; conv_item(I.win_w_in + (size_t)s * 1024 * 1536, nullptr, nullptr, 1536, 1024, 1536, 1, 1280, (bf16_t*)(ws + W_A_IN) + (size_t)s * 1536 * 1024, r % I_AIN, scr, lane); continue; } r -= 2 * I_AIN;
            if (r < 2 * I_SQ) { const int s = r / I_SQ; conv_item(I.win_w_out + (size_t)s * 1024 * 1024, nullptr, nullptr, 1024, 1024, 1024, 0, 0, (bf16_t*)(ws + W_A_OUT) + (size_t)s * 1024 * 1024, r % I_SQ, scr, lane); continue; } r -= 2 * I_SQ;
            if (r < I_SQ) { conv_item(I.mla_w_in, nullptr, nullptr, 800, 1024, 1024, 2, 0, (bf16_t*)(ws + W_B_IN), r, scr, lane); continue; } r -= I_SQ;
            if (r < I_BUQ) { conv_item(I.mla_w_uq, nullptr, I.mla_q_norm, 1536, 512, 1536, 3, 0, (bf16_t*)(ws + W_B_UQ), r, scr, lane); continue; } r -= I_BUQ;
            if (r < I_BUKV) { conv_item(I.mla_w_ukv, nullptr, I.mla_kv_norm, 2048, 256, 2048, 4, 0, (bf16_t*)(ws + W_B_UKV), r, scr, lane); continue; } r -= I_BUKV;
            if (r < I_SQ) { conv_item(I.mla_w_out, nullptr, nullptr, 1024, 1024, 1024, 0, 0, (bf16_t*)(ws + W_B_OUT), r, scr, lane); continue; } r -= I_SQ;
            if (r < I_CIN) { conv_item(I.dif_w_in, nullptr, nullptr, 3072, 1024, 3072, 1, 2048, (bf16_t*)(ws + W_C_IN), r, scr, lane); continue; } r -= I_CIN;
            conv_item(I.dif_w_out, nullptr, nullptr, 1024, 1024, 1024, 0, 0, (bf16_t*)(ws + W_C_OUT), r, scr, lane);
        }
    }
    __syncthreads();
    {
        LAS float* sc = (LAS float*)lds;
        LAS float* red = sc + 9 * 1024;
        for (int idx = tid; idx < 9 * 1024; idx += NTHREADS) { const int m = idx >> 10, k = idx & 1023; const float v = m < 8 ? I.c[m * 1024 + k] : I.c_ctx[k]; sc[idx] = v / (1.f + expf(-v)); }
        __syncthreads();
        float* mod = (float*)(ws + WS_MOD);
        for (int task = cid; task < DEPTH * 96; task += G) {
            const int layer = task / 96, j = (task % 96) * 64 + lane;
            float acc[9];
#pragma unroll
            for (int m = 0; m < 9; ++m) acc[m] = 0.f;
            const float* wp = I.ada_w + ((size_t)layer * 1024 + w * 128) * 6144 + j;
#pragma unroll 32
            for (int k = 0; k < 128; ++k) { const float wv = wp[(size_t)k * 6144];
#pragma unroll
                for (int m = 0; m < 9; ++m) acc[m] = fmaf(sc[m * 1024 + w * 128 + k], wv, acc[m]); }
#pragma unroll
            for (int m = 0; m < 9; ++m) red[(w * 9 + m) * 64 + lane] = acc[m];
            __syncthreads();
            for (int o = tid; o < 9 * 64; o += NTHREADS) { const int m = o >> 6, jl = o & 63; float s = 0.f;
#pragma unroll
                for (int ww = 0; ww < 8; ++ww) s += red[(ww * 9 + m) * 64 + jl];
                const int jj = (task % 96) * 64 + jl; mod[((size_t)layer * 9 + m) * 6144 + jj] = s + I.ada_b[layer * 6144 + jj]; }
            __syncthreads();
        }
    }
    {
        const int gt = cid * NTHREADS + tid, NGT = G * NTHREADS;
        float2* tab64 = (float2*)(ws + WS_TAB64); float2* tab32 = (float2*)(ws + WS_TAB32);
        for (int t = gt; t < 64 * 16 + 64 * 8; t += NGT) {
            if (t < 1024) { const int pos = t >> 4, j = t & 15; const float inv = (float)pow(10000.0, -(double)(2 * j) / 32.0), ang = (float)pos * inv;
                tab64[t] = make_float2((float)cos((double)ang), (float)sin((double)ang)); }
            else { const int u = t - 1024, pos = u >> 3, j = u & 7; const float inv = (float)pow(10000.0, -(double)(2 * j) / 16.0), ang = (float)pos * inv;
                tab32[u] = make_float2((float)cos((double)ang), (float)sin((double)ang)); }
        }
        bf16_t* rtw = (bf16_t*)(ws + WS_RTW);
        for (int t = gt; t < DEPTH * 64 * 1024; t += NGT) {
            const int layer = t >> 16, n = (t >> 10) & 63, k = t & 1023;
            float v = 0.f;
            if (n < 4) v = I.moe_w_grp[((size_t)layer * 1024 + k) * 4 + n]; else if (n < 36) v = I.moe_w_rt[((size_t)layer * 1024 + k) * 32 + (n - 4)];
            const unsigned hi = f2bf(v); const unsigned lo = f2bf(v - bf2f(hi));
            rtw[((size_t)layer * 2 + 0) * 65536 + n * 1024 + k] = (bf16_t)hi; rtw[((size_t)layer * 2 + 1) * 65536 + n * 1024 + k] = (bf16_t)lo;
        }
    }
}
__device__ __forceinline__ void phase_h0(const float* x, const float* ctx, const float* mod0, bf16_t* H, int G, int cid) {
    const int lane = threadIdx.x & 63, gw = cid * NWAVES + (threadIdx.x >> 6), NGW = G * NWAVES;
    for (int row0 = gw * 2; row0 < T; row0 += NGW * 2) {
        const float* src = row0 < TL ? x + (size_t)row0 * 1024 : ctx + (size_t)(row0 - TL) * 1024; const float* mp = mod0 + (size_t)mrow_of(row0) * 6144;
        f32x4 v[2][4];
#pragma unroll
        for (int rr = 0; rr < 2; ++rr)
#pragma unroll
            for (int i = 0; i < 4; ++i) v[rr][i] = *(const f32x4*)(src + rr * 1024 + i * 256 + lane * 4);
#pragma unroll
        for (int rr = 0; rr < 2; ++rr)
#pragma unroll
            for (int i = 0; i < 4; ++i) { const int c = i * 256 + lane * 4;
                const f32x4 sh = *(const f32x4*)(mp + c), sc = *(const f32x4*)(mp + 1024 + c);
                const f32x4 h = v[rr][i] * (sc + 1.f) + sh; u32x2 wv; wv.x = cvt_pk_bf16(h[0], h[1]); wv.y = cvt_pk_bf16(h[2], h[3]);
                *(u32x2*)(H + (size_t)(row0 + rr) * 1024 + c) = wv; }
    }
}
constexpr int CNT_STRIDE = 64;
struct LnrArgs { const float* Xl; const float* Xc; const bf16_t* Y; float* STATS; bf16_t* H; const float* modl; const float* gam; const float* bet; const bf16_t* rtw; const float* b_grp; const float* b_rt; int* cnt; int* list; float* tokw; int nrows; };
#define LBAR() do { asm volatile("s_waitcnt lgkmcnt(0)" ::: "memory"); __builtin_amdgcn_s_barrier(); asm volatile("" ::: "memory"); } while (0)
template <int VAR = 0, bool XBF = false>
__device__ __forceinline__ void phase_lnr(LAS unsigned char* lds, const LnrArgs A, int G, int cid) {
    asm volatile("" : "+s"(G), "+s"(cid));
    constexpr int TSTR = 2064;
    int tid_ = threadIdx.x; asm volatile("" : "+v"(tid_));
    const int tid = tid_, lane = tid & 63, w = __builtin_amdgcn_readfirstlane(tid >> 6), r = lane & 31, hh = lane >> 5;
    LAS unsigned char* THI = lds; LAS unsigned char* TLO = lds + 32 * TSTR;
    LAS float* PART = (LAS float*)lds;

    LAS int* bcnt = (LAS int*)(lds + 2 * 32 * TSTR);
    LAS int* bbase = bcnt + 32;
    LAS float* bias = (LAS float*)(bbase + 32);
    LAS int* ents = (LAS int*)(bias + 40);
    LAS float* LOG = (LAS float*)(ents + 16 * 64 * 2);
    const int ngroups = A.nrows >> 5;
    const int nfull = (ngroups / G) * G, rem = ngroups - nfull; const bool halves = rem > 0 && 2 * rem <= G;
    const int nitems = halves ? nfull + 2 * rem : ngroups;
#define LNR_ITEM(j, grp_, h_, nr_) const int grp_ = (j) < nfull || !halves ? (j) : nfull + (((j) - nfull) >> 1); const int h_ = (j) < nfull || !halves ? 0 : (((j) - nfull) & 1); const int nr_ = (j) < nfull || !halves ? 32 : 16
    if (tid < 32) bcnt[tid] = 0;
    if (tid < 36) bias[tid] = tid < 4 ? A.b_grp[tid] : A.b_rt[tid - 4];
    f32x4 z[4][4]; u32x2 zr[4][4]; u32x2 yv[4][4];
#define LNR_LOAD(j_) do { LNR_ITEM(j_, g__, h__, n__); _Pragma("unroll") for (int t4 = 0; t4 < 4; ++t4) { const int tl_ = 4 * w + t4; const int row_ = g__ * 32 + h__ * 16 + (tl_ < n__ ? tl_ : tl_ - 16); \
        const float* xs_ = row_ < TL ? A.Xl + (size_t)row_ * 1024 : A.Xc + (size_t)(row_ - TL) * 1024; \
        const bf16_t* xb_ = row_ < TL ? (const bf16_t*)A.Xl + (size_t)row_ * 1024 : (const bf16_t*)A.Xc + (size_t)(row_ - TL) * 1024; \
        _Pragma("unroll") for (int i = 0; i < 4; ++i) { if (XBF) zr[t4][i] = *(const u32x2*)(xb_ + i * 256 + lane * 4); else z[t4][i] = *(const f32x4*)(xs_ + i * 256 + lane * 4); \
            yv[t4][i] = *(const u32x2*)(A.Y + (size_t)row_ * 1024 + i * 256 + lane * 4); } } } while (0)
    if (cid < nitems) LNR_LOAD(cid);
    int gi = 0;
    for (int item = cid; item < nitems; item += G, ++gi) {
        LNR_ITEM(item, grp, hsel, nrow);
#pragma unroll
        for (int t4 = 0; t4 < 4; ++t4) {
            const int tl = 4 * w + t4, row = grp * 32 + hsel * 16 + (tl < nrow ? tl : tl - 16); const bool rvalid = tl < nrow; const float* mp = A.modl + (size_t)mrow_of(row) * 6144;
            float s = 0.f, q = 0.f;
            if (XBF) {
#pragma unroll
                for (int i = 0; i < 4; ++i) { const u32x2 xr = zr[t4][i]; z[t4][i][0] = f16lo(xr.x); z[t4][i][1] = f16hi(xr.x); z[t4][i][2] = f16lo(xr.y); z[t4][i][3] = f16hi(xr.y); }
            }
#pragma unroll
            for (int i = 0; i < 4; ++i) { const int c = i * 256 + lane * 4; const f32x4 gv = *(const f32x4*)(mp + 2 * 1024 + c); const u32x2 yb = yv[t4][i];
                f32x4 y; y[0] = bf2f(yb.x & 0xffffu); y[1] = bf2f(yb.x >> 16); y[2] = bf2f(yb.y & 0xffffu); y[3] = bf2f(yb.y >> 16);
                const f32x4 v = z[t4][i] * DN_ALPHA + gv * y; z[t4][i] = v; s += (v[0] + v[1]) + (v[2] + v[3]); q += (v[0] * v[0] + v[1] * v[1]) + (v[2] * v[2] + v[3] * v[3]); }
            wave_sum2(s, q);
            const float mean = s * (1.f / 1024.f); const float var = fmaxf(q * (1.f / 1024.f) - mean * mean, 0.f);
            const float rstd = 1.0f / sqrtf(var + LN_EPS);
            if (lane == 0 && rvalid) *(f32x2*)(A.STATS + (size_t)row * 2) = (f32x2){mean, rstd};
#pragma unroll
            for (int i = 0; i < 4; ++i) { const int c = i * 256 + lane * 4;
                const f32x4 xo = (z[t4][i] - mean) * rstd * *(const f32x4*)(A.gam + c) + *(const f32x4*)(A.bet + c);
                const f32x4 h = xo * (*(const f32x4*)(mp + 4 * 1024 + c) + 1.f) + *(const f32x4*)(mp + 3 * 1024 + c);
                u32x2 hi; hi.x = cvt_pk_bf16(h[0], h[1]); hi.y = cvt_pk_bf16(h[2], h[3]);
                if (rvalid) *(u32x2*)(A.H + (size_t)row * 1024 + c) = hi;
                f32x4 rem; rem[0] = h[0] - bf2f(hi.x & 0xffffu); rem[1] = h[1] - bf2f(hi.x >> 16); rem[2] = h[2] - bf2f(hi.y & 0xffffu); rem[3] = h[3] - bf2f(hi.y >> 16);
                u32x2 lo; lo.x = cvt_pk_bf16(rem[0], rem[1]); lo.y = cvt_pk_bf16(rem[2], rem[3]);
                *(LAS u32x2*)(THI + tl * TSTR + c * 2) = hi; *(LAS u32x2*)(TLO + tl * TSTR + c * 2) = lo; }
        }
        LBAR();
        if (VAR == 1) { if (item + G < nitems) LNR_LOAD(item + G); continue; }
        f32x16 acc, acc2, acc3;
#pragma unroll
        for (int i = 0; i < 16; ++i) { acc[i] = 0.f; acc2[i] = 0.f; acc3[i] = 0.f; }
        { const int ct = w & 1, ks = w >> 1; const bf16_t* bh = A.rtw + (size_t)(ct * 32 + r) * 1024 + ks * 256 + 8 * hh; const bf16_t* bl = bh + 65536;
          bf16x8 wh[16], wl[16];
#pragma unroll
          for (int st = 0; st < 16; ++st) { wh[st] = *(const bf16x8*)(bh + 16 * st); wl[st] = *(const bf16x8*)(bl + 16 * st); }
#pragma unroll
          for (int st = 0; st < 16; ++st) {
              const bf16x8 ah = *(const LAS bf16x8*)(THI + r * TSTR + (ks * 256 + 16 * st + 8 * hh) * 2), al = *(const LAS bf16x8*)(TLO + r * TSTR + (ks * 256 + 16 * st + 8 * hh) * 2);
              acc = MFMA32(ah, wh[st], acc); acc2 = MFMA32(ah, wl[st], acc2); acc3 = MFMA32(al, wh[st], acc3);
          }
          acc = acc + acc2 + acc3; }
        if (item + G < nitems) LNR_LOAD(item + G);
        LBAR();
#pragma unroll
        for (int i = 0; i < 16; ++i) PART[(w * 32 + (i & 3) + 8 * (i >> 2) + 4 * hh) * 33 + r] = acc[i];
        LBAR();
        for (int o = tid; o < 32 * 36; o += NTHREADS) { const int tk = o / 36, n = o % 36, ct = n >> 5, nl = n & 31;
            float s = 0.f;
#pragma unroll
            for (int ks = 0; ks < 4; ++ks) s += PART[((ks * 2 + ct) * 32 + tk) * 33 + nl];
            LOG[tk * 40 + n] = s + bias[n]; }
        LBAR();
        if (VAR != 2 && tid < nrow) {
            const LAS float* lg = LOG + tid * 40; const int row = grp * 32 + hsel * 16 + tid;
            const float g0 = lg[0], g1 = lg[1], g2 = lg[2], g3 = lg[3];
            int gs = 0; float gm = g0;
            if (g1 > gm) { gm = g1; gs = 1; } if (g2 > gm) { gm = g2; gs = 2; } if (g3 > gm) { gm = g3; gs = 3; }
            const float pg = 1.f / (expf(g0 - gm) + expf(g1 - gm) + expf(g2 - gm) + expf(g3 - gm));
            int i1 = 0; float v1 = lg[4 + gs * 8];
            for (int j = 1; j < 8; ++j) { const float v = lg[4 + gs * 8 + j]; if (v > v1) { v1 = v; i1 = j; } }
            int i2 = -1; float v2 = -INFINITY;
            for (int j = 0; j < 8; ++j) { const float v = lg[4 + gs * 8 + j]; if (j != i1 && v > v2) { v2 = v; i2 = j; } }
            const int ea = gs * 8 + i1, eb = gs * 8 + i2;
            const int ra = __hip_atomic_fetch_add(bcnt + ea, 1, __ATOMIC_RELAXED, __HIP_MEMORY_SCOPE_WORKGROUP), rb = __hip_atomic_fetch_add(bcnt + eb, 1, __ATOMIC_RELAXED, __HIP_MEMORY_SCOPE_WORKGROUP);
            const float e2 = expf(v2 - v1), w1 = pg / (1.f + e2), w2 = pg * e2 / (1.f + e2);
            *(f32x2*)(A.tokw + (size_t)row * 2) = (f32x2){w1, w2};
            LAS int* ep = ents + (gi * 64 + tid * 2) * 2;
            ep[0] = (ea << 16) | ra; ep[1] = row * 2; ep[2] = (eb << 16) | rb; ep[3] = row * 2 + 1;
        } else if (VAR != 2 && tid < 32) {
            LAS int* ep = ents + (gi * 64 + tid * 2) * 2; ep[0] = -1; ep[2] = -1;
        }
    }
#undef LNR_LOAD
#undef LNR_ITEM
    if (tid < 32) { const int n = bcnt[tid]; bbase[tid] = n ? atomicAdd(&A.cnt[tid * CNT_STRIDE], n) : 0; }
    __syncthreads();
    if (VAR == 0) for (int i = tid; i < gi * 64; i += NTHREADS) { const int key = ents[2 * i], val = ents[2 * i + 1], e = key >> 16; if (key >= 0) A.list[(size_t)e * T + bbase[e] + (key & 0xffff)] = val; }
    __syncthreads();
}
struct LnfArgs { const float* Xl; const float* Xc; const bf16_t* Y; const float* STATS; const bf16_t* Y2; const float* modl; const float* gam1; const float* bet1; const float* gam; const float* bet; float* Xout; bf16_t* H; const float* modn; int nrows; };
template <bool XINBF = false, bool XOUTBF = false>
__device__ __forceinline__ void phase_lnf(const LnfArgs A, int G, int cid) {
    asm volatile("" : "+s"(G), "+s"(cid));
    int tid_ = threadIdx.x; asm volatile("" : "+v"(tid_));
    const int lane = tid_ & 63, gw = cid * NWAVES + (tid_ >> 6), NGW = G * NWAVES;
#define LNF_DECL(S) f32x4 S##z[2][4]; u32x2 S##zr[2][4], S##yv[2][4], S##ya[2][4], S##yb[2][4]; f32x2 S##st[2]
#define LNF_LOAD(S, R0) do { const int r0_ = (R0); \
        const float* xs = r0_ < TL ? A.Xl + (size_t)r0_ * 1024 : A.Xc + (size_t)(r0_ - TL) * 1024; \
        const bf16_t* xb = r0_ < TL ? (const bf16_t*)A.Xl + (size_t)r0_ * 1024 : (const bf16_t*)A.Xc + (size_t)(r0_ - TL) * 1024; \
        _Pragma("unroll") for (int rr = 0; rr < 2; ++rr) { \
            S##st[rr] = *(const f32x2*)(A.STATS + (size_t)(r0_ + rr) * 2); \
            _Pragma("unroll") for (int i = 0; i < 4; ++i) { const int c = i * 256 + lane * 4; const size_t row = (size_t)(r0_ + rr); \
                if (XINBF) S##zr[rr][i] = *(const u32x2*)(xb + rr * 1024 + c); else S##z[rr][i] = *(const f32x4*)(xs + rr * 1024 + c); \
                S##yv[rr][i] = *(const u32x2*)(A.Y + row * 1024 + c); \
                S##ya[rr][i] = *(const u32x2*)(A.Y2 + row * 2048 + c); S##yb[rr][i] = *(const u32x2*)(A.Y2 + row * 2048 + 1024 + c); } } } while (0)
#define LNF_COMPUTE(S, R0) do { const int r0_ = (R0); \
        const int mr = mrow_of(r0_); const float* gm = A.modl + (size_t)mr * 6144 + 2 * 1024; const float* gf = A.modl + (size_t)mr * 6144 + 5 * 1024;        \
          \
        f32x4 pg1[4], pg2[4], pa1[4], pb1[4], pa[4], pb[4], psc[4], psh[4]; \
        _Pragma("unroll") for (int i = 0; i < 4; ++i) { const int c = i * 256 + lane * 4; \
            pg1[i] = *(const f32x4*)(gm + c); pg2[i] = *(const f32x4*)(gf + c); pa1[i] = *(const f32x4*)(A.gam1 + c); pb1[i] = *(const f32x4*)(A.bet1 + c); \
            pa[i] = *(const f32x4*)(A.gam + c); pb[i] = *(const f32x4*)(A.bet + c); \
            if (XINBF && A.H) { const float* mp = A.modn + (size_t)mr * 6144; psc[i] = *(const f32x4*)(mp + 1024 + c); psh[i] = *(const f32x4*)(mp + c); } } \
        __builtin_amdgcn_sched_barrier(0); \
        _Pragma("unroll") for (int rr = 0; rr < 2; ++rr) { \
            const size_t row = (size_t)(r0_ + rr); \
            f32x4 zz[4]; float s = 0.f, q = 0.f; \
            _Pragma("unroll") for (int i = 0; i < 4; ++i) { \
                const u32x2 y1 = S##yv[rr][i], a = S##ya[rr][i], b = S##yb[rr][i]; \
                f32x4 xin; if (XINBF) { const u32x2 xr = S##zr[rr][i]; xin[0] = f16lo(xr.x); xin[1] = f16hi(xr.x); xin[2] = f16lo(xr.y); xin[3] = f16hi(xr.y); } else xin = S##z[rr][i]; \
                f32x4 ym; ym[0] = bf2f(y1.x & 0xffffu); ym[1] = bf2f(y1.x >> 16); ym[2] = bf2f(y1.y & 0xffffu); ym[3] = bf2f(y1.y >> 16); \
                const f32x4 x1 = ((xin * DN_ALPHA + pg1[i] * ym) - S##st[rr][0]) * S##st[rr][1] * pa1[i] + pb1[i]; \
                f32x4 y; y[0] = bf2f(a.x & 0xffffu) + bf2f(b.x & 0xffffu); y[1] = bf2f(a.x >> 16) + bf2f(b.x >> 16); y[2] = bf2f(a.y & 0xffffu) + bf2f(b.y & 0xffffu); y[3] = bf2f(a.y >> 16) + bf2f(b.y >> 16); \
                const f32x4 v = x1 * DN_ALPHA + pg2[i] * y; zz[i] = v; s += (v[0] + v[1]) + (v[2] + v[3]); q += (v[0] * v[0] + v[1] * v[1]) + (v[2] * v[2] + v[3] * v[3]); } \
            wave_sum2(s, q); \
            const float mean = s * (1.f / 1024.f); const float var = fmaxf(q * (1.f / 1024.f) - mean * mean, 0.f); \
            const float rstd = 1.0f / sqrtf(var + LN_EPS); \
            _Pragma("unroll") for (int i = 0; i < 4; ++i) { const int c = i * 256 + lane * 4; \
                const f32x4 xo = (zz[i] - mean) * rstd * pa[i] + pb[i]; \
                if (XOUTBF) { u32x2 xw; xw.x = pack_f16(xo[0], xo[1]); xw.y = pack_f16(xo[2], xo[3]); *(u32x2*)((bf16_t*)A.Xout + row * 1024 + c) = xw; } \
                else *(f32x4*)(A.Xout + row * 1024 + c) = xo; \
                if (A.H) { const float* mp = A.modn + (size_t)mr * 6144; const f32x4 sc_ = XINBF ? psc[i] : *(const f32x4*)(mp + 1024 + c), sh_ = XINBF ? psh[i] : *(const f32x4*)(mp + c);        \
                    const f32x4 h = xo * (sc_ + 1.f) + sh_; \
                    u32x2 wv; wv.x = cvt_pk_bf16(h[0], h[1]); wv.y = cvt_pk_bf16(h[2], h[3]); *(u32x2*)(A.H + row * 1024 + c) = wv; } } } } while (0)
    const int stride = NGW * 2;
    LNF_DECL(c_);
    for (int row0 = gw * 2; row0 < A.nrows; row0 += stride) { LNF_LOAD(c_, row0); LNF_COMPUTE(c_, row0); }
}
#undef LNF_DECL
#undef LNF_LOAD
#undef LNF_COMPUTE
}
#ifndef PH_MASK
#define PH_MASK 0xFFFF
#endif
#define PH_EN(k) ((PH_MASK >> (k)) & 1)
#ifndef PH_REPM
#define PH_REPM 0
#endif
#define NREP(k) (((PH_REPM >> (k)) & 1) ? 2 : 1)
#ifndef ATT_PIPE_A
#define ATT_PIPE_A false
#endif
#ifndef ATT_PIPE_B
#define ATT_PIPE_B false
#endif
#ifndef ATT_PIPE_C
#define ATT_PIPE_C false
#endif
#ifndef ONE_LAUNCH
#define ONE_LAUNCH 1
#endif
constexpr int NPH = 2 + 8 * DEPTH;
struct Params { const float* in[30]; float* out; unsigned char* ws; int ph_lo, ph_hi; };

__global__ void __launch_bounds__(NTHREADS, 2) k_run(Params p) {
    extern __shared__ __attribute__((aligned(16))) unsigned char lds_raw[];
    LAS unsigned char* lds = (LAS unsigned char*)lds_raw;
    volatile LAS unsigned* MISC = (volatile LAS unsigned*)(lds + MISC_OFF);
    const int G = gridDim.x;
    const int cid = (G % 8 == 0) ? ((int)blockIdx.x % 8) * (G / 8) + (int)blockIdx.x / 8 : (int)blockIdx.x;
    typedef const __attribute__((address_space(4))) Params* KP;
    KP pp = (KP)__builtin_amdgcn_kernarg_segment_ptr();
    unsigned char* ws = p.ws;
    for (int u = threadIdx.x; u < 256; u += NTHREADS) MISC[u] = 0u;
    __syncthreads();
    const int lo = p.ph_lo, hi = p.ph_hi;
    XcdBarrier bar; bar.bar = (unsigned*)(ws + WS_CTL) + CW_BAR; bar.x = 0; bar.st = nullptr;
    if (hi - lo > 1) bar = xcd_barrier_post((unsigned*)(ws + WS_CTL) + CW_BAR, MISC + 8);
#define IN(k) (lo <= (k) && (k) < hi)
#define SEAM(k) do { if (IN(k) && IN((k) + 1)) { xcd_barrier(bar); if (NREP(15) == 2) xcd_barrier(bar); } } while (0)

    if (PH_EN(0) && IN(0)) {
        thin::ProIn I; I.c = p.in[1]; I.c_ctx = p.in[3]; I.ada_w = p.in[4]; I.ada_b = p.in[5]; I.win_w_in = p.in[10]; I.win_w_out = p.in[11];
        I.mla_w_in = p.in[13]; I.mla_q_norm = p.in[14]; I.mla_kv_norm = p.in[15]; I.mla_w_uq = p.in[16]; I.mla_w_ukv = p.in[17]; I.mla_w_out = p.in[18];
        I.dif_w_in = p.in[19]; I.dif_w_out = p.in[22]; I.moe_w_grp = p.in[23]; I.moe_w_rt = p.in[25]; I.moe_w_gate = p.in[27]; I.moe_w_up = p.in[28]; I.moe_w_down = p.in[29]; I.ws = ws;
        for (int rep = 0; rep < NREP(0); ++rep) { thin::prologue(lds, I, G, cid); __syncthreads(); }
    }
    SEAM(0);
    if (PH_EN(1) && IN(1)) for (int rep = 0; rep < NREP(1); ++rep) thin::phase_h0(p.in[0], p.in[2], (const float*)(ws + WS_MOD), (bf16_t*)(ws + WS_H), G, cid);
    SEAM(1);

#pragma unroll 1
    for (int li = 0; li < DEPTH; ++li) {
        asm volatile("" : "+s"(pp));
        { size_t zoff = 0; asm volatile("" : "+s"(zoff)); ws = pp->ws + zoff; }
        const int base = 2 + 8 * li, kind = li % 3, slot = li / 3; const bool last = li == DEPTH - 1;
        float* mod = (float*)(ws + WS_MOD);
        const float* tab64 = (const float*)(ws + WS_TAB64); const float* tab32 = (const float*)(ws + WS_TAB32);
        float* X = (float*)(ws + WS_X); bf16_t* H = (bf16_t*)(ws + WS_H); bf16_t* O = (bf16_t*)(ws + WS_O);
        unsigned char* R1 = ws + WS_R1;
        int* list = (int*)(ws + WS_LIST); float* tokw = (float*)(ws + WS_TOKW); float* SSQ = (float*)(ws + WS_SSQ);
        const float* modl = mod + (size_t)li * 9 * 6144;
        const int Mpost = last ? TL : T;
        int* cnt = (int*)(ws + WS_CTL) + CW_CNT + li * NE * 64;
#define IDLE_FILL(nunits, myid, budget) do { if (li + 1 < DEPTH) { const int nu_ = (nunits), R_ = (nu_ + G - 1) / G - 1; if (R_ * G + (myid) >= nu_) { \
            thin::moe_fill(lds, pp->in[27], pp->in[28], pp->in[29], ws, li + 1, (budget), (int*)(ws + WS_CTL) + CW_Q + 64 * (li + 1)); __syncthreads(); } } } while (0)
        if (IN(base + 0)) {
            if (PH_EN(2) && kind == 0) {
                pg8::Gemm g{H, (const bf16_t*)(ws + W_A_IN) + (size_t)slot * 1536 * 1024, 1024}; pg8::StaticOrder So; So.init(T, 1536, G, (int)blockIdx.x);
                epi::EpiQKV E{(bf16_t*)(R1 + R_QA), 1024, (bf16_t*)(R1 + R_KA), 256, (bf16_t*)(R1 + R_VTA), 4, 64, 4, 1, 0.125f * LOG2E, tab64};
                for (int rep = 0; rep < NREP(2); ++rep) pg8::gemm_phase<epi::EpiQKV, pg8::StaticOrder, true>(lds, g, So, E);
            } else if (PH_EN(3) && kind == 1) {
                pg8::Gemm g{H, (const bf16_t*)(ws + W_B_IN), 1024}; pg8::StaticOrder So; So.init(T, 1024, G, (int)blockIdx.x);
                epi::EpiB1 E{(bf16_t*)(R1 + R_CQ), (bf16_t*)(R1 + R_CKV), (bf16_t*)(R1 + R_KR), SSQ, tab32};
                for (int rep = 0; rep < NREP(3); ++rep) pg8::gemm_phase<epi::EpiB1, pg8::StaticOrder, true>(lds, g, So, E);
            } else if (PH_EN(4) && kind == 2) {
                pg8::Gemm g{H, (const bf16_t*)(ws + W_C_IN), 1024}; pg8::StaticOrder So; So.init(T, 3072, G, (int)blockIdx.x);
                epi::EpiQKV E{(bf16_t*)(R1 + R_QC), 1024, (bf16_t*)(R1 + R_KC), 1024, (bf16_t*)(R1 + R_VTC), 8, 128, 4, 4, 0.125f * LOG2E, tab64};
                for (int rep = 0; rep < NREP(4); ++rep) pg8::gemm_phase<epi::EpiQKV, pg8::StaticOrder, true>(lds, g, So, E);
            }
        }
        SEAM(base + 0);
        if (PH_EN(5) && IN(base + 1) && kind == 1) {
            { pg8::Gemm g{(const bf16_t*)(R1 + R_CQ), (const bf16_t*)(ws + W_B_UQ), 512}; pg8::StaticOrder So; So.init(T, 1536, G, (int)blockIdx.x);
              epi::EpiB2 E{(bf16_t*)(R1 + R_QB), SSQ, tab32, 0.10206207261596575f * LOG2E};
              for (int rep = 0; rep < NREP(5); ++rep) pg8::gemm_phase<epi::EpiB2, pg8::StaticOrder, true>(lds, g, So, E); }
            { pg8::Gemm g{(const bf16_t*)(R1 + R_CKV), (const bf16_t*)(ws + W_B_UKV), 256}; pg8::StaticOrder So; So.init(T, 2048, G, (int)blockIdx.x);
              epi::EpiB3 E{(bf16_t*)(R1 + R_KN), (bf16_t*)(R1 + R_VTB), SSQ};
              for (int rep = 0; rep < NREP(5); ++rep) pg8::gemm_phase<epi::EpiB3, pg8::StaticOrder, true>(lds, g, So, E); }
        }
        if (kind == 1) SEAM(base + 1);
#ifdef CLK_PROBE
        if (li == 1 && IN(base + 2)) {
            f32x16 c0; bf16x8 fa, fb;
#pragma unroll
            for (int i = 0; i < 16; ++i) c0[i] = 0.f;
#pragma unroll
            for (int i = 0; i < 8; ++i) { fa[i] = (short)(0x3c00 + tid + i); fb[i] = (short)(0x3d00 + i); }
#pragma unroll 1
            for (int it = 0; it < 16384 / 8; ++it) {
#pragma unroll
                for (int u = 0; u < 8; ++u) c0 = MFMA32(fa, fb, c0);
            }
            float sres = 0.f;
#pragma unroll
            for (int i = 0; i < 16; ++i) sres += c0[i];
            ((float*)pp->out)[blockIdx.x * NTHREADS + tid] = sres;
        }
#endif
        if (IN(base + 2)) {
            attn::Tensors At; At.O = O; At.sink = nullptr; At.lamp = nullptr; At.subln = nullptr; At.lambda_init = 0.f; At.K2 = nullptr;
            if (PH_EN(6) && kind == 0) { At.Q = (const bf16_t*)(R1 + R_QA); At.K1 = (const bf16_t*)(R1 + R_KA); At.VT = (const bf16_t*)(R1 + R_VTA); At.sink = pp->in[12] + slot * 16;
                for (int rep = 0; rep < NREP(6); ++rep) attn::phase<0, ATT_PIPE_A>(lds, At, G, cid, !last); }
            else if (PH_EN(7) && kind == 1) { At.Q = (const bf16_t*)(R1 + R_QB); At.K1 = (const bf16_t*)(R1 + R_KN); At.K2 = (const bf16_t*)(R1 + R_KR); At.VT = (const bf16_t*)(R1 + R_VTB);
#ifdef ATT_PROBE
                { attn::Tensors At2 = At; At2.O = (bf16_t*)pp->out; attn::phase<1, ATT_PIPE_B, ATT_PROBE>(lds, At2, G, cid, !last); }
#endif
                for (int rep = 0; rep < NREP(7); ++rep) attn::phase<1, ATT_PIPE_B>(lds, At, G, cid, !last); }
            else if (PH_EN(8) && kind == 2) { At.Q = (const bf16_t*)(R1 + R_QC); At.K1 = (const bf16_t*)(R1 + R_KC); At.VT = (const bf16_t*)(R1 + R_VTC); At.lamp = pp->in[20] + slot * 256; At.subln = pp->in[21] + slot * 128;
                At.lambda_init = 0.8f - 0.6f * expf(-0.3f * (float)li);
                for (int rep = 0; rep < NREP(8); ++rep) attn::phase<2, ATT_PIPE_C>(lds, At, G, cid, !last); }
        }
        SEAM(base + 2);
        if (PH_EN(9) && IN(base + 3)) {
            const bf16_t* Wt = kind == 0 ? (const bf16_t*)(ws + W_A_OUT) + (size_t)slot * 1024 * 1024 : (kind == 1 ? (const bf16_t*)(ws + W_B_OUT) : (const bf16_t*)(ws + W_C_OUT));
            pg8::Gemm g{O, Wt, 1024}; pg8::StaticOrder So; So.init(Mpost, 1024, G, (int)blockIdx.x);
            epi::EpiOut E{(bf16_t*)(R1 + R_Y)};
            if (NREP(9) == 2) pg8::gemm_phase<epi::EpiOut, pg8::StaticOrder, true>(lds, g, So, E);
            pg8::gemm_phase<epi::EpiOut, pg8::StaticOrder, true>(lds, g, So, E);
        }
        SEAM(base + 3);
        if (PH_EN(10) && IN(base + 4)) {
            const float* Xl = li == 0 ? pp->in[0] : X; const float* Xc = li == 0 ? pp->in[2] : (const float*)((const bf16_t*)X + (size_t)TL * 1024);
            thin::LnrArgs A{Xl, Xc, (const bf16_t*)(R1 + R_Y), (float*)(ws + WS_STATS), H, modl, pp->in[6] + li * 1024, pp->in[7] + li * 1024, (const bf16_t*)(ws + WS_RTW) + (size_t)li * 2 * 65536, pp->in[24] + li * 4, pp->in[26] + li * 32, cnt, list, tokw, Mpost};
            if (NREP(10) == 2) { thin::LnrArgs A2 = A; A2.STATS = (float*)R1; A2.H = (bf16_t*)(R1 + (size_t)T * 4096); A2.cnt = (int*)(ws + WS_CTL) + CW_CNT + 4 * NE * 64; A2.list = (int*)(R1 + (size_t)T * 6144); A2.tokw = (float*)(R1 + (size_t)T * 6144 + (size_t)NE * T * 4);
#ifdef LNR_PROBE
            thin::phase_lnr<LNR_PROBE>(lds, A2, G, cid);
#else
            thin::phase_lnr(lds, A2, G, cid);
#endif
            }
            if (li == 0) thin::phase_lnr<0, false>(lds, A, G, cid); else thin::phase_lnr<0, true>(lds, A, G, cid);
        }
        SEAM(base + 4);
        if (IN(base + 5) || IN(base + 6)) {
            if (threadIdx.x == 0) { int a = 0; for (int e = 0; e < NE; ++e) { MISC[16 + e] = (unsigned)a; a += (cnt[e * 64] + 255) >> 8; } MISC[16 + NE] = (unsigned)a; }
            __syncthreads();
        }
        if (PH_EN(11) && IN(base + 5)) {
            pg8::Gemm g{H, (const bf16_t*)(ws + WS_WGU) + (size_t)li * NE * 1024 * 1024, 1024};
            MoeOrder<true> So{(const LAS int*)(lds + MISC_OFF + 64), cnt, list, G, cid};
            epi::EpiGU E{(bf16_t*)(R1 + R_ACT)};
            for (int rep = 0; rep < NREP(11); ++rep) pg8::gemm_phase<epi::EpiGU, MoeOrder<true>, true>(lds, g, So, E);
        }
        SEAM(base + 5);
        if (PH_EN(12) && IN(base + 6)) {
            pg8::Gemm g{(const bf16_t*)(R1 + R_ACT), (const bf16_t*)(ws + WS_WD) + (size_t)li * NE * 1024 * 512, 512};
            MoeOrder<false> So{(const LAS int*)(lds + MISC_OFF + 64), cnt, list, G, cid};
            epi::EpiDown E{(bf16_t*)(R1 + R_Y2), list, cnt, tokw};
            for (int rep = 0; rep < NREP(12); ++rep) pg8::gemm_phase<epi::EpiDown, MoeOrder<false>, true>(lds, g, So, E);
        }
        SEAM(base + 6);
        if (PH_EN(13) && IN(base + 7)) {
            const float* Xl = li == 0 ? pp->in[0] : X; const float* Xc = li == 0 ? pp->in[2] : (const float*)((const bf16_t*)X + (size_t)TL * 1024);
            thin::LnfArgs A{Xl, Xc, (const bf16_t*)(R1 + R_Y), (const float*)(ws + WS_STATS), (const bf16_t*)(R1 + R_Y2), modl, pp->in[6] + li * 1024, pp->in[7] + li * 1024, pp->in[8] + li * 1024, pp->in[9] + li * 1024, last ? pp->out : X, last ? nullptr : H, last ? nullptr : mod + (size_t)(li + 1) * 9 * 6144, Mpost};
            if (NREP(13) == 2 && !last) { thin::LnfArgs A2 = A; A2.Xout = pp->out; A2.H = O; A2.nrows = TL; thin::phase_lnf(A2, G, cid); }
            if (li == 0) thin::phase_lnf<false, true>(A, G, cid); else if (!last) thin::phase_lnf<true, true>(A, G, cid); else thin::phase_lnf<true, false>(A, G, cid);
        }
        if (!last) SEAM(base + 7);
    }
#undef IN
#undef SEAM
}

extern "C" void kernel_launch(void* const* d_in, const int* in_sizes, int n_in, void* d_out, int out_size, void* d_ws, size_t ws_size, hipStream_t stream) {
    static int grid = 0;
    if (grid == 0) {
        if (n_in != 30 || ws_size < WS_END) { grid = -1; return; }
        int dev = 0, cus = 0;
        if (hipGetDevice(&dev) != hipSuccess || hipDeviceGetAttribute(&cus, hipDeviceAttributeMultiprocessorCount, dev) != hipSuccess) { grid = -1; return; }
        if (hipFuncSetAttribute((const void*)k_run, hipFuncAttributeMaxDynamicSharedMemorySize, LDS_BYTES) != hipSuccess) { grid = -1; return; }
        int per_cu = 0;
        if (hipOccupancyMaxActiveBlocksPerMultiprocessor(&per_cu, (const void*)k_run, NTHREADS, LDS_BYTES) != hipSuccess || per_cu < 1) { (void)hipGetLastError(); grid = -1; return; }
        grid = cus;
    }
    if (grid < 0) return;
    (void)hipMemsetAsync((char*)d_ws + WS_CTL, 0, CTL_ZERO_BYTES, stream);
    Params p{};
    for (int i = 0; i < 30; ++i) p.in[i] = (const float*)d_in[i];
    p.out = (float*)d_out; p.ws = (unsigned char*)d_ws;
#if ONE_LAUNCH
    p.ph_lo = 0; p.ph_hi = NPH;
    k_run<<<dim3(grid), dim3(NTHREADS), LDS_BYTES, stream>>>(p);
#else
    for (int ph = 0; ph < NPH; ++ph) {
        if (ph >= 2 && ((ph - 2) % 8) == 1 && (((ph - 2) / 8) % 3) != 1) continue;
        p.ph_lo = ph; p.ph_hi = ph + 1;
        k_run<<<dim3(grid), dim3(NTHREADS), LDS_BYTES, stream>>>(p);
    }
#endif
}
```

```cpp
#include <hip/hip_runtime.h>
#include <stdint.h>
#include <math.h>

constexpr int D = 1024, NB = 8, S = 4096, L = 256, DEPTH = 4;
constexpr int TL = NB * S, TC = NB * L, T = TL + TC;
constexpr int NKEY = S + L;
constexpr int NE = 32, DE = 512;
constexpr float LN_EPS = 1e-5f, RMS_EPS = 1e-6f;
constexpr float DN_ALPHA = 1.6817928305074290861f;
constexpr float LOG2E = 1.4426950408889634f;
constexpr int NWAVES = 8, NTHREADS = 512;

#define LAS __attribute__((address_space(3)))
typedef unsigned short bf16_t;
typedef short bf16x8 __attribute__((ext_vector_type(8)));
typedef float f32x4 __attribute__((ext_vector_type(4)));
typedef float f32x2 __attribute__((ext_vector_type(2)));
typedef float f32x16 __attribute__((ext_vector_type(16)));
typedef unsigned u32x4 __attribute__((ext_vector_type(4)));
typedef unsigned u32x2 __attribute__((ext_vector_type(2)));

__device__ __forceinline__ unsigned cvt_pk_bf16(float lo, float hi) { unsigned r; asm volatile("v_cvt_pk_bf16_f32 %0, %1, %2" : "=v"(r) : "v"(lo), "v"(hi)); return r; }
__device__ __forceinline__ unsigned f2bf(float f) { unsigned u = __builtin_bit_cast(unsigned, f); return (u + 0x7fffu + ((u >> 16) & 1u)) >> 16; }
__device__ __forceinline__ float bf2f(unsigned h) { return __builtin_bit_cast(float, h << 16); }
__device__ __forceinline__ int mrow_of(int r) { return r < TL ? (r >> 12) : NB; }
__device__ __forceinline__ float dpp_add(float v, unsigned x, const int ctrl_unused) { return v; }
#define DPP_ADD_STEP(v, CTRL) v += __uint_as_float(__builtin_amdgcn_update_dpp(0u, __float_as_uint(v), CTRL, 0xF, 0xF, true))
__device__ __forceinline__ float xor16_sum(float v) { const unsigned x = __float_as_uint(v); auto r = __builtin_amdgcn_permlane16_swap(x, x, false, false); return __uint_as_float(r[0]) + __uint_as_float(r[1]); }
__device__ __forceinline__ float xor32_sum(float v) { const unsigned x = __float_as_uint(v); auto r = __builtin_amdgcn_permlane32_swap(x, x, false, false); return __uint_as_float(r[0]) + __uint_as_float(r[1]); }
typedef _Float16 f16x2 __attribute__((ext_vector_type(2)));
__device__ __forceinline__ unsigned pack_f16(float a, float b) { a = __builtin_fminf(__builtin_fmaxf(a, -65504.f), 65504.f); b = __builtin_fminf(__builtin_fmaxf(b, -65504.f), 65504.f);
    f16x2 h; h.x = (_Float16)a; h.y = (_Float16)b; return __builtin_bit_cast(unsigned, h); }
__device__ __forceinline__ float f16lo(unsigned u) { return (float)__builtin_bit_cast(f16x2, u).x; }
__device__ __forceinline__ float f16hi(unsigned u) { return (float)__builtin_bit_cast(f16x2, u).y; }
__device__ __forceinline__ float xor32_max(float v) { const unsigned x = __float_as_uint(v); auto r = __builtin_amdgcn_permlane32_swap(x, x, false, false); return fmaxf(__uint_as_float(r[0]), __uint_as_float(r[1])); }
__device__ __forceinline__ float wave_sum(float v) {
    DPP_ADD_STEP(v, 0xB1); DPP_ADD_STEP(v, 0x4E); DPP_ADD_STEP(v, 0x141); DPP_ADD_STEP(v, 0x140);
    return xor32_sum(xor16_sum(v));
}
__device__ __forceinline__ void wave_sum2(float& a, float& b) {
    DPP_ADD_STEP(a, 0xB1); DPP_ADD_STEP(b, 0xB1); DPP_ADD_STEP(a, 0x4E); DPP_ADD_STEP(b, 0x4E); DPP_ADD_STEP(a, 0x141); DPP_ADD_STEP(b, 0x141); DPP_ADD_STEP(a, 0x140); DPP_ADD_STEP(b, 0x140);
    a = xor16_sum(a); b = xor16_sum(b); a = xor32_sum(a); b = xor32_sum(b);
}

constexpr size_t MiB = 1u << 20;
constexpr size_t WS_CTL = 0, CTL_ZERO_BYTES = 128 * 1024;
constexpr int CW_Q = 512;
constexpr int CW_BAR = 1024;
constexpr int CW_CNT = 8192;
constexpr size_t WS_MOD = 1 * MiB;
constexpr size_t WS_TAB64 = 2 * MiB, WS_TAB32 = WS_TAB64 + 8192;
constexpr size_t WS_RTW = 3 * MiB;
constexpr size_t WS_TOKW = 4 * MiB;
constexpr size_t WS_SSQ = 5 * MiB;
constexpr size_t WS_STATS = 7 * MiB;
constexpr size_t WS_LIST = 8 * MiB;
constexpr size_t WS_WSMALL = 16 * MiB;
constexpr size_t W_A_IN = WS_WSMALL;
constexpr size_t W_A_OUT = W_A_IN + 2ull * 1536 * 1024 * 2;
constexpr size_t W_B_IN = W_A_OUT + 2ull * 1024 * 1024 * 2;
constexpr size_t W_B_UQ = W_B_IN + 1024ull * 1024 * 2;
constexpr size_t W_B_UKV = W_B_UQ + 1536ull * 512 * 2;
constexpr size_t W_B_OUT = W_B_UKV + 2048ull * 256 * 2;
constexpr size_t W_C_IN = W_B_OUT + 1024ull * 1024 * 2;
constexpr size_t W_C_OUT = W_C_IN + 3072ull * 1024 * 2;
constexpr size_t WS_WGU = 48 * MiB;
constexpr size_t WS_WD = WS_WGU + 4ull * 32 * 1024 * 1024 * 2;
constexpr size_t WS_X = WS_WD + 4ull * 32 * 1024 * 512 * 2;
constexpr size_t WS_H = WS_X + (size_t)T * 1024 * 4;
constexpr size_t WS_O = WS_H + (size_t)T * 1024 * 2;
constexpr size_t WS_R1 = WS_O + (size_t)T * 1024 * 2;
static_assert(W_C_OUT + 1024ull * 1024 * 2 <= WS_WGU, "small weights fit");
constexpr size_t R_QA = 0, R_KA = R_QA + (size_t)T * 1024 * 2, R_VTA = R_KA + (size_t)T * 256 * 2;
constexpr size_t R_CQ = 0, R_CKV = R_CQ + (size_t)T * 512 * 2, R_KR = R_CKV + (size_t)T * 256 * 2, R_QB = R_KR + (size_t)T * 32 * 2,
                 R_KN = R_QB + (size_t)T * 1536 * 2, R_VTB = R_KN + (size_t)T * 1024 * 2, R_ENDB = R_VTB + (size_t)NB * 16 * 64 * NKEY * 2;
constexpr size_t R_QC = 0, R_KC = R_QC + (size_t)T * 1024 * 2, R_VTC = R_KC + (size_t)T * 1024 * 2;
constexpr int NPOS = 2 * T + NE * 256;
constexpr size_t R_ACT = 0, R_Y2 = R_ACT + (size_t)NPOS * 512 * 2, R_ENDM = R_Y2 + (size_t)T * 2 * 1024 * 2;
constexpr size_t R_Y = R_ENDM, R_ENDY = R_Y + (size_t)T * 1024 * 2;
static_assert(R_ENDY <= R_ENDB, "MoE region + y inside R1");
constexpr size_t WS_END = WS_R1 + R_ENDB;

constexpr int LDS_BYTES = 147456;
constexpr int MISC_OFF = 146432;

#define XB_TMO      128
#define XB_XCNT(j)  (256  + 64 * (j))
#define XB_XSUB(j)  (1280 + 64 * (j))
#define XB_XGEN(j)  (2304 + 64 * (j))
#define XB_TOP      3328
#define XB_TOPGEN   3392
#define XCD_BAR_WORDS 3456
#define XB_SPIN_CAP (1u << 18)
__device__ __forceinline__ unsigned xb_ld(unsigned* p)              { return __hip_atomic_load(p, __ATOMIC_RELAXED, __HIP_MEMORY_SCOPE_AGENT); }
__device__ __forceinline__ unsigned xb_add(unsigned* p, unsigned v) { return __hip_atomic_fetch_add(p, v, __ATOMIC_RELAXED, __HIP_MEMORY_SCOPE_AGENT); }
__device__ __forceinline__ unsigned xb_xcc_id() { return (unsigned)__builtin_amdgcn_s_getreg((3 << 11) | 20) & 0xFu; }
#define XB_SPIN(cond, bar) do { unsigned _sp = 0; while (cond) { __builtin_amdgcn_s_sleep(1); \
    if ((++_sp & 255u) == 0u) { if (xb_ld(&(bar)[XB_TMO])) break; if (_sp > XB_SPIN_CAP) { atomicAdd(&(bar)[XB_TMO], 1u); break; } } } } while (0)
struct XcdBarrier { unsigned* bar; unsigned x; volatile LAS unsigned* st; };
__device__ __forceinline__ XcdBarrier xcd_barrier_post(unsigned* bar, volatile LAS unsigned* st) {
    XcdBarrier b; b.bar = bar; b.x = xb_xcc_id(); b.st = st;
    if (threadIdx.x == 0) (void)xb_add(&bar[XB_XCNT(b.x)], 1u);
    return b;
}
__device__ __forceinline__ void xcd_barrier_complete(unsigned* bar, unsigned x, unsigned& nloc, unsigned& nx) {
    const unsigned G = gridDim.x * gridDim.y * gridDim.z;
    unsigned sum, cnt, mine, sp = 0u;
    for (;;) {
        sum = 0u; cnt = 0u; mine = 0u;
#pragma unroll
        for (unsigned j = 0; j < 16; ++j) { const unsigned c = xb_ld(&bar[XB_XCNT(j)]); sum += c; cnt += (c > 0u) ? 1u : 0u; mine = (j == x) ? c : mine; }
        if (sum == G) break;
        __builtin_amdgcn_s_sleep(1);
        if ((++sp & 255u) == 0u) { if (xb_ld(&bar[XB_TMO])) break; if (sp > XB_SPIN_CAP) { atomicAdd(&bar[XB_TMO], 1u); break; } }
    }
    nloc = mine > 0u ? mine : 1u; nx = cnt > 0u ? cnt : 1u;
}
__device__ __forceinline__ void xcd_barrier(const XcdBarrier& b) {
    asm volatile("s_waitcnt vmcnt(0)" ::: "memory");
    __syncthreads();
    if (threadIdx.x == 0) {
        unsigned* bar = b.bar;
        __builtin_amdgcn_s_waitcnt(0);
        unsigned nloc = b.st[0], nx = b.st[1];
        if (nloc == 0u) { xcd_barrier_complete(bar, b.x, nloc, nx); b.st[0] = nloc; b.st[1] = nx; }
        const unsigned old = xb_add(&bar[XB_XSUB(b.x)], 1u);
        const unsigned gen = old / nloc;
        if (old + 1u == (gen + 1u) * nloc) {
            __builtin_amdgcn_fence(__ATOMIC_RELEASE, "agent");
            asm volatile("s_waitcnt vmcnt(0)" ::: "memory");
            const unsigned og = xb_add(&bar[XB_TOP], 1u);
            const unsigned tg = og / nx;
            if (og + 1u == (tg + 1u) * nx) xb_add(&bar[XB_TOPGEN], 1u);
            else XB_SPIN(xb_ld(&bar[XB_TOPGEN]) == tg, bar);
            __builtin_amdgcn_fence(__ATOMIC_ACQUIRE, "agent");
            xb_add(&bar[XB_XGEN(b.x)], 1u);
            asm volatile("s_waitcnt vmcnt(0)" ::: "memory");
        } else {
            XB_SPIN(xb_ld(&bar[XB_XGEN(b.x)]) == gen, bar);
            __builtin_amdgcn_fence(__ATOMIC_ACQUIRE, "agent");
            asm volatile("s_waitcnt vmcnt(0)" ::: "memory");
        }
    }
    __syncthreads();
}

namespace pg8 {
constexpr int BM = 256, BK = 64, HALF = 128, HTB = HALF * BK * 2, STAGE_BYTES = 8 * HTB, NXCD = 8, WGM = 2;
__host__ __device__ __forceinline__ int lds_byte(int r, int c) { const int st = (r >> 4) * 2 + (c >> 5), rr = r & 15, cc = c & 31, ob = rr * 64 + cc * 2; return st * 1024 + (ob ^ (((ob >> 9) & 1) << 5)); }
__host__ __device__ __forceinline__ void stage_rc(int b, int& R, int& C) { const int st = b / 1024, sb = b % 1024, swz = sb ^ (((sb >> 9) & 1) << 5); R = (st >> 1) * 16 + swz / 64; C = (st & 1) * 32 + (swz % 64) / 2; }
__host__ __device__ __forceinline__ int perm32(int rho) { const int n = rho >> 4, i = rho & 15; return 8 * (i >> 2) + 4 * n + (i & 3); }

struct Unit { int pm, pn, e, t, r0, nai; };
struct Gemm { const bf16_t* A; const bf16_t* Bt; int K; };

struct StaticOrder {
    static constexpr bool GATHER = false;
    int nM, nN, nwg, G, c;
    __device__ void init(int M, int N, int G_, int c_) { asm volatile("" : "+s"(G_), "+s"(c_));
        nM = M / BM; nN = N / BM; nwg = nM * nN; G = G_; c = c_; }
    __device__ bool next(int i, Unit& u) const {
        const int nfull = (nwg / G) * G, rem = nwg - nfull; const bool halves = rem > 0 && 2 * rem <= G;
        long Lx = (long)i * G + c; u.r0 = 0; u.nai = 2;
        if (Lx >= nfull && halves) { if (i * G != nfull || c >= 2 * rem) return false; Lx = nfull + (c >> 1); u.r0 = (c & 1) * HALF; u.nai = 1; }
        if (Lx >= nwg) return false;
        int wgid = (int)Lx; { const int q = nwg / NXCD, r = nwg % NXCD, xcd = wgid % NXCD, off = wgid / NXCD; wgid = (xcd < r ? xcd * (q + 1) : r * (q + 1) + (xcd - r) * q) + off; }
        const int nig = WGM * nN, gid = wgid / nig, fm = gid * WGM, gsz = (nM - fm) < WGM ? (nM - fm) : WGM;
        u.pm = fm + ((wgid % nig) % gsz); u.pn = (wgid % nig) / gsz; u.e = 0; u.t = 0; return true;
    }
    __device__ __forceinline__ int arow(const Unit& u, int r) const { return u.pm * BM + u.r0 + r; }
};

template <class Epi, class Sched, bool ALIGN_EPI>
__device__ __forceinline__ void gemm_phase(LAS unsigned char* lds, const Gemm g, const Sched& S, const Epi& E) {
    int tid_ = threadIdx.x; asm volatile("" : "+v"(tid_));
    const int tid = tid_, wid = __builtin_amdgcn_readfirstlane(tid >> 6), lane = tid & 63, wr = wid >> 2, wc = wid & 3, fr = lane & 15, fq = lane >> 4;
    const int K = g.K, nt = K / BK;
    unsigned voffB[2];
#pragma unroll
    for (int i = 0; i < 2; ++i) { int R, C; stage_rc(tid * 16 + i * 8192, R, C); const int Rb = Epi::PERM ? ((R & ~31) + perm32(R & 31)) : R;
        voffB[i] = (unsigned)(Rb * K + C) * 2u; }
    const size_t kstep = (size_t)(BK * 2);
    const size_t hstep = (size_t)HALF * K * 2;
    const size_t tstep = 2 * hstep;
    const unsigned ldsw = (unsigned)wid * 1024u;
    const int aoff = lds_byte(wr * 64 + fr, fq * 8), boff = lds_byte(wc * 32 + fr, fq * 8);
#define PG8_SA(b, h) (((b) * 2 + (h)) * HTB)
#define PG8_SB(b, h) ((4 + (b) * 2 + (h)) * HTB)
#define PG8_STAGE(bufoff, gbase, voff) do { _Pragma("unroll") for (int _i = 0; _i < 2; ++_i) \
        __builtin_amdgcn_global_load_lds((const unsigned*)((const char*)(gbase) + (voff)[_i]), (LAS unsigned*)(lds + (bufoff) + ldsw + _i * 8192), 16, 0, 0); } while (0)
#define PG8_LDA(dst, b, h) do { _Pragma("unroll") for (int m = 0; m < 4; ++m) _Pragma("unroll") for (int k = 0; k < 2; ++k) dst[m][k] = *(const LAS bf16x8*)(lds + PG8_SA(b, h) + aoff + m * 2048 + k * 1024); } while (0)
#define PG8_LDB(dst, b, h) do { _Pragma("unroll") for (int n = 0; n < 2; ++n) _Pragma("unroll") for (int k = 0; k < 2; ++k) dst[n][k] = *(const LAS bf16x8*)(lds + PG8_SB(b, h) + boff + n * 2048 + k * 1024); } while (0)
#define PG8_MMA(ai, bj, At, Bt) do { __builtin_amdgcn_s_setprio(1); _Pragma("unroll") for (int m = 0; m < 4; ++m) _Pragma("unroll") for (int n = 0; n < 2; ++n) _Pragma("unroll") for (int k = 0; k < 2; ++k) \
        acc[ai][bj][m][n] = __builtin_amdgcn_mfma_f32_16x16x32_bf16(Bt[n][k], At[m][k], acc[ai][bj][m][n], 0, 0, 0); __builtin_amdgcn_s_setprio(0); } while (0)
#define PG8_WAIT_V(n) asm volatile("s_waitcnt vmcnt(" #n ")" ::: "memory")
#define PG8_WAIT_L(n) asm volatile("s_waitcnt lgkmcnt(" #n ")" ::: "memory")
#define PG8_BAR __builtin_amdgcn_s_barrier()
#define PG8_SCHED __builtin_amdgcn_sched_barrier(0)
#define PG8_AOFF(dst, u) do { _Pragma("unroll") for (int _i = 0; _i < 2; ++_i) { int R_, C_; stage_rc(tid * 16 + _i * 8192, R_, C_); \
        _Pragma("unroll") for (int _h = 0; _h < 2; ++_h) dst[_h][_i] = (unsigned)(S.arow(u, _h * HALF + R_) * K + C_) * 2u; } } while (0)
    Unit cur, nxt; int ui = 0;
    if (!S.next(0, cur)) return;
    f32x4 acc[2][2][4][2];
#pragma unroll
    for (int a = 0; a < 2; ++a)
#pragma unroll
        for (int b = 0; b < 2; ++b)
#pragma unroll
            for (int m = 0; m < 4; ++m)
#pragma unroll
                for (int n = 0; n < 2; ++n) acc[a][b][m][n] = (f32x4){0.f, 0.f, 0.f, 0.f};
    bf16x8 At[4][2], B0[2][2], B1[2][2];
    unsigned voffA[2]; unsigned vA[2][2], nA_[2][2];
    const char* cA = (const char*)g.A; const char* nAp = cA;
    if constexpr (Sched::GATHER) { PG8_AOFF(vA, cur); }
    else {
#pragma unroll
        for (int i = 0; i < 2; ++i) { int R, C; stage_rc(tid * 16 + i * 8192, R, C); voffA[i] = (unsigned)(R * K + C) * 2u; }
        cA = (const char*)g.A + (size_t)cur.pm * tstep + (size_t)cur.r0 * K * 2;
    }
#define PG8_STA(bufoff, kptr, h, offs) do { if constexpr (Sched::GATHER) { PG8_STAGE(bufoff, kptr, offs[h]); } else { PG8_STAGE(bufoff, (kptr) + (h) * hstep, voffA); } } while (0)
    const char* cB = (const char*)g.Bt + (size_t)cur.pn * tstep;
    PG8_STAGE(PG8_SB(0, 0), cB, voffB); PG8_STAGE(PG8_SB(0, 1), cB + hstep, voffB); PG8_STA(PG8_SA(0, 0), cA, 0, vA); PG8_STA(PG8_SA(0, 1), cA, 1, vA);
    if (wr == 1) PG8_BAR;
    PG8_WAIT_V(2); PG8_BAR;
    PG8_STAGE(PG8_SB(1, 0), cB + kstep, voffB); PG8_STA(PG8_SA(1, 0), cA + kstep, 0, vA); PG8_STAGE(PG8_SB(1, 1), cB + hstep + kstep, voffB);
    PG8_WAIT_V(6); PG8_BAR;
    for (;;) {
        const bool has_next = S.next(ui + 1, nxt);
        if constexpr (Sched::GATHER) {
            if (has_next) { PG8_AOFF(nA_, nxt); } else {
#pragma unroll
                for (int _h = 0; _h < 2; ++_h)
#pragma unroll
                    for (int _i = 0; _i < 2; ++_i) nA_[_h][_i] = vA[_h][_i]; }
        } else { nAp = has_next ? (const char*)g.A + (size_t)nxt.pm * tstep + (size_t)nxt.r0 * K * 2 : cA; }
        const char* nB = has_next ? (const char*)g.Bt + (size_t)nxt.pn * tstep : cB;
        const bool full = cur.nai == 2;
#pragma unroll 1
        for (int t = 0; t < nt; t += 2) {
            const bool last = (t == nt - 2);
            const char* a1 = cA + (size_t)(t + 1) * kstep;
            const char* a2 = last ? nAp : cA + (size_t)(t + 2) * kstep; const char* b2 = last ? nB : cB + (size_t)(t + 2) * kstep;
            const char* a3 = a2 + kstep; const char* b3 = b2 + kstep;
            unsigned wq[2][2];
            if constexpr (Sched::GATHER) {
#pragma unroll
                for (int _h = 0; _h < 2; ++_h)
#pragma unroll
                    for (int _i = 0; _i < 2; ++_i) wq[_h][_i] = last ? nA_[_h][_i] : vA[_h][_i];
            }
            PG8_LDB(B0, 0, 0); PG8_LDB(B1, 0, 1); PG8_SCHED; PG8_LDA(At, 0, 0); PG8_STA(PG8_SA(1, 1), a1, 1, vA);
            PG8_WAIT_V(8); PG8_WAIT_L(0); PG8_BAR; PG8_MMA(0, 0, At, B0); PG8_MMA(0, 1, At, B1); PG8_BAR; PG8_SCHED;
            PG8_LDA(At, 0, 1); PG8_STAGE(PG8_SB(0, 0), b2, voffB); PG8_STAGE(PG8_SB(0, 1), b2 + hstep, voffB); PG8_STA(PG8_SA(0, 0), a2, 0, wq);
            PG8_WAIT_V(8); PG8_WAIT_L(0); PG8_BAR; if (full) { PG8_MMA(1, 0, At, B0); PG8_MMA(1, 1, At, B1); } PG8_BAR; PG8_SCHED;
            PG8_LDB(B0, 1, 0); PG8_LDB(B1, 1, 1); PG8_SCHED; PG8_LDA(At, 1, 0); PG8_STA(PG8_SA(0, 1), a2, 1, wq);
            PG8_WAIT_V(8); PG8_WAIT_L(0); PG8_BAR; PG8_MMA(0, 0, At, B0); PG8_MMA(0, 1, At, B1); PG8_BAR; PG8_SCHED;
            PG8_LDA(At, 1, 1); PG8_STAGE(PG8_SB(1, 0), b3, voffB); PG8_STAGE(PG8_SB(1, 1), b3 + hstep, voffB); PG8_STA(PG8_SA(1, 0), a3, 0, wq);
            PG8_WAIT_V(8); PG8_WAIT_L(0); PG8_BAR; if (full) { PG8_MMA(1, 0, At, B0); PG8_MMA(1, 1, At, B1); } PG8_BAR; PG8_SCHED;
        }
        if constexpr (ALIGN_EPI) { if (wr == 0) PG8_BAR; }
        E(acc, cur, wr, wc, fr, fq);
        if (!has_next) break;
#pragma unroll
        for (int a = 0; a < 2; ++a)
#pragma unroll
            for (int b = 0; b < 2; ++b)
#pragma unroll
                for (int m = 0; m < 4; ++m)
#pragma unroll
                    for (int n = 0; n < 2; ++n) acc[a][b][m][n] = (f32x4){0.f, 0.f, 0.f, 0.f};
        cur = nxt; cB = nB; ++ui;
        if constexpr (Sched::GATHER) {
#pragma unroll
            for (int _h = 0; _h < 2; ++_h)
#pragma unroll
                for (int _i = 0; _i < 2; ++_i) vA[_h][_i] = nA_[_h][_i];
        } else { cA = nAp; }
        if constexpr (ALIGN_EPI) { if (wr == 1) PG8_BAR; }
    }
    PG8_WAIT_V(0);
    if constexpr (!ALIGN_EPI) { if (wr == 0) PG8_BAR; }
    PG8_BAR;
#undef PG8_STA
#undef PG8_SA
#undef PG8_SB
#undef PG8_STAGE
#undef PG8_LDA
#undef PG8_LDB
#undef PG8_MMA
#undef PG8_WAIT_V
#undef PG8_WAIT_L
#undef PG8_BAR
#undef PG8_SCHED
#undef PG8_AOFF
}
}
namespace epi {
using pg8::Unit;
typedef float2 cs2;
__device__ __forceinline__ void rope8(f32x4& v0, f32x4& v1, const f32x4 c01, const f32x4 c23) {
    float a, b;
    a = v0[0]; b = v0[1]; v0[0] = a * c01[0] - b * c01[1]; v0[1] = b * c01[0] + a * c01[1];
    a = v0[2]; b = v0[3]; v0[2] = a * c01[2] - b * c01[3]; v0[3] = b * c01[2] + a * c01[3];
    a = v1[0]; b = v1[1]; v1[0] = a * c23[0] - b * c23[1]; v1[1] = b * c23[0] + a * c23[1];
    a = v1[2]; b = v1[3]; v1[2] = a * c23[2] - b * c23[3]; v1[3] = b * c23[2] + a * c23[3];
}
__device__ __forceinline__ u32x4 pack8(const f32x4 v0, const f32x4 v1) { u32x4 w; w.x = cvt_pk_bf16(v0[0], v0[1]); w.y = cvt_pk_bf16(v0[2], v0[3]); w.z = cvt_pk_bf16(v1[0], v1[1]); w.w = cvt_pk_bf16(v1[2], v1[3]); return w; }
__device__ __forceinline__ void store_vt(bf16_t* VT, int HV, int DV, int row, int vcol, const f32x4 v0, const f32x4 v1) {
    const int b = row < TL ? (row >> 12) : ((row - TL) >> 8), key = row < TL ? (row & 4095) : (S + ((row - TL) & 255));
    const int hv = vcol / DV, dv = vcol % DV;
    bf16_t* p = VT + ((size_t)(b * HV + hv) * DV + dv) * NKEY + key;
#pragma unroll
    for (int i = 0; i < 4; ++i) { p[(size_t)i * NKEY] = (bf16_t)f2bf(v0[i]); p[(size_t)(4 + i) * NKEY] = (bf16_t)f2bf(v1[i]); }
}

struct EpiQKV {
    static constexpr bool PERM = true;
    bf16_t* Q; int ldq; bf16_t* Kb; int ldk; bf16_t* VT; int HV, DV; int nQ, nK; float qscale; const float* tab64;
    __device__ __forceinline__ void operator()(const f32x4 (&acc)[2][2][4][2], const Unit& u, int wr, int wc, int fr, int fq) const {
        const int kindt = u.pn < nQ ? 0 : (u.pn < nQ + nK ? 1 : 2);
        const int tcol = (kindt == 0 ? u.pn : (kindt == 1 ? u.pn - nQ : u.pn - nQ - nK)) * 256 + wc * 32 + fq * 8;
#pragma unroll
        for (int ai = 0; ai < 2; ++ai) if (ai < u.nai)
#pragma unroll
            for (int m = 0; m < 4; ++m) {
                asm volatile("" ::: "memory");
                const int row = u.pm * 256 + u.r0 + ai * 128 + wr * 64 + m * 16 + fr;
                if (kindt == 2) {
#pragma unroll
                    for (int bj = 0; bj < 2; ++bj) store_vt(VT, HV, DV, row, tcol + bj * 128, acc[ai][bj][m][0], acc[ai][bj][m][1]);
                } else {
                    f32x4 c01 = (f32x4){1.f, 0.f, 1.f, 0.f}, c23 = c01;
                    if (row < TL) { const int s = row & 4095, pos = (wc & 1) ? (s & 63) : (s >> 6);
                        const f32x4* tp = (const f32x4*)(tab64 + ((size_t)pos * 16 + fq * 4) * 2); c01 = tp[0]; c23 = tp[1]; }
                    const float sc = kindt == 0 ? qscale : 1.f;
                    bf16_t* dst = (kindt == 0 ? Q + (size_t)row * ldq : Kb + (size_t)row * ldk) + tcol;
#pragma unroll
                    for (int bj = 0; bj < 2; ++bj) { f32x4 v0 = acc[ai][bj][m][0], v1 = acc[ai][bj][m][1]; rope8(v0, v1, c01, c23); v0 = v0 * sc; v1 = v1 * sc;
                        *(u32x4*)(dst + bj * 128) = pack8(v0, v1); }
                }
            }
    }
};
struct EpiB1 {
    static constexpr bool PERM = true;
    bf16_t* CQ; bf16_t* CKV; bf16_t* KR; float* SSQ; const float* tab32;
    __device__ __forceinline__ void operator()(const f32x4 (&acc)[2][2][4][2], const Unit& u, int wr, int wc, int fr, int fq) const {
#pragma unroll
        for (int ai = 0; ai < 2; ++ai) if (ai < u.nai)
#pragma unroll
            for (int m = 0; m < 4; ++m) {
                asm volatile("" ::: "memory");
                const int row = u.pm * 256 + u.r0 + ai * 128 + wr * 64 + m * 16 + fr;
                if (u.pn < 3) {
                    float ss = 0.f;
#pragma unroll
                    for (int bj = 0; bj < 2; ++bj)
#pragma unroll
                        for (int n = 0; n < 2; ++n) { const f32x4 v = acc[ai][bj][m][n]; ss += (v[0] * v[0] + v[1] * v[1]) + (v[2] * v[2] + v[3] * v[3]); }
                    ss = xor32_sum(xor16_sum(ss));
                    if (fq == 0) SSQ[(size_t)row * 12 + u.pn * 4 + wc] = ss;
                    bf16_t* dst = (u.pn < 2 ? CQ + (size_t)row * 512 + u.pn * 256 : CKV + (size_t)row * 256) + wc * 32 + fq * 8;
#pragma unroll
                    for (int bj = 0; bj < 2; ++bj) *(u32x4*)(dst + bj * 128) = pack8(acc[ai][bj][m][0], acc[ai][bj][m][1]);
                } else if (wc == 0) {
                    f32x4 v0 = acc[ai][0][m][0], v1 = acc[ai][0][m][1];
                    if (row < TL) { const int s = row & 4095, pos = (fq & 2) ? (s & 63) : (s >> 6);
                        const f32x4* tp = (const f32x4*)(tab32 + ((size_t)pos * 8 + (fq & 1) * 4) * 2); rope8(v0, v1, tp[0], tp[1]); }
                    *(u32x4*)(KR + (size_t)row * 32 + fq * 8) = pack8(v0, v1);
                }
            }
    }
};
struct EpiB2 {
    static constexpr bool PERM = true;
    bf16_t* QB; const float* SSQ; const float* tab32; float qscale;
    __device__ __forceinline__ void operator()(const f32x4 (&acc)[2][2][4][2], const Unit& u, int wr, int wc, int fr, int fq) const {
#pragma unroll
        for (int ai = 0; ai < 2; ++ai) if (ai < u.nai)
#pragma unroll
            for (int m = 0; m < 4; ++m) {
                asm volatile("" ::: "memory");
                const int row = u.pm * 256 + u.r0 + ai * 128 + wr * 64 + m * 16 + fr;
                const f32x4 s0 = *(const f32x4*)(SSQ + (size_t)row * 12), s1 = *(const f32x4*)(SSQ + (size_t)row * 12 + 4);
                const float ss = ((s0[0] + s0[1]) + (s0[2] + s0[3])) + ((s1[0] + s1[1]) + (s1[2] + s1[3]));
                const float sc = qscale / sqrtf(ss * (1.f / 512.f) + RMS_EPS);
#pragma unroll
                for (int bj = 0; bj < 2; ++bj) {
                    const int col = u.pn * 256 + bj * 128 + wc * 32 + fq * 8, w0 = col % 96;
                    f32x4 v0 = acc[ai][bj][m][0] * sc, v1 = acc[ai][bj][m][1] * sc;
                    if (w0 >= 64 && row < TL) { const int off = w0 - 64, s = row & 4095, pos = (off & 16) ? (s & 63) : (s >> 6);
                        const f32x4* tp = (const f32x4*)(tab32 + ((size_t)pos * 8 + ((off & 15) >> 1)) * 2); rope8(v0, v1, tp[0], tp[1]); }
                    *(u32x4*)(QB + (size_t)row * 1536 + col) = pack8(v0, v1);
                }
            }
    }
};
struct EpiB3 {
    static constexpr bool PERM = true;
    bf16_t* KN; bf16_t* VT; const float* SSQ;
    __device__ __forceinline__ void operator()(const f32x4 (&acc)[2][2][4][2], const Unit& u, int wr, int wc, int fr, int fq) const {
#pragma unroll
        for (int ai = 0; ai < 2; ++ai) if (ai < u.nai)
#pragma unroll
            for (int m = 0; m < 4; ++m) {
                asm volatile("" ::: "memory");
                const int row = u.pm * 256 + u.r0 + ai * 128 + wr * 64 + m * 16 + fr;
                const f32x4 s2 = *(const f32x4*)(SSQ + (size_t)row * 12 + 8);
                const float sc = 1.0f / sqrtf(((s2[0] + s2[1]) + (s2[2] + s2[3])) * (1.f / 256.f) + RMS_EPS);
#pragma unroll
                for (int bj = 0; bj < 2; ++bj) {
                    const f32x4 v0 = acc[ai][bj][m][0] * sc, v1 = acc[ai][bj][m][1] * sc;
                    const int tc = bj * 128 + wc * 32 + fq * 8;
                    if (u.pn < 4) *(u32x4*)(KN + (size_t)row * 1024 + u.pn * 256 + tc) = pack8(v0, v1);
                    else store_vt(VT, 16, 64, row, (u.pn - 4) * 256 + tc, v0, v1);
                }
            }
    }
};
struct EpiOut {
    static constexpr bool PERM = true;
    bf16_t* Y;
    __device__ __forceinline__ void operator()(const f32x4 (&acc)[2][2][4][2], const Unit& u, int wr, int wc, int fr, int fq) const {
#pragma unroll
        for (int ai = 0; ai < 2; ++ai) if (ai < u.nai)
#pragma unroll
            for (int m = 0; m < 4; ++m) {
                const int row = u.pm * 256 + u.r0 + ai * 128 + wr * 64 + m * 16 + fr;
#pragma unroll
                for (int bj = 0; bj < 2; ++bj)
                    *(u32x4*)(Y + (size_t)row * 1024 + u.pn * 256 + bj * 128 + wc * 32 + fq * 8) = pack8(acc[ai][bj][m][0], acc[ai][bj][m][1]);
            }
    }
};
struct EpiGU {
    static constexpr bool PERM = true;
    bf16_t* ACT;
    __device__ __forceinline__ void operator()(const f32x4 (&acc)[2][2][4][2], const Unit& u, int wr, int wc, int fr, int fq) const {
#pragma unroll
        for (int ai = 0; ai < 2; ++ai) if (ai < u.nai)
#pragma unroll
            for (int m = 0; m < 4; ++m) {
                asm volatile("" ::: "memory");
                const int row = u.pm * 256 + u.r0 + ai * 128 + wr * 64 + m * 16 + fr;
#pragma unroll
                for (int bj = 0; bj < 2; ++bj) {
                    const f32x4 g = acc[ai][bj][m][0], up = acc[ai][bj][m][1]; f32x4 a;
#pragma unroll
                    for (int i = 0; i < 4; ++i) a[i] = g[i] / (1.f + __expf(-g[i])) * up[i];
                    u32x2 w; w.x = cvt_pk_bf16(a[0], a[1]); w.y = cvt_pk_bf16(a[2], a[3]);
                    *(u32x2*)(ACT + (size_t)row * 512 + (u.pn & 3) * 128 + bj * 64 + wc * 16 + fq * 4) = w;
                }
            }
    }
};
struct EpiDown {
    static constexpr bool PERM = true;
    bf16_t* Y2; const int* list; const int* cnt; const float* tokw;
    __device__ __forceinline__ void operator()(const f32x4 (&acc)[2][2][4][2], const Unit& u, int wr, int wc, int fr, int fq) const {
        const int ne = cnt[u.e * 64];
#pragma unroll
        for (int ai = 0; ai < 2; ++ai) if (ai < u.nai)
#pragma unroll
            for (int m = 0; m < 4; ++m) {
                asm volatile("" ::: "memory");
                const int idx = u.t * 256 + u.r0 + ai * 128 + wr * 64 + m * 16 + fr;
                if (idx < ne) {
                    const int ent = list[(size_t)u.e * T + idx]; const float w = tokw[ent];
#pragma unroll
                    for (int bj = 0; bj < 2; ++bj)
                        *(u32x4*)(Y2 + (size_t)ent * 1024 + (u.pn & 3) * 256 + bj * 128 + wc * 32 + fq * 8) = pack8(acc[ai][bj][m][0] * w, acc[ai][bj][m][1] * w);
                }
            }
    }
};
}

template <bool GATHER_> struct MoeOrder {
    static constexpr bool GATHER = GATHER_;
    const LAS int* tp; const int* cnt; const int* list; int G, c;
    __device__ bool next(int i, pg8::Unit& u) const {
        const int nwg = tp[NE] * 4, nfull = (nwg / G) * G, rem = nwg - nfull; const bool halves = rem > 0 && 2 * rem <= G;
        int Lx = i * G + c; u.r0 = 0; u.nai = 2;
        if (Lx >= nfull && halves) { if (i * G != nfull || c >= 2 * rem) return false; Lx = nfull + (c >> 1); u.r0 = (c & 1) * 128; u.nai = 1; }
        if (Lx >= nwg) return false;
        const int tt = Lx >> 2;
        int e = 0;
#pragma unroll 1
        for (int k = 1; k < NE; ++k) e = (tp[k] <= tt) ? k : e;
        u.pm = tt; u.t = tt - tp[e]; u.e = e; u.pn = e * 4 + (Lx & 3); return true;
    }
    __device__ __forceinline__ int arow(const pg8::Unit& u, int r) const {
        if (!GATHER_) return u.pm * 256 + u.r0 + r;
        const int idx = u.t * 256 + u.r0 + r;
        return idx < cnt[u.e * 64] ? (list[(size_t)u.e * T + idx] >> 1) : 0;
    }
};
namespace attn {
struct Tensors {
    const bf16_t* Q; const bf16_t* K1; const bf16_t* K2; const bf16_t* VT; bf16_t* O;
    const float* sink; const float* lamp; const float* subln; float lambda_init;
};
__device__ __forceinline__ float max3f(float a, float b, float c) { float r; asm("v_max3_f32 %0, %1, %2, %3" : "=v"(r) : "v"(a), "v"(b), "v"(c)); return r; }
__device__ __forceinline__ float max32(const f32x16& a, const f32x16& b) {
    float r0 = max3f(a[0], a[1], a[2]), r1 = max3f(a[3], a[4], a[5]), r2 = max3f(a[6], a[7], a[8]), r3 = max3f(a[9], a[10], a[11]);
    r0 = max3f(r0, a[12], a[13]); r1 = max3f(r1, a[14], a[15]); r2 = max3f(r2, b[0], b[1]); r3 = max3f(r3, b[2], b[3]);
    r0 = max3f(r0, b[4], b[5]); r1 = max3f(r1, b[6], b[7]); r2 = max3f(r2, b[8], b[9]); r3 = max3f(r3, b[10], b[11]);
    r0 = max3f(r0, b[12], b[13]); r1 = max3f(r1, b[14], b[15]);
    return max3f(max3f(r0, r1, r2), r3, r3);
}
constexpr float ATT_THR = 10.f;
#define MFMA32(a, b, c) __builtin_amdgcn_mfma_f32_32x32x16_bf16((a), (b), (c), 0, 0, 0)

template <int KIND, bool PIPE = false, int VAR = 0>
__device__ __forceinline__ void phase(LAS unsigned char* lds, const Tensors P, int G, int cid, bool with_ctx) {
    asm volatile("" : "+s"(G), "+s"(cid));
    constexpr int NST = KIND == 1 ? 6 : 4, DV = KIND == 2 ? 128 : 64, NDV = DV / 32, KROWB = KIND == 0 ? 128 : 256, KCH = KIND == 0 ? 8 : (KIND == 1 ? 12 : 16);
    constexpr int KJ = (64 * KCH + 511) / 512, VJ = DV * 8 / 512, HV = KIND == 0 ? 4 : (KIND == 1 ? 16 : 8);
    constexpr int LDQ = KIND == 1 ? 1536 : 1024, LDK = KIND == 0 ? 256 : 1024;
    constexpr int KB0 = 0, VB0 = 32768, BUFSTEP = 16384, SCR = 65536;
    int tid_ = threadIdx.x; asm volatile("" : "+v"(tid_));
    const int tid = tid_, lane = tid & 63, w = __builtin_amdgcn_readfirstlane(tid >> 6), r = lane & 31, hh = lane >> 5;
    const int NU = 2048 + (with_ctx ? 128 : 0);
    constexpr int KPIECES = 64 * KROWB / 8192, VPIECES = DV * 128 / 8192;
    int ksrc[KPIECES], ksrb[KPIECES]; bool kpart2[KPIECES];
#pragma unroll
    for (int j = 0; j < KPIECES; ++j) {
        const int p = (j * 8 + w) * 1024 + lane * 16, kk = p / KROWB, pc = (p % KROWB) >> 4;
        int c = pc ^ (KROWB == 128 ? ((kk >> 1) & 7) : (kk & 15)); if (c >= KCH) c = 0;
        kpart2[j] = (KIND == 1) && c >= 8;
        ksrc[j] = kpart2[j] ? kk * 32 + (c - 8) * 8 : kk * LDK + c * 8;
        ksrb[j] = kpart2[j] ? 32 : LDK;
    }
    int vsrc[VPIECES];
#pragma unroll
    for (int j = 0; j < VPIECES; ++j) { const int p = (j * 8 + w) * 1024 + lane * 16, dv = p >> 7, pc = (p & 127) >> 4, c = pc ^ ((dv >> 1) & 7); vsrc[j] = dv * NKEY + c * 8; }
    const int rs = (r & ~12) | ((r & 4) << 1) | ((r & 8) >> 1);
    const int krow0 = rs * KROWB, krow1 = (32 + rs) * KROWB;
    const int ksw0 = KROWB == 128 ? ((rs >> 1) & 7) : (rs & 15), ksw1 = KROWB == 128 ? (((32 + rs) >> 1) & 7) : ((32 + rs) & 15);
    const int vsw = (r >> 1) & 7;
    float lam = 0.f;
    if (KIND == 2) { const float a = wave_sum(P.lamp[lane] * P.lamp[64 + lane]), b2 = wave_sum(P.lamp[128 + lane] * P.lamp[192 + lane]); lam = expf(a) - expf(b2) + P.lambda_init; }

#define ATT_DECL(X) int X##b = 0, X##hd = 0, X##qb = 0, X##qi = 0, X##wlo = 0, X##nwin = 0, X##nt = 0, X##ocol = 0, X##qcol = 0, X##kcol = 0, X##hv = 0, X##cmap = 0, X##qrow = 0, X##lat = 0
#define ATT_COPY(D_, S_) do { D_##b = S_##b; D_##hd = S_##hd; D_##qb = S_##qb; D_##qi = S_##qi; D_##wlo = S_##wlo; D_##nwin = S_##nwin; D_##nt = S_##nt; D_##ocol = S_##ocol; D_##qcol = S_##qcol; D_##kcol = S_##kcol; D_##hv = S_##hv; D_##cmap = S_##cmap; D_##qrow = S_##qrow; D_##lat = S_##lat; } while (0)
#define ATT_DECODE(U_, X) do { X##lat = (U_) < 2048; const int V_ = X##lat ? (U_) : (U_) - 2048; X##wlo = 0; X##nwin = 0; X##cmap = 0; int q0_; \
        if (KIND == 0) { \
            if (X##lat) { X##b = V_ >> 8; X##hd = (V_ >> 6) & 3; X##qb = V_ & 63; const int whi = X##qb + 2 > 63 ? 63 : X##qb + 2; X##wlo = X##qb - 2 < 0 ? 0 : X##qb - 2; X##nwin = whi - X##wlo + 1; } \
            else { X##b = V_ >> 4; X##hd = (V_ >> 2) & 3; X##qb = V_ & 3; } \
            q0_ = X##qb * 64; X##qi = q0_ + 32 * (w & 1) + r; const int hq = X##hd * 4 + (w >> 1); X##qcol = hq * 64; X##ocol = hq * 64; X##kcol = X##hd * 64; X##hv = X##hd; X##nt = X##nwin + 4; \
        } else if (KIND == 1) { \
            if (X##lat) { X##b = V_ >> 8; X##hd = (V_ >> 4) & 15; X##qb = V_ & 15; X##nt = 68; } else { X##b = V_ >> 4; X##hd = V_ & 15; X##qb = 0; X##nt = 4; } \
            q0_ = X##qb * 256; X##qi = q0_ + 32 * w + r; X##qcol = X##hd * 96; X##ocol = X##hd * 64; X##kcol = X##hd * 64; X##hv = X##hd; \
        } else { \
            if (X##lat) { X##b = V_ >> 8; X##hd = (V_ >> 5) & 7; X##qb = V_ & 31; X##nt = 68; } else { X##b = V_ >> 4; X##hd = (V_ >> 1) & 7; X##qb = V_ & 1; X##nt = 4; } \
            q0_ = X##qb * 128; X##qi = q0_ + 32 * (w & 3) + r; X##cmap = (w >> 2) * 8; X##qcol = (X##hd * 2 + (w >> 2)) * 64; X##ocol = X##hd * 128; X##kcol = X##hd * 128; X##hv = X##hd; \
        } \
        X##qrow = X##lat ? X##b * S + X##qi : TL + X##b * L + X##qi; } while (0)
#define ATT_TILE_KT(X, tt) ((KIND == 0) ? ((tt) < X##nwin ? X##wlo + (tt) : 64 + (tt) - X##nwin) : (X##lat ? (tt) : 64 + (tt)))
#define ATT_ISSUE(X, tt, buf_) do { const int kt_ = ATT_TILE_KT(X, tt); const int rb_ = kt_ < 64 ? X##b * S + 64 * kt_ : TL + X##b * L + 64 * (kt_ - 64); \
        const bf16_t* K1u_ = P.K1 + X##kcol; const bf16_t* VTu_ = P.VT + (size_t)(X##b * HV + X##hv) * DV * NKEY; \
        _Pragma("unroll") for (int j = 0; j < KPIECES; ++j) __builtin_amdgcn_global_load_lds((const unsigned*)((kpart2[j] ? P.K2 : K1u_) + (size_t)rb_ * ksrb[j] + ksrc[j]), (LAS unsigned*)(lds + KB0 + (buf_) * BUFSTEP + (j * 8 + w) * 1024), 16, 0, 0); \
        _Pragma("unroll") for (int j = 0; j < VPIECES; ++j) __builtin_amdgcn_global_load_lds((const unsigned*)(VTu_ + 64 * kt_ + vsrc[j]), (LAS unsigned*)(lds + VB0 + (buf_) * BUFSTEP + (j * 8 + w) * 1024), 16, 0, 0); } while (0)
#define ATT_QLOAD(dst, X) do { _Pragma("unroll") for (int st = 0; st < NST; ++st) dst[st] = *(const bf16x8*)(P.Q + (size_t)X##qrow * LDQ + X##qcol + 16 * st + 8 * hh); } while (0)
#define ATT_VFRAG(d, sub, sp) (*(const LAS bf16x8*)(vb + (32 * (d) + r) * 128 + 16 * ((4 * (sub) + 2 * (sp) + hh) ^ vsw)))
#define ATT_QX(SV, sp, lo, hi) do { _Pragma("unroll") for (int i_ = (lo); i_ < (hi); i_ += 2) { f32x2 t_; t_.x = __builtin_amdgcn_exp2f(SV[8 * (sp) + i_]); t_.y = __builtin_amdgcn_exp2f(SV[8 * (sp) + i_ + 1]); SV[8 * (sp) + i_] = t_.x; SV[8 * (sp) + i_ + 1] = t_.y; psv += t_; } } while (0)
#define ATT_QC(SV, sub, sp) do { u32x4 a_; a_.x = cvt_pk_bf16(SV[8 * (sp) + 0], SV[8 * (sp) + 1]); a_.y = cvt_pk_bf16(SV[8 * (sp) + 2], SV[8 * (sp) + 3]); a_.z = cvt_pk_bf16(SV[8 * (sp) + 4], SV[8 * (sp) + 5]); a_.w = cvt_pk_bf16(SV[8 * (sp) + 6], SV[8 * (sp) + 7]); pf[sub][sp] = __builtin_bit_cast(bf16x8, a_); } while (0)
#define ATT_TILE(tt, ISLAST) do { \
            const int buf = ((tt) + pb) & 1; \
            ATT_DECL(nx); if (ISLAST) { const int Un_ = U + G < NU ? U + G : U; ATT_DECODE(Un_, nx); ATT_ISSUE(nx, 0, buf ^ 1); } else { ATT_ISSUE(cu, (tt) + 1, buf ^ 1); } \
            const LAS unsigned char* kb = lds + KB0 + buf * BUFSTEP; const LAS unsigned char* vb = lds + VB0 + buf * BUFSTEP; \
            const float negm = -m; \
            f32x16 s0, s1; \
            _Pragma("unroll") for (int i = 0; i < 16; ++i) { s0[i] = negm; s1[i] = negm; } \
            { bf16x8 kf[NST][2]; \
              _Pragma("unroll") for (int st = 0; st < NST; ++st) { const int c = 2 * st + hh + cucmap; \
                  kf[st][0] = *(const LAS bf16x8*)(kb + krow0 + 16 * (c ^ ksw0)); kf[st][1] = *(const LAS bf16x8*)(kb + krow1 + 16 * (c ^ ksw1)); } \
              __builtin_amdgcn_sched_barrier(0); \
              __builtin_amdgcn_s_setprio(1); \
              _Pragma("unroll") for (int st = 0; st < NST; ++st) { s0 = MFMA32(kf[st][0], qf[st], s0); s1 = MFMA32(kf[st][1], qf[st], s1); } \
              __builtin_amdgcn_s_setprio(0); } \
            if (ISLAST) { __builtin_amdgcn_sched_barrier(0); ATT_QLOAD(qf, nx); }        \
            constexpr int NDVP = NDV < 2 ? NDV : 2; \
            bf16x8 vf[NDVP][2][2]; bf16x8 vq[2][4]; \
            if (NDV == 4) { _Pragma("unroll") for (int q = 0; q < 2; ++q) _Pragma("unroll") for (int d = 0; d < 4; ++d) vq[q][d] = ATT_VFRAG(d, 0, q); } \
            else { _Pragma("unroll") for (int d = 0; d < NDVP; ++d) _Pragma("unroll") for (int sub = 0; sub < 2; ++sub) _Pragma("unroll") for (int sp = 0; sp < 2; ++sp) vf[d][sub][sp] = ATT_VFRAG(d, sub, sp); } \
            __builtin_amdgcn_sched_barrier(0); \
            if (KIND == 0) { const int kt = ATT_TILE_KT(cu, tt); \
                if (kt < 64 && (kt == cuqb - 2 || kt == cuqb + 2)) { const int d0 = 64 * kt + 8 * hh - cuqi; \
                    _Pragma("unroll") for (int i = 0; i < 16; ++i) { const int da = d0 + (i & 7) + 16 * (i >> 3), db = da + 32; \
                        if (da < -128 || da > 128) s0[i] = -INFINITY; if (db < -128 || db > 128) s1[i] = -INFINITY; } } } \
            float mx = max32(s0, s1); \
            mx = xor32_max(mx); \
            const bool first = (KIND != 0) && (tt) == 0; \
            if (first || __any(mx > ATT_THR)) { \
                const float d = first ? mx : fmaxf(mx, 0.f), alpha = first ? 1.f : __builtin_amdgcn_exp2f(-d); \
                m += d; lsum *= alpha; \
                _Pragma("unroll") for (int dd = 0; dd < NDV; ++dd) o[dd] = o[dd] * alpha; \
                _Pragma("unroll") for (int i = 0; i < 16; ++i) { s0[i] -= d; s1[i] -= d; } } \
            f32x2 psv; psv.x = 0.f; psv.y = 0.f; \
            bf16x8 pf[2][2]; \
            ATT_QX(s0, 0, 0, 8); ATT_QC(s0, 0, 0); \
            __builtin_amdgcn_sched_barrier(0); \
            if (NDV == 4) { \
                  \
                o[0] = MFMA32(vq[0][0], pf[0][0], o[0]); o[1] = MFMA32(vq[0][1], pf[0][0], o[1]); __builtin_amdgcn_sched_barrier(0); ATT_QX(s0, 1, 0, 4); __builtin_amdgcn_sched_barrier(0); \
                o[2] = MFMA32(vq[0][2], pf[0][0], o[2]); o[3] = MFMA32(vq[0][3], pf[0][0], o[3]); __builtin_amdgcn_sched_barrier(0); ATT_QX(s0, 1, 4, 8); ATT_QC(s0, 0, 1); __builtin_amdgcn_sched_barrier(0); \
                _Pragma("unroll") for (int d = 0; d < 4; ++d) vq[0][d] = ATT_VFRAG(d, 1, 0); \
                __builtin_amdgcn_sched_barrier(0); \
                o[0] = MFMA32(vq[1][0], pf[0][1], o[0]); o[1] = MFMA32(vq[1][1], pf[0][1], o[1]); __builtin_amdgcn_sched_barrier(0); ATT_QX(s1, 0, 0, 4); __builtin_amdgcn_sched_barrier(0); \
                o[2] = MFMA32(vq[1][2], pf[0][1], o[2]); o[3] = MFMA32(vq[1][3], pf[0][1], o[3]); __builtin_amdgcn_sched_barrier(0); ATT_QX(s1, 0, 4, 8); ATT_QC(s1, 1, 0); __builtin_amdgcn_sched_barrier(0); \
                _Pragma("unroll") for (int d = 0; d < 4; ++d) vq[1][d] = ATT_VFRAG(d, 1, 1); \
                __builtin_amdgcn_sched_barrier(0); \
                o[0] = MFMA32(vq[0][0], pf[1][0], o[0]); o[1] = MFMA32(vq[0][1], pf[1][0], o[1]); __builtin_amdgcn_sched_barrier(0); ATT_QX(s1, 1, 0, 4); __builtin_amdgcn_sched_barrier(0); \
                o[2] = MFMA32(vq[0][2], pf[1][0], o[2]); o[3] = MFMA32(vq[0][3], pf[1][0], o[3]); __builtin_amdgcn_sched_barrier(0); ATT_QX(s1, 1, 4, 8); ATT_QC(s1, 1, 1); __builtin_amdgcn_sched_barrier(0); \
                o[0] = MFMA32(vq[1][0], pf[1][1], o[0]); o[1] = MFMA32(vq[1][1], pf[1][1], o[1]); o[2] = MFMA32(vq[1][2], pf[1][1], o[2]); o[3] = MFMA32(vq[1][3], pf[1][1], o[3]); \
            } else { \
                o[0] = MFMA32(vf[0][0][0], pf[0][0], o[0]); __builtin_amdgcn_sched_barrier(0); ATT_QX(s0, 1, 0, 4); __builtin_amdgcn_sched_barrier(0); \
                o[1] = MFMA32(vf[1][0][0], pf[0][0], o[1]); __builtin_amdgcn_sched_barrier(0); ATT_QX(s0, 1, 4, 8); ATT_QC(s0, 0, 1); __builtin_amdgcn_sched_barrier(0); \
                o[0] = MFMA32(vf[0][0][1], pf[0][1], o[0]); __builtin_amdgcn_sched_barrier(0); ATT_QX(s1, 0, 0, 4); __builtin_amdgcn_sched_barrier(0); \
                o[1] = MFMA32(vf[1][0][1], pf[0][1], o[1]); __builtin_amdgcn_sched_barrier(0); ATT_QX(s1, 0, 4, 8); ATT_QC(s1, 1, 0); __builtin_amdgcn_sched_barrier(0); \
                o[0] = MFMA32(vf[0][1][0], pf[1][0], o[0]); __builtin_amdgcn_sched_barrier(0); ATT_QX(s1, 1, 0, 4); __builtin_amdgcn_sched_barrier(0); \
                o[1] = MFMA32(vf[1][1][0], pf[1][0], o[1]); __builtin_amdgcn_sched_barrier(0); ATT_QX(s1, 1, 4, 8); ATT_QC(s1, 1, 1); __builtin_amdgcn_sched_barrier(0); \
                o[0] = MFMA32(vf[0][1][1], pf[1][1], o[0]); o[1] = MFMA32(vf[1][1][1], pf[1][1], o[1]); \
            } \
            lsum += psv.x + psv.y; \
            __syncthreads(); } while (0)

    int pb = 0;
    bf16x8 qf[NST];
    if (cid < NU) { ATT_DECL(cu); ATT_DECODE(cid, cu); ATT_QLOAD(qf, cu); ATT_ISSUE(cu, 0, 0); __syncthreads(); }
    for (int U = cid; U < NU; U += G) {
        ATT_DECL(cu); ATT_DECODE(U, cu);
        const int nt = cunt, qrow = cuqrow, ocol = cuocol;
        float m = 0.f, lsum = 0.f;
        if (KIND == 0) { m = P.sink[cuhd * 4 + (w >> 1)] * LOG2E; lsum = hh == 0 ? 1.f : 0.f; }
        f32x16 o[NDV];
#pragma unroll
        for (int d = 0; d < NDV; ++d)
#pragma unroll
            for (int i = 0; i < 16; ++i) o[d][i] = 0.f;
        for (int tt = 0; tt < nt - 1; ++tt) ATT_TILE(tt, 0);
        ATT_TILE(nt - 1, 1);
        pb = (nt + pb) & 1;
        const float inv = 1.f / (xor32_sum(lsum));
        if (KIND != 2) {
#pragma unroll
            for (int d = 0; d < NDV; ++d)
#pragma unroll
                for (int g4 = 0; g4 < 4; ++g4) {
                    u32x2 wv; wv.x = cvt_pk_bf16(o[d][4 * g4] * inv, o[d][4 * g4 + 1] * inv); wv.y = cvt_pk_bf16(o[d][4 * g4 + 2] * inv, o[d][4 * g4 + 3] * inv);
                    *(u32x2*)(P.O + (size_t)qrow * 1024 + ocol + 32 * d + 8 * g4 + 4 * hh) = wv;
                }
        } else {
            LAS float* scr = (LAS float*)(lds + SCR) + (size_t)(w & 3) * 64 * 64 + lane;
            if (w >= 4) {
#pragma unroll
                for (int d = 0; d < NDV; ++d)
#pragma unroll
                    for (int i = 0; i < 16; ++i) scr[(d * 16 + i) * 64] = o[d][i] * inv;
            }
            __syncthreads();
            if (w < 4) {
                float ss = 0.f;
#pragma unroll
                for (int d = 0; d < NDV; ++d)
#pragma unroll
                    for (int i = 0; i < 16; ++i) { const float v = o[d][i] * inv - lam * scr[(d * 16 + i) * 64]; o[d][i] = v; ss += v * v; }
                ss = xor32_sum(ss);
                const float rsn = (1.f - P.lambda_init) / sqrtf(ss * (1.f / 128.f) + RMS_EPS);
#pragma unroll
                for (int d = 0; d < NDV; ++d)
#pragma unroll
                    for (int g4 = 0; g4 < 4; ++g4) {
                        const int dv0 = 32 * d + 8 * g4 + 4 * hh; const f32x4 gv = *(const f32x4*)(P.subln + dv0);
                        u32x2 wv; wv.x = cvt_pk_bf16(o[d][4 * g4] * rsn * gv[0], o[d][4 * g4 + 1] * rsn * gv[1]); wv.y = cvt_pk_bf16(o[d][4 * g4 + 2] * rsn * gv[2], o[d][4 * g4 + 3] * rsn * gv[3]);
                        *(u32x2*)(P.O + (size_t)qrow * 1024 + ocol + dv0) = wv;
                    }
            }
        }
    }
#undef ATT_DECL
#undef ATT_COPY
#undef ATT_DECODE
#undef ATT_TILE_KT
#undef ATT_ISSUE
#undef ATT_QLOAD
#undef ATT_TILE
}
}
namespace thin {
__device__ __forceinline__ int sig64(int p) { return (p >> 5) * 32 + ((p & 31) >> 1) + 16 * (p & 1); }
__device__ __forceinline__ int sig32(int p) { return (p >> 4) * 16 + ((p & 15) >> 1) + 8 * (p & 1); }
__device__ __forceinline__ int src_col(int mode, int lim, int n, bool& second) {
    second = false;
    switch (mode) {
        case 1: return n < lim ? (n & ~63) + sig64(n & 63) : n;
        case 2: return n < 768 ? n : (n < 800 ? 768 + sig32(n - 768) : -1);
        case 3: { const int hq = n / 96, w = n % 96; return w < 64 ? n : hq * 96 + 64 + sig32(w - 64); }
        case 4: return n < 1024 ? (n >> 6) * 128 + (n & 63) : ((n - 1024) >> 6) * 128 + 64 + (n & 63);
        case 5: second = (n & 7) >= 4; return 4 * (n >> 3) + (n & 3);
        default: return n;
    }
}
__device__ __forceinline__ void conv_item(const float* src, const float* src2, const float* gain, int Nsrc, int K, int N, int mode, int lim, bf16_t* WT, int item, LAS float* scr, int lane) {
    const int nblk = N >> 6, kb = item / nblk, nb = item % nblk, k0 = kb * 64, n0 = nb * 64;
    bool second; const int col = src_col(mode, lim, n0 + lane, second);
    const float* sp = (second ? src2 : src) + (col < 0 ? 0 : col);
    float vv[64];
#pragma unroll
    for (int kk = 0; kk < 64; ++kk) vv[kk] = col < 0 ? 0.f : __builtin_nontemporal_load(sp + (size_t)(k0 + kk) * Nsrc);
    if (gain) {
#pragma unroll
        for (int kk = 0; kk < 64; ++kk) vv[kk] *= gain[k0 + kk];
    }
#pragma unroll
    for (int kk = 0; kk < 64; ++kk) scr[kk * 65 + lane] = vv[kk];
    asm volatile("s_waitcnt lgkmcnt(0)" ::: "memory");
    const int c = lane & 7;
#pragma unroll
    for (int j = 0; j < 8; ++j) { const int n = (lane >> 3) + 8 * j; const LAS float* s = scr + (8 * c) * 65 + n;
        u32x4 o; o.x = cvt_pk_bf16(s[0 * 65], s[1 * 65]); o.y = cvt_pk_bf16(s[2 * 65], s[3 * 65]); o.z = cvt_pk_bf16(s[4 * 65], s[5 * 65]); o.w = cvt_pk_bf16(s[6 * 65], s[7 * 65]);
        __builtin_nontemporal_store(o, (u32x4*)(WT + (size_t)(n0 + n) * K + k0 + 8 * c)); }
    asm volatile("s_waitcnt lgkmcnt(0)" ::: "memory");
}
constexpr int MOE_ITEMS = NE * 256 + NE * 128;
__device__ __forceinline__ void moe_fill(LAS unsigned char* lds, const float* w_gate, const float* w_up, const float* w_down, unsigned char* ws, int layer, int max_items, int* qctr) {
    int tid_ = threadIdx.x; asm volatile("" : "+v"(tid_));
    const int lane = tid_ & 63, w = __builtin_amdgcn_readfirstlane(tid_ >> 6);
    LAS float* scr = (LAS float*)lds + w * (64 * 65);
    for (int n = 0; n < max_items; ++n) {
        int it = 0; if (lane == 0) it = atomicAdd(qctr, 1);
        it = __builtin_amdgcn_readfirstlane(it);
        if (it >= MOE_ITEMS) break;
        if (it < NE * 256) { const int mi = layer * NE + (it >> 8), ii = it & 255;
            conv_item(w_gate + (size_t)mi * 1024 * 512, w_up + (size_t)mi * 1024 * 512, nullptr, 512, 1024, 1024, 5, 0, (bf16_t*)(ws + WS_WGU) + (size_t)mi * 1024 * 1024, ii, scr, lane); }
        else { const int r = it - NE * 256, mi = layer * NE + (r >> 7), ii = r & 127;
            conv_item(w_down + (size_t)mi * 512 * 1024, nullptr, nullptr, 1024, 512, 1024, 0, 0, (bf16_t*)(ws + WS_WD) + (size_t)mi * 1024 * 512, ii, scr, lane); }
    }
}
struct ProIn {
    const float *c, *c_ctx, *ada_w, *ada_b, *win_w_in, *win_w_out, *mla_w_in, *mla_q_norm, *mla_kv_norm, *mla_w_uq, *mla_w_ukv, *mla_w_out, *dif_w_in, *dif_w_out,
                *moe_w_grp, *moe_w_rt, *moe_w_gate, *moe_w_up, *moe_w_down;
    unsigned char* ws;
};
__device__ __forceinline__ void prologue(LAS unsigned char* lds, const ProIn& I, int G, int cid) {
    const int tid = threadIdx.x, lane = tid & 63, w = __builtin_amdgcn_readfirstlane(tid >> 6);
    unsigned char* ws = I.ws;
    {
        LAS float* scr = (LAS float*)lds + w * (64 * 65);
        const int gw = cid * NWAVES + w, NGW = G * NWAVES;
        constexpr int I_AIN = 16 * 24, I_SQ = 16 * 16, I_BUQ = 8 * 24, I_BUKV = 4 * 32, I_CIN = 16 * 48, I_GU = 16 * 16, I_D = 8 * 16;
        constexpr int NSMALL = 2 * I_AIN + 2 * I_SQ + I_SQ + I_BUQ + I_BUKV + I_SQ + I_CIN + I_SQ;
        constexpr int NITEMS = NSMALL + 128 * I_GU + 128 * I_D;
        for (int it = gw; it < NITEMS; it += NGW) {
            int r = it;
            if (r >= NSMALL) {
                r -= NSMALL;
                if (r < 128 * I_GU) { const int mi = r / I_GU, ii = r % I_GU;
                    conv_item(I.moe_w_gate + (size_t)mi * 1024 * 512, I.moe_w_up + (size_t)mi * 1024 * 512, nullptr, 512, 1024, 1024, 5, 0, (bf16_t*)(ws + WS_WGU) + (size_t)mi * 1024 * 1024, ii, scr, lane); }
                else { r -= 128 * I_GU; const int mi = r / I_D, ii = r % I_D;
                    conv_item(I.moe_w_down + (size_t)mi * 512 * 1024, nullptr, nullptr, 1024, 512, 1024, 0, 0, (bf16_t*)(ws + WS_WD) + (size_t)mi * 1024 * 512, ii, scr, lane); }
                continue;
            }
            if (r < 2 * I_AIN) { const int s = r / I_AIN; conv_item(I.win_w_in + (size_t)s * 1024 * 1536, nullptr, nullptr, 1536, 1024, 1536, 1, 1280, (bf16_t*)(ws + W_A_IN) + (size_t)s * 1536 * 1024, r % I_AIN, scr, lane); continue; } r -= 2 * I_AIN;
            if (r < 2 * I_SQ) { const int s = r / I_SQ; conv_item(I.win_w_out + (size_t)s * 1024 * 1024, nullptr, nullptr, 1024, 1024, 1024, 0, 0, (bf16_t*)(ws + W_A_OUT) + (size_t)s * 1024 * 1024, r % I_SQ, scr, lane); continue; } r -= 2 * I_SQ;
            if (r < I_SQ) { conv_item(I.mla_w_in, nullptr, nullptr, 800, 1024, 1024, 2, 0, (bf16_t*)(ws + W_B_IN), r, scr, lane); continue; } r -= I_SQ;
            if (r < I_BUQ) { conv_item(I.mla_w_uq, nullptr, I.mla_q_norm, 1536, 512, 1536, 3, 0, (bf16_t*)(ws + W_B_UQ), r, scr, lane); continue; } r -= I_BUQ;
            if (r < I_BUKV) { conv_item(I.mla_w_ukv, nullptr, I.mla_kv_norm, 2048, 256, 2048, 4, 0, (bf16_t*)(ws + W_B_UKV), r, scr, lane); continue; } r -= I_BUKV;
            if (r < I_SQ) { conv_item(I.mla_w_out, nullptr, nullptr, 1024, 1024, 1024, 0, 0, (bf16_t*)(ws + W_B_OUT), r, scr, lane); continue; } r -= I_SQ;
            if (r < I_CIN) { conv_item(I.dif_w_in, nullptr, nullptr, 3072, 1024, 3072, 1, 2048, (bf16_t*)(ws + W_C_IN), r, scr, lane); continue; } r -= I_CIN;
            conv_item(I.dif_w_out, nullptr, nullptr, 1024, 1024, 1024, 0, 0, (bf16_t*)(ws + W_C_OUT), r, scr, lane);
        }
    }
    __syncthreads();
    {
        LAS float* sc = (LAS float*)lds;
        LAS float* red = sc + 9 * 1024;
        for (int idx = tid; idx < 9 * 1024; idx += NTHREADS) { const int m = idx >> 10, k = idx & 1023; const float v = m < 8 ? I.c[m * 1024 + k] : I.c_ctx[k]; sc[idx] = v / (1.f + expf(-v)); }
        __syncthreads();
        float* mod = (float*)(ws + WS_MOD);
        for (int task = cid; task < DEPTH * 96; task += G) {
            const int layer = task / 96, j = (task % 96) * 64 + lane;
            float acc[9];
#pragma unroll
            for (int m = 0; m < 9; ++m) acc[m] = 0.f;
            const float* wp = I.ada_w + ((size_t)layer * 1024 + w * 128) * 6144 + j;
#pragma unroll 32
            for (int k = 0; k < 128; ++k) { const float wv = wp[(size_t)k * 6144];
#pragma unroll
                for (int m = 0; m < 9; ++m) acc[m] = fmaf(sc[m * 1024 + w * 128 + k], wv, acc[m]); }
#pragma unroll
            for (int m = 0; m < 9; ++m) red[(w * 9 + m) * 64 + lane] = acc[m];
            __syncthreads();
            for (int o = tid; o < 9 * 64; o += NTHREADS) { const int m = o >> 6, jl = o & 63; float s = 0.f;
#pragma unroll
                for (int ww = 0; ww < 8; ++ww) s += red[(ww * 9 + m) * 64 + jl];
                const int jj = (task % 96) * 64 + jl; mod[((size_t)layer * 9 + m) * 6144 + jj] = s + I.ada_b[layer * 6144 + jj]; }
            __syncthreads();
        }
    }
    {
        const int gt = cid * NTHREADS + tid, NGT = G * NTHREADS;
        float2* tab64 = (float2*)(ws + WS_TAB64); float2* tab32 = (float2*)(ws + WS_TAB32);
        for (int t = gt; t < 64 * 16 + 64 * 8; t += NGT) {
            if (t < 1024) { const int pos = t >> 4, j = t & 15; const float inv = (float)pow(10000.0, -(double)(2 * j) / 32.0), ang = (float)pos * inv;
                tab64[t] = make_float2((float)cos((double)ang), (float)sin((double)ang)); }
            else { const int u = t - 1024, pos = u >> 3, j = u & 7; const float inv = (float)pow(10000.0, -(double)(2 * j) / 16.0), ang = (float)pos * inv;
                tab32[u] = make_float2((float)cos((double)ang), (float)sin((double)ang)); }
        }
        bf16_t* rtw = (bf16_t*)(ws + WS_RTW);
        for (int t = gt; t < DEPTH * 64 * 1024; t += NGT) {
            const int layer = t >> 16, n = (t >> 10) & 63, k = t & 1023;
            float v = 0.f;
            if (n < 4) v = I.moe_w_grp[((size_t)layer * 1024 + k) * 4 + n]; else if (n < 36) v = I.moe_w_rt[((size_t)layer * 1024 + k) * 32 + (n - 4)];
            const unsigned hi = f2bf(v); const unsigned lo = f2bf(v - bf2f(hi));
            rtw[((size_t)layer * 2 + 0) * 65536 + n * 1024 + k] = (bf16_t)hi; rtw[((size_t)layer * 2 + 1) * 65536 + n * 1024 + k] = (bf16_t)lo;
        }
    }
}
__device__ __forceinline__ void phase_h0(const float* x, const float* ctx, const float* mod0, bf16_t* H, int G, int cid) {
    const int lane = threadIdx.x & 63, gw = cid * NWAVES + (threadIdx.x >> 6), NGW = G * NWAVES;
    for (int row0 = gw * 2; row0 < T; row0 += NGW * 2) {
        const float* src = row0 < TL ? x + (size_t)row0 * 1024 : ctx + (size_t)(row0 - TL) * 1024; const float* mp = mod0 + (size_t)mrow_of(row0) * 6144;
        f32x4 v[2][4];
#pragma unroll
        for (int rr = 0; rr < 2; ++rr)
#pragma unroll
            for (int i = 0; i < 4; ++i) v[rr][i] = *(const f32x4*)(src + rr * 1024 + i * 256 + lane * 4);
#pragma unroll
        for (int rr = 0; rr < 2; ++rr)
#pragma unroll
            for (int i = 0; i < 4; ++i) { const int c = i * 256 + lane * 4;
                const f32x4 sh = *(const f32x4*)(mp + c), sc = *(const f32x4*)(mp + 1024 + c);
                const f32x4 h = v[rr][i] * (sc + 1.f) + sh; u32x2 wv; wv.x = cvt_pk_bf16(h[0], h[1]); wv.y = cvt_pk_bf16(h[2], h[3]);
                *(u32x2*)(H + (size_t)(row0 + rr) * 1024 + c) = wv; }
    }
}
constexpr int CNT_STRIDE = 64;
struct LnrArgs { const float* Xl; const float* Xc; const bf16_t* Y; float* STATS; bf16_t* H; const float* modl; const float* gam; const float* bet; const bf16_t* rtw; const float* b_grp; const float* b_rt; int* cnt; int* list; float* tokw; int nrows; };
#define LBAR() do { asm volatile("s_waitcnt lgkmcnt(0)" ::: "memory"); __builtin_amdgcn_s_barrier(); asm volatile("" ::: "memory"); } while (0)
template <int VAR = 0, bool XBF = false>
__device__ __forceinline__ void phase_lnr(LAS unsigned char* lds, const LnrArgs A, int G, int cid) {
    asm volatile("" : "+s"(G), "+s"(cid));
    constexpr int TSTR = 2064;
    int tid_ = threadIdx.x; asm volatile("" : "+v"(tid_));
    const int tid = tid_, lane = tid & 63, w = __builtin_amdgcn_readfirstlane(tid >> 6), r = lane & 31, hh = lane >> 5;
    LAS unsigned char* THI = lds; LAS unsigned char* TLO = lds + 32 * TSTR;
    LAS float* PART = (LAS float*)lds;

    LAS int* bcnt = (LAS int*)(lds + 2 * 32 * TSTR);
    LAS int* bbase = bcnt + 32;
    LAS float* bias = (LAS float*)(bbase + 32);
    LAS int* ents = (LAS int*)(bias + 40);
    LAS float* LOG = (LAS float*)(ents + 16 * 64 * 2);
    const int ngroups = A.nrows >> 5;
    const int nfull = (ngroups / G) * G, rem = ngroups - nfull; const bool halves = rem > 0 && 2 * rem <= G;
    const int nitems = halves ? nfull + 2 * rem : ngroups;
#define LNR_ITEM(j, grp_, h_, nr_) const int grp_ = (j) < nfull || !halves ? (j) : nfull + (((j) - nfull) >> 1); const int h_ = (j) < nfull || !halves ? 0 : (((j) - nfull) & 1); const int nr_ = (j) < nfull || !halves ? 32 : 16
    if (tid < 32) bcnt[tid] = 0;
    if (tid < 36) bias[tid] = tid < 4 ? A.b_grp[tid] : A.b_rt[tid - 4];
    f32x4 z[4][4]; u32x2 zr[4][4]; u32x2 yv[4][4];
#define LNR_LOAD(j_) do { LNR_ITEM(j_, g__, h__, n__); \
        _Pragma("unroll") for (int t4 = 0; t4 < 4; ++t4) { const int tl_ = 4 * w + t4; const int row_ = g__ * 32 + h__ * 16 + (tl_ < n__ ? tl_ : tl_ - 16); \
        const float* xs_ = row_ < TL ? A.Xl + (size_t)row_ * 1024 : A.Xc + (size_t)(row_ - TL) * 1024; \
        const bf16_t* xb_ = row_ < TL ? (const bf16_t*)A.Xl + (size_t)row_ * 1024 : (const bf16_t*)A.Xc + (size_t)(row_ - TL) * 1024; \
        _Pragma("unroll") for (int i = 0; i < 4; ++i) { if (XBF) zr[t4][i] = *(const u32x2*)(xb_ + i * 256 + lane * 4); else z[t4][i] = *(const f32x4*)(xs_ + i * 256 + lane * 4); \
            yv[t4][i] = *(const u32x2*)(A.Y + (size_t)row_ * 1024 + i * 256 + lane * 4); } } } while (0)
    if (cid < nitems) LNR_LOAD(cid);
    int gi = 0;
    for (int item = cid; item < nitems; item += G, ++gi) {
        LNR_ITEM(item, grp, hsel, nrow);
        f32x4 pgv[4], pga[4], pbe[4], psc[4], psh[4];
        { const float* mq_ = A.modl + (size_t)mrow_of(grp * 32 + hsel * 16) * 6144;
#pragma unroll
          for (int i = 0; i < 4; ++i) { const int c_ = i * 256 + lane * 4;
              pgv[i] = *(const f32x4*)(mq_ + 2 * 1024 + c_); psc[i] = *(const f32x4*)(mq_ + 4 * 1024 + c_); psh[i] = *(const f32x4*)(mq_ + 3 * 1024 + c_);
              if (XBF) { pga[i] = *(const f32x4*)(A.gam + c_); pbe[i] = *(const f32x4*)(A.bet + c_); } } }
        __builtin_amdgcn_sched_barrier(0);
#pragma unroll
        for (int t4 = 0; t4 < 4; ++t4) {
            const int tl = 4 * w + t4, row = grp * 32 + hsel * 16 + (tl < nrow ? tl : tl - 16); const bool rvalid = tl < nrow; const float* mp = A.modl + (size_t)mrow_of(row) * 6144;
            float s = 0.f, q = 0.f;
            if (XBF) {
#pragma unroll
                for (int i = 0; i < 4; ++i) { const u32x2 xr = zr[t4][i]; z[t4][i][0] = f16lo(xr.x); z[t4][i][1] = f16hi(xr.x); z[t4][i][2] = f16lo(xr.y); z[t4][i][3] = f16hi(xr.y); }
            }
#pragma unroll
            for (int i = 0; i < 4; ++i) { const f32x4 gv = pgv[i]; const u32x2 yb = yv[t4][i];
                f32x4 y; y[0] = bf2f(yb.x & 0xffffu); y[1] = bf2f(yb.x >> 16); y[2] = bf2f(yb.y & 0xffffu); y[3] = bf2f(yb.y >> 16);
                const f32x4 v = z[t4][i] * DN_ALPHA + gv * y; z[t4][i] = v; s += (v[0] + v[1]) + (v[2] + v[3]); q += (v[0] * v[0] + v[1] * v[1]) + (v[2] * v[2] + v[3] * v[3]); }
            wave_sum2(s, q);
            const float mean = s * (1.f / 1024.f); const float var = fmaxf(q * (1.f / 1024.f) - mean * mean, 0.f);
            const float rstd = 1.0f / sqrtf(var + LN_EPS);
            if (lane == 0 && rvalid) *(f32x2*)(A.STATS + (size_t)row * 2) = (f32x2){mean, rstd};
#pragma unroll
            for (int i = 0; i < 4; ++i) { const int c = i * 256 + lane * 4;
                const f32x4 ga_ = XBF ? pga[i] : *(const f32x4*)(A.gam + c), be_ = XBF ? pbe[i] : *(const f32x4*)(A.bet + c);
                const f32x4 xo = (z[t4][i] - mean) * rstd * ga_ + be_;
                const f32x4 h = xo * (psc[i] + 1.f) + psh[i];
                u32x2 hi; hi.x = cvt_pk_bf16(h[0], h[1]); hi.y = cvt_pk_bf16(h[2], h[3]);
                if (rvalid) *(u32x2*)(A.H + (size_t)row * 1024 + c) = hi;
                f32x4 rem; rem[0] = h[0] - bf2f(hi.x & 0xffffu); rem[1] = h[1] - bf2f(hi.x >> 16); rem[2] = h[2] - bf2f(hi.y & 0xffffu); rem[3] = h[3] - bf2f(hi.y >> 16);
                u32x2 lo; lo.x = cvt_pk_bf16(rem[0], rem[1]); lo.y = cvt_pk_bf16(rem[2], rem[3]);
                *(LAS u32x2*)(THI + tl * TSTR + c * 2) = hi; *(LAS u32x2*)(TLO + tl * TSTR + c * 2) = lo; }
        }
        LBAR();
        if (VAR == 1) { if (item + G < nitems) LNR_LOAD(item + G); continue; }
        f32x16 acc, acc2, acc3;
#pragma unroll
        for (int i = 0; i < 16; ++i) { acc[i] = 0.f; acc2[i] = 0.f; acc3[i] = 0.f; }
        { const int ct = w & 1, ks = w >> 1; const bf16_t* bh = A.rtw + (size_t)(ct * 32 + r) * 1024 + ks * 256 + 8 * hh; const bf16_t* bl = bh + 65536;
          bf16x8 wh[16], wl[16];
#pragma unroll
          for (int st = 0; st < 16; ++st) { wh[st] = *(const bf16x8*)(bh + 16 * st); wl[st] = *(const bf16x8*)(bl + 16 * st); }
#pragma unroll
          for (int st = 0; st < 16; ++st) {
              const bf16x8 ah = *(const LAS bf16x8*)(THI + r * TSTR + (ks * 256 + 16 * st + 8 * hh) * 2), al = *(const LAS bf16x8*)(TLO + r * TSTR + (ks * 256 + 16 * st + 8 * hh) * 2);
              acc = MFMA32(ah, wh[st], acc); acc2 = MFMA32(ah, wl[st], acc2); acc3 = MFMA32(al, wh[st], acc3);
          }
          acc = acc + acc2 + acc3; }
        if (item + G < nitems) LNR_LOAD(item + G);
        LBAR();
#pragma unroll
        for (int i = 0; i < 16; ++i) PART[(w * 32 + (i & 3) + 8 * (i >> 2) + 4 * hh) * 33 + r] = acc[i];
        LBAR();
        for (int o = tid; o < 32 * 36; o += NTHREADS) { const int tk = o / 36, n = o % 36, ct = n >> 5, nl = n & 31;
            float s = 0.f;
#pragma unroll
            for (int ks = 0; ks < 4; ++ks) s += PART[((ks * 2 + ct) * 32 + tk) * 33 + nl];
            LOG[tk * 40 + n] = s + bias[n]; }
        LBAR();
        if (VAR != 2 && tid < nrow) {
            const LAS float* lg = LOG + tid * 40; const int row = grp * 32 + hsel * 16 + tid;
            const float g0 = lg[0], g1 = lg[1], g2 = lg[2], g3 = lg[3];
            int gs = 0; float gm = g0;
            if (g1 > gm) { gm = g1; gs = 1; } if (g2 > gm) { gm = g2; gs = 2; } if (g3 > gm) { gm = g3; gs = 3; }
            const float pg = 1.f / (expf(g0 - gm) + expf(g1 - gm) + expf(g2 - gm) + expf(g3 - gm));
            int i1 = 0; float v1 = lg[4 + gs * 8];
            for (int j = 1; j < 8; ++j) { const float v = lg[4 + gs * 8 + j]; if (v > v1) { v1 = v; i1 = j; } }
            int i2 = -1; float v2 = -INFINITY;
            for (int j = 0; j < 8; ++j) { const float v = lg[4 + gs * 8 + j]; if (j != i1 && v > v2) { v2 = v; i2 = j; } }
            const int ea = gs * 8 + i1, eb = gs * 8 + i2;
            const int ra = __hip_atomic_fetch_add(bcnt + ea, 1, __ATOMIC_RELAXED, __HIP_MEMORY_SCOPE_WORKGROUP), rb = __hip_atomic_fetch_add(bcnt + eb, 1, __ATOMIC_RELAXED, __HIP_MEMORY_SCOPE_WORKGROUP);
            const float e2 = expf(v2 - v1), w1 = pg / (1.f + e2), w2 = pg * e2 / (1.f + e2);
            *(f32x2*)(A.tokw + (size_t)row * 2) = (f32x2){w1, w2};
            LAS int* ep = ents + (gi * 64 + tid * 2) * 2;
            ep[0] = (ea << 16) | ra; ep[1] = row * 2; ep[2] = (eb << 16) | rb; ep[3] = row * 2 + 1;
        } else if (VAR != 2 && tid < 32) {
            LAS int* ep = ents + (gi * 64 + tid * 2) * 2; ep[0] = -1; ep[2] = -1;
        }
    }
#undef LNR_LOAD
#undef LNR_ITEM
    if (tid < 32) { const int n = bcnt[tid]; bbase[tid] = n ? atomicAdd(&A.cnt[tid * CNT_STRIDE], n) : 0; }
    __syncthreads();
    if (VAR == 0) for (int i = tid; i < gi * 64; i += NTHREADS) { const int key = ents[2 * i], val = ents[2 * i + 1], e = key >> 16; if (key >= 0) A.list[(size_t)e * T + bbase[e] + (key & 0xffff)] = val; }
    __syncthreads();
}
struct LnfArgs { const float* Xl; const float* Xc; const bf16_t* Y; const float* STATS; const bf16_t* Y2; const float* modl; const float* gam1; const float* bet1; const float* gam; const float* bet; float* Xout; bf16_t* H; const float* modn; int nrows; };
template <bool XINBF = false, bool XOUTBF = false>
__device__ __forceinline__ void phase_lnf(const LnfArgs A, int G, int cid) {
    asm volatile("" : "+s"(G), "+s"(cid));
    int tid_ = threadIdx.x; asm volatile("" : "+v"(tid_));
    const int lane = tid_ & 63, gw = cid * NWAVES + (tid_ >> 6), NGW = G * NWAVES;
#define LNF_DECL(S) f32x4 S##z[2][4]; u32x2 S##zr[2][4], S##yv[2][4], S##ya[2][4], S##yb[2][4]; f32x2 S##st[2]
#define LNF_LOAD(S, R0) do { const int r0_ = (R0); \
        const float* xs = r0_ < TL ? A.Xl + (size_t)r0_ * 1024 : A.Xc + (size_t)(r0_ - TL) * 1024; \
        const bf16_t* xb = r0_ < TL ? (const bf16_t*)A.Xl + (size_t)r0_ * 1024 : (const bf16_t*)A.Xc + (size_t)(r0_ - TL) * 1024; \
        _Pragma("unroll") for (int rr = 0; rr < 2; ++rr) { \
            S##st[rr] = *(const f32x2*)(A.STATS + (size_t)(r0_ + rr) * 2); \
            _Pragma("unroll") for (int i = 0; i < 4; ++i) { const int c = i * 256 + lane * 4; const size_t row = (size_t)(r0_ + rr); \
                if (XINBF) S##zr[rr][i] = *(const u32x2*)(xb + rr * 1024 + c); else S##z[rr][i] = *(const f32x4*)(xs + rr * 1024 + c); \
                S##yv[rr][i] = *(const u32x2*)(A.Y + row * 1024 + c); \
                S##ya[rr][i] = *(const u32x2*)(A.Y2 + row * 2048 + c); S##yb[rr][i] = *(const u32x2*)(A.Y2 + row * 2048 + 1024 + c); } } } while (0)
#define LNF_COMPUTE(S, R0) do { const int r0_ = (R0); \
        const int mr = mrow_of(r0_); const float* gm = A.modl + (size_t)mr * 6144 + 2 * 1024; const float* gf = A.modl + (size_t)mr * 6144 + 5 * 1024;        \
          \
        f32x4 pg1[4], pg2[4], pa1[4], pb1[4], pa[4], pb[4], psc[4], psh[4]; \
        _Pragma("unroll") for (int i = 0; i < 4; ++i) { const int c = i * 256 + lane * 4; \
            pg1[i] = *(const f32x4*)(gm + c); pg2[i] = *(const f32x4*)(gf + c); pa1[i] = *(const f32x4*)(A.gam1 + c); pb1[i] = *(const f32x4*)(A.bet1 + c); \
            pa[i] = *(const f32x4*)(A.gam + c); pb[i] = *(const f32x4*)(A.bet + c); \
            if (XINBF && A.H) { const float* mp = A.modn + (size_t)mr * 6144; psc[i] = *(const f32x4*)(mp + 1024 + c); psh[i] = *(const f32x4*)(mp + c); } } \
        __builtin_amdgcn_sched_barrier(0); \
        _Pragma("unroll") for (int rr = 0; rr < 2; ++rr) { \
            const size_t row = (size_t)(r0_ + rr); \
            f32x4 zz[4]; float s = 0.f, q = 0.f; \
            _Pragma("unroll") for (int i = 0; i < 4; ++i) { \
                const u32x2 y1 = S##yv[rr][i], a = S##ya[rr][i], b = S##yb[rr][i]; \
                f32x4 xin; if (XINBF) { const u32x2 xr = S##zr[rr][i]; xin[0] = f16lo(xr.x); xin[1] = f16hi(xr.x); xin[2] = f16lo(xr.y); xin[3] = f16hi(xr.y); } else xin = S##z[rr][i]; \
                f32x4 ym; ym[0] = bf2f(y1.x & 0xffffu); ym[1] = bf2f(y1.x >> 16); ym[2] = bf2f(y1.y & 0xffffu); ym[3] = bf2f(y1.y >> 16); \
                const f32x4 x1 = ((xin * DN_ALPHA + pg1[i] * ym) - S##st[rr][0]) * S##st[rr][1] * pa1[i] + pb1[i]; \
                f32x4 y; y[0] = bf2f(a.x & 0xffffu) + bf2f(b.x & 0xffffu); y[1] = bf2f(a.x >> 16) + bf2f(b.x >> 16); y[2] = bf2f(a.y & 0xffffu) + bf2f(b.y & 0xffffu); y[3] = bf2f(a.y >> 16) + bf2f(b.y >> 16); \
                const f32x4 v = x1 * DN_ALPHA + pg2[i] * y; zz[i] = v; s += (v[0] + v[1]) + (v[2] + v[3]); q += (v[0] * v[0] + v[1] * v[1]) + (v[2] * v[2] + v[3] * v[3]); } \
            wave_sum2(s, q); \
            const float mean = s * (1.f / 1024.f); const float var = fmaxf(q * (1.f / 1024.f) - mean * mean, 0.f); \
            const float rstd = 1.0f / sqrtf(var + LN_EPS); \
            _Pragma("unroll") for (int i = 0; i < 4; ++i) { const int c = i * 256 + lane * 4; \
                const f32x4 xo = (zz[i] - mean) * rstd * pa[i] + pb[i]; \
                if (XOUTBF) { u32x2 xw; xw.x = pack_f16(xo[0], xo[1]); xw.y = pack_f16(xo[2], xo[3]); *(u32x2*)((bf16_t*)A.Xout + row * 1024 + c) = xw; } \
                else *(f32x4*)(A.Xout + row * 1024 + c) = xo; \
                if (A.H) { const float* mp = A.modn + (size_t)mr * 6144; const f32x4 sc_ = XINBF ? psc[i] : *(const f32x4*)(mp + 1024 + c), sh_ = XINBF ? psh[i] : *(const f32x4*)(mp + c);        \
                    const f32x4 h = xo * (sc_ + 1.f) + sh_; \
                    u32x2 wv; wv.x = cvt_pk_bf16(h[0], h[1]); wv.y = cvt_pk_bf16(h[2], h[3]); *(u32x2*)(A.H + row * 1024 + c) = wv; } } } } while (0)
    const int stride = NGW * 2;
    LNF_DECL(c_);
    for (int row0 = gw * 2; row0 < A.nrows; row0 += stride) { LNF_LOAD(c_, row0); LNF_COMPUTE(c_, row0); }
}
#undef LNF_DECL
#undef LNF_LOAD
#undef LNF_COMPUTE
}
#ifndef PH_MASK
#define PH_MASK 0xFFFF
#endif
#define PH_EN(k) ((PH_MASK >> (k)) & 1)
#ifndef PH_REPM
#define PH_REPM 0
#endif
#define NREP(k) (((PH_REPM >> (k)) & 1) ? 2 : 1)
#ifndef ATT_PIPE_A
#define ATT_PIPE_A false
#endif
#ifndef ATT_PIPE_B
#define ATT_PIPE_B false
#endif
#ifndef ATT_PIPE_C
#define ATT_PIPE_C false
#endif
#ifndef ONE_LAUNCH
#define ONE_LAUNCH 1
#endif
constexpr int NPH = 2 + 8 * DEPTH;
struct Params { const float* in[30]; float* out; unsigned char* ws; int ph_lo, ph_hi; };

__global__ void __launch_bounds__(NTHREADS, 2) k_run(Params p) {
    extern __shared__ __attribute__((aligned(16))) unsigned char lds_raw[];
    LAS unsigned char* lds = (LAS unsigned char*)lds_raw;
    volatile LAS unsigned* MISC = (volatile LAS unsigned*)(lds + MISC_OFF);
    const int G = gridDim.x;
    const int cid = (G % 8 == 0) ? ((int)blockIdx.x % 8) * (G / 8) + (int)blockIdx.x / 8 : (int)blockIdx.x;
    typedef const __attribute__((address_space(4))) Params* KP;
    KP pp = (KP)__builtin_amdgcn_kernarg_segment_ptr();
    unsigned char* ws = p.ws;
    for (int u = threadIdx.x; u < 256; u += NTHREADS) MISC[u] = 0u;
    __syncthreads();
    const int lo = p.ph_lo, hi = p.ph_hi;
    XcdBarrier bar; bar.bar = (unsigned*)(ws + WS_CTL) + CW_BAR; bar.x = 0; bar.st = nullptr;
    if (hi - lo > 1) bar = xcd_barrier_post((unsigned*)(ws + WS_CTL) + CW_BAR, MISC + 8);
#define IN(k) (lo <= (k) && (k) < hi)
#define SEAM(k) do { if (IN(k) && IN((k) + 1)) { xcd_barrier(bar); if (NREP(15) == 2) xcd_barrier(bar); } } while (0)

    if (PH_EN(0) && IN(0)) {
        thin::ProIn I; I.c = p.in[1]; I.c_ctx = p.in[3]; I.ada_w = p.in[4]; I.ada_b = p.in[5]; I.win_w_in = p.in[10]; I.win_w_out = p.in[11];
        I.mla_w_in = p.in[13]; I.mla_q_norm = p.in[14]; I.mla_kv_norm = p.in[15]; I.mla_w_uq = p.in[16]; I.mla_w_ukv = p.in[17]; I.mla_w_out = p.in[18];
        I.dif_w_in = p.in[19]; I.dif_w_out = p.in[22]; I.moe_w_grp = p.in[23]; I.moe_w_rt = p.in[25]; I.moe_w_gate = p.in[27]; I.moe_w_up = p.in[28]; I.moe_w_down = p.in[29]; I.ws = ws;
        for (int rep = 0; rep < NREP(0); ++rep) { thin::prologue(lds, I, G, cid); __syncthreads(); }
    }
    SEAM(0);
    if (PH_EN(1) && IN(1)) for (int rep = 0; rep < NREP(1); ++rep) thin::phase_h0(p.in[0], p.in[2], (const float*)(ws + WS_MOD), (bf16_t*)(ws + WS_H), G, cid);
    SEAM(1);

#pragma unroll 1
    for (int li = 0; li < DEPTH; ++li) {
        asm volatile("" : "+s"(pp));
        { size_t zoff = 0; asm volatile("" : "+s"(zoff)); ws = pp->ws + zoff; }
        const int base = 2 + 8 * li, kind = li % 3, slot = li / 3; const bool last = li == DEPTH - 1;
        float* mod = (float*)(ws + WS_MOD);
        const float* tab64 = (const float*)(ws + WS_TAB64); const float* tab32 = (const float*)(ws + WS_TAB32);
        float* X = (float*)(ws + WS_X); bf16_t* H = (bf16_t*)(ws + WS_H); bf16_t* O = (bf16_t*)(ws + WS_O);
        unsigned char* R1 = ws + WS_R1;
        int* list = (int*)(ws + WS_LIST); float* tokw = (float*)(ws + WS_TOKW); float* SSQ = (float*)(ws + WS_SSQ);
        const float* modl = mod + (size_t)li * 9 * 6144;
        const int Mpost = last ? TL : T;
        int* cnt = (int*)(ws + WS_CTL) + CW_CNT + li * NE * 64;
#define IDLE_FILL(nunits, myid, budget) do { if (li + 1 < DEPTH) { const int nu_ = (nunits), R_ = (nu_ + G - 1) / G - 1; if (R_ * G + (myid) >= nu_) { \
            thin::moe_fill(lds, pp->in[27], pp->in[28], pp->in[29], ws, li + 1, (budget), (int*)(ws + WS_CTL) + CW_Q + 64 * (li + 1)); __syncthreads(); } } } while (0)
        if (IN(base + 0)) {
            if (PH_EN(2) && kind == 0) {
                pg8::Gemm g{H, (const bf16_t*)(ws + W_A_IN) + (size_t)slot * 1536 * 1024, 1024}; pg8::StaticOrder So; So.init(T, 1536, G, (int)blockIdx.x);
                epi::EpiQKV E{(bf16_t*)(R1 + R_QA), 1024, (bf16_t*)(R1 + R_KA), 256, (bf16_t*)(R1 + R_VTA), 4, 64, 4, 1, 0.125f * LOG2E, tab64};
                for (int rep = 0; rep < NREP(2); ++rep) pg8::gemm_phase<epi::EpiQKV, pg8::StaticOrder, true>(lds, g, So, E);
            } else if (PH_EN(3) && kind == 1) {
                pg8::Gemm g{H, (const bf16_t*)(ws + W_B_IN), 1024}; pg8::StaticOrder So; So.init(T, 1024, G, (int)blockIdx.x);
                epi::EpiB1 E{(bf16_t*)(R1 + R_CQ), (bf16_t*)(R1 + R_CKV), (bf16_t*)(R1 + R_KR), SSQ, tab32};
                for (int rep = 0; rep < NREP(3); ++rep) pg8::gemm_phase<epi::EpiB1, pg8::StaticOrder, true>(lds, g, So, E);
            } else if (PH_EN(4) && kind == 2) {
                pg8::Gemm g{H, (const bf16_t*)(ws + W_C_IN), 1024}; pg8::StaticOrder So; So.init(T, 3072, G, (int)blockIdx.x);
                epi::EpiQKV E{(bf16_t*)(R1 + R_QC), 1024, (bf16_t*)(R1 + R_KC), 1024, (bf16_t*)(R1 + R_VTC), 8, 128, 4, 4, 0.125f * LOG2E, tab64};
                for (int rep = 0; rep < NREP(4); ++rep) pg8::gemm_phase<epi::EpiQKV, pg8::StaticOrder, true>(lds, g, So, E);
            }
        }
        SEAM(base + 0);
        if (PH_EN(5) && IN(base + 1) && kind == 1) {
            { pg8::Gemm g{(const bf16_t*)(R1 + R_CQ), (const bf16_t*)(ws + W_B_UQ), 512}; pg8::StaticOrder So; So.init(T, 1536, G, (int)blockIdx.x);
              epi::EpiB2 E{(bf16_t*)(R1 + R_QB), SSQ, tab32, 0.10206207261596575f * LOG2E};
              for (int rep = 0; rep < NREP(5); ++rep) pg8::gemm_phase<epi::EpiB2, pg8::StaticOrder, true>(lds, g, So, E); }
            { pg8::Gemm g{(const bf16_t*)(R1 + R_CKV), (const bf16_t*)(ws + W_B_UKV), 256}; pg8::StaticOrder So; So.init(T, 2048, G, (int)blockIdx.x);
              epi::EpiB3 E{(bf16_t*)(R1 + R_KN), (bf16_t*)(R1 + R_VTB), SSQ};
              for (int rep = 0; rep < NREP(5); ++rep) pg8::gemm_phase<epi::EpiB3, pg8::StaticOrder, true>(lds, g, So, E); }
        }
        if (kind == 1) SEAM(base + 1);
#ifdef CLK_PROBE
        if (li == 1 && IN(base + 2)) {
            f32x16 c0; bf16x8 fa, fb;
#pragma unroll
            for (int i = 0; i < 16; ++i) c0[i] = 0.f;
#pragma unroll
            for (int i = 0; i < 8; ++i) { fa[i] = (short)(0x3c00 + tid + i); fb[i] = (short)(0x3d00 + i); }
#pragma unroll 1
            for (int it = 0; it < 16384 / 8; ++it) {
#pragma unroll
                for (int u = 0; u < 8; ++u) c0 = MFMA32(fa, fb, c0);
            }
            float sres = 0.f;
#pragma unroll
            for (int i = 0; i < 16; ++i) sres += c0[i];
            ((float*)pp->out)[blockIdx.x * NTHREADS + tid] = sres;
        }
#endif
        if (IN(base + 2)) {
            attn::Tensors At; At.O = O; At.sink = nullptr; At.lamp = nullptr; At.subln = nullptr; At.lambda_init = 0.f; At.K2 = nullptr;
            if (PH_EN(6) && kind == 0) { At.Q = (const bf16_t*)(R1 + R_QA); At.K1 = (const bf16_t*)(R1 + R_KA); At.VT = (const bf16_t*)(R1 + R_VTA); At.sink = pp->in[12] + slot * 16;
                for (int rep = 0; rep < NREP(6); ++rep) attn::phase<0, ATT_PIPE_A>(lds, At, G, cid, !last); }
            else if (PH_EN(7) && kind == 1) { At.Q = (const bf16_t*)(R1 + R_QB); At.K1 = (const bf16_t*)(R1 + R_KN); At.K2 = (const bf16_t*)(R1 + R_KR); At.VT = (const bf16_t*)(R1 + R_VTB);
#ifdef ATT_PROBE
                { attn::Tensors At2 = At; At2.O = (bf16_t*)pp->out; attn::phase<1, ATT_PIPE_B, ATT_PROBE>(lds, At2, G, cid, !last); }
#endif
                for (int rep = 0; rep < NREP(7); ++rep) attn::phase<1, ATT_PIPE_B>(lds, At, G, cid, !last); }
            else if (PH_EN(8) && kind == 2) { At.Q = (const bf16_t*)(R1 + R_QC); At.K1 = (const bf16_t*)(R1 + R_KC); At.VT = (const bf16_t*)(R1 + R_VTC); At.lamp = pp->in[20] + slot * 256; At.subln = pp->in[21] + slot * 128;
                At.lambda_init = 0.8f - 0.6f * expf(-0.3f * (float)li);
                for (int rep = 0; rep < NREP(8); ++rep) attn::phase<2, ATT_PIPE_C>(lds, At, G, cid, !last); }
        }
        SEAM(base + 2);
        if (PH_EN(9) && IN(base + 3)) {
            const bf16_t* Wt = kind == 0 ? (const bf16_t*)(ws + W_A_OUT) + (size_t)slot * 1024 * 1024 : (kind == 1 ? (const bf16_t*)(ws + W_B_OUT) : (const bf16_t*)(ws + W_C_OUT));
            pg8::Gemm g{O, Wt, 1024}; pg8::StaticOrder So; So.init(Mpost, 1024, G, (int)blockIdx.x);
            epi::EpiOut E{(bf16_t*)(R1 + R_Y)};
            if (NREP(9) == 2) pg8::gemm_phase<epi::EpiOut, pg8::StaticOrder, true>(lds, g, So, E);
            pg8::gemm_phase<epi::EpiOut, pg8::StaticOrder, true>(lds, g, So, E);
        }
        SEAM(base + 3);
        if (PH_EN(10) && IN(base + 4)) {
            const float* Xl = li == 0 ? pp->in[0] : X; const float* Xc = li == 0 ? pp->in[2] : (const float*)((const bf16_t*)X + (size_t)TL * 1024);
            thin::LnrArgs A{Xl, Xc, (const bf16_t*)(R1 + R_Y), (float*)(ws + WS_STATS), H, modl, pp->in[6] + li * 1024, pp->in[7] + li * 1024, (const bf16_t*)(ws + WS_RTW) + (size_t)li * 2 * 65536, pp->in[24] + li * 4, pp->in[26] + li * 32, cnt, list, tokw, Mpost};
            if (NREP(10) == 2) { thin::LnrArgs A2 = A; A2.STATS = (float*)R1; A2.H = (bf16_t*)(R1 + (size_t)T * 4096); A2.cnt = (int*)(ws + WS_CTL) + CW_CNT + 4 * NE * 64; A2.list = (int*)(R1 + (size_t)T * 6144); A2.tokw = (float*)(R1 + (size_t)T * 6144 + (size_t)NE * T * 4);
#ifdef LNR_PROBE
            thin::phase_lnr<LNR_PROBE>(lds, A2, G, cid);
#else
            thin::phase_lnr(lds, A2, G, cid);
#endif
            }
            if (li == 0) thin::phase_lnr<0, false>(lds, A, G, cid); else thin::phase_lnr<0, true>(lds, A, G, cid);
        }
        SEAM(base + 4);
        if (IN(base + 5) || IN(base + 6)) {
            if (threadIdx.x == 0) { int a = 0; for (int e = 0; e < NE; ++e) { MISC[16 + e] = (unsigned)a; a += (cnt[e * 64] + 255) >> 8; } MISC[16 + NE] = (unsigned)a; }
            __syncthreads();
        }
        if (PH_EN(11) && IN(base + 5)) {
            pg8::Gemm g{H, (const bf16_t*)(ws + WS_WGU) + (size_t)li * NE * 1024 * 1024, 1024};
            MoeOrder<true> So{(const LAS int*)(lds + MISC_OFF + 64), cnt, list, G, cid};
            epi::EpiGU E{(bf16_t*)(R1 + R_ACT)};
            for (int rep = 0; rep < NREP(11); ++rep) pg8::gemm_phase<epi::EpiGU, MoeOrder<true>, true>(lds, g, So, E);
        }
        SEAM(base + 5);
        if (PH_EN(12) && IN(base + 6)) {
            pg8::Gemm g{(const bf16_t*)(R1 + R_ACT), (const bf16_t*)(ws + WS_WD) + (size_t)li * NE * 1024 * 512, 512};
            MoeOrder<false> So{(const LAS int*)(lds + MISC_OFF + 64), cnt, list, G, cid};
            epi::EpiDown E{(bf16_t*)(R1 + R_Y2), list, cnt, tokw};
            for (int rep = 0; rep < NREP(12); ++rep) pg8::gemm_phase<epi::EpiDown, MoeOrder<false>, true>(lds, g, So, E);
        }
        SEAM(base + 6);
        if (PH_EN(13) && IN(base + 7)) {
            const float* Xl = li == 0 ? pp->in[0] : X; const float* Xc = li == 0 ? pp->in[2] : (const float*)((const bf16_t*)X + (size_t)TL * 1024);
            thin::LnfArgs A{Xl, Xc, (const bf16_t*)(R1 + R_Y), (const float*)(ws + WS_STATS), (const bf16_t*)(R1 + R_Y2), modl, pp->in[6] + li * 1024, pp->in[7] + li * 1024, pp->in[8] + li * 1024, pp->in[9] + li * 1024, last ? pp->out : X, last ? nullptr : H, last ? nullptr : mod + (size_t)(li + 1) * 9 * 6144, Mpost};
            if (NREP(13) == 2 && !last) { thin::LnfArgs A2 = A; A2.Xout = pp->out; A2.H = O; A2.nrows = TL; thin::phase_lnf(A2, G, cid); }
            if (li == 0) thin::phase_lnf<false, true>(A, G, cid); else if (!last) thin::phase_lnf<true, true>(A, G, cid); else thin::phase_lnf<true, false>(A, G, cid);
        }
        if (!last) SEAM(base + 7);
    }
#undef IN
#undef SEAM
}

extern "C" void kernel_launch(void* const* d_in, const int* in_sizes, int n_in, void* d_out, int out_size, void* d_ws, size_t ws_size, hipStream_t stream) {
    static int grid = 0;
    if (grid == 0) {
        if (n_in != 30 || ws_size < WS_END) { grid = -1; return; }
        int dev = 0, cus = 0;
        if (hipGetDevice(&dev) != hipSuccess || hipDeviceGetAttribute(&cus, hipDeviceAttributeMultiprocessorCount, dev) != hipSuccess) { grid = -1; return; }
        if (hipFuncSetAttribute((const void*)k_run, hipFuncAttributeMaxDynamicSharedMemorySize, LDS_BYTES) != hipSuccess) { grid = -1; return; }
        int per_cu = 0;
        if (hipOccupancyMaxActiveBlocksPerMultiprocessor(&per_cu, (const void*)k_run, NTHREADS, LDS_BYTES) != hipSuccess || per_cu < 1) { (void)hipGetLastError(); grid = -1; return; }
        grid = cus;
    }
    if (grid < 0) return;
    (void)hipMemsetAsync((char*)d_ws + WS_CTL, 0, CTL_ZERO_BYTES, stream);
    Params p{};
    for (int i = 0; i < 30; ++i) p.in[i] = (const float*)d_in[i];
    p.out = (float*)d_out; p.ws = (unsigned char*)d_ws;
#if ONE_LAUNCH
    p.ph_lo = 0; p.ph_hi = NPH;
    k_run<<<dim3(grid), dim3(NTHREADS), LDS_BYTES, stream>>>(p);
#else
    for (int ph = 0; ph < NPH; ++ph) {
        if (ph >= 2 && ((ph - 2) % 8) == 1 && (((ph - 2) / 8) % 3) != 1) continue;
        p.ph_lo = ph; p.ph_hi = ph + 1;
        k_run<<<dim3(grid), dim3(NTHREADS), LDS_BYTES, stream>>>(p);
    }
#endif
}
```

```cpp
#include <hip/hip_runtime.h>
#include <stdint.h>
#include <math.h>

constexpr int D = 1024, NB = 8, S = 4096, L = 256, DEPTH = 4;
constexpr int TL = NB * S, TC = NB * L, T = TL + TC;
constexpr int NKEY = S + L;
constexpr int NE = 32, DE = 512;
constexpr float LN_EPS = 1e-5f, RMS_EPS = 1e-6f;
constexpr float DN_ALPHA = 1.6817928305074290861f;
constexpr float LOG2E = 1.4426950408889634f;
constexpr int NWAVES = 8, NTHREADS = 512;

#define LAS __attribute__((address_space(3)))
typedef unsigned short bf16_t;
typedef short bf16x8 __attribute__((ext_vector_type(8)));
typedef float f32x4 __attribute__((ext_vector_type(4)));
typedef float f32x2 __attribute__((ext_vector_type(2)));
typedef float f32x16 __attribute__((ext_vector_type(16)));
typedef unsigned u32x4 __attribute__((ext_vector_type(4)));
typedef unsigned u32x2 __attribute__((ext_vector_type(2)));

__device__ __forceinline__ unsigned cvt_pk_bf16(float lo, float hi) { unsigned r; asm volatile("v_cvt_pk_bf16_f32 %0, %1, %2" : "=v"(r) : "v"(lo), "v"(hi)); return r; }
__device__ __forceinline__ unsigned f2bf(float f) { unsigned u = __builtin_bit_cast(unsigned, f); return (u + 0x7fffu + ((u >> 16) & 1u)) >> 16; }
__device__ __forceinline__ float bf2f(unsigned h) { return __builtin_bit_cast(float, h << 16); }
__device__ __forceinline__ int mrow_of(int r) { return r < TL ? (r >> 12) : NB; }
__device__ __forceinline__ float dpp_add(float v, unsigned x, const int ctrl_unused) { return v; }
#define DPP_ADD_STEP(v, CTRL) v += __uint_as_float(__builtin_amdgcn_update_dpp(0u, __float_as_uint(v), CTRL, 0xF, 0xF, true))
__device__ __forceinline__ float xor16_sum(float v) { const unsigned x = __float_as_uint(v); auto r = __builtin_amdgcn_permlane16_swap(x, x, false, false); return __uint_as_float(r[0]) + __uint_as_float(r[1]); }
__device__ __forceinline__ float xor32_sum(float v) { const unsigned x = __float_as_uint(v); auto r = __builtin_amdgcn_permlane32_swap(x, x, false, false); return __uint_as_float(r[0]) + __uint_as_float(r[1]); }
typedef _Float16 f16x2 __attribute__((ext_vector_type(2)));
__device__ __forceinline__ unsigned pack_f16(float a, float b) { a = __builtin_fminf(__builtin_fmaxf(a, -65504.f), 65504.f); b = __builtin_fminf(__builtin_fmaxf(b, -65504.f), 65504.f);
    f16x2 h; h.x = (_Float16)a; h.y = (_Float16)b; return __builtin_bit_cast(unsigned, h); }
__device__ __forceinline__ float f16lo(unsigned u) { return (float)__builtin_bit_cast(f16x2, u).x; }
__device__ __forceinline__ float f16hi(unsigned u) { return (float)__builtin_bit_cast(f16x2, u).y; }
__device__ __forceinline__ float xor32_max(float v) { const unsigned x = __float_as_uint(v); auto r = __builtin_amdgcn_permlane32_swap(x, x, false, false); return fmaxf(__uint_as_float(r[0]), __uint_as_float(r[1])); }
__device__ __forceinline__ float wave_sum(float v) {
    DPP_ADD_STEP(v, 0xB1); DPP_ADD_STEP(v, 0x4E); DPP_ADD_STEP(v, 0x141); DPP_ADD_STEP(v, 0x140);
    return xor32_sum(xor16_sum(v));
}
__device__ __forceinline__ void wave_sum2(float& a, float& b) {
    DPP_ADD_STEP(a, 0xB1); DPP_ADD_STEP(b, 0xB1); DPP_ADD_STEP(a, 0x4E); DPP_ADD_STEP(b, 0x4E); DPP_ADD_STEP(a, 0x141); DPP_ADD_STEP(b, 0x141); DPP_ADD_STEP(a, 0x140); DPP_ADD_STEP(b, 0x140);
    a = xor16_sum(a); b = xor16_sum(b); a = xor32_sum(a); b = xor32_sum(b);
}

constexpr size_t MiB = 1u << 20;
constexpr size_t WS_CTL = 0, CTL_ZERO_BYTES = 128 * 1024;
constexpr int CW_Q = 512;
constexpr int CW_BAR = 1024;
constexpr int CW_CNT = 8192;
constexpr size_t WS_MOD = 1 * MiB;
constexpr size_t WS_TAB64 = 2 * MiB, WS_TAB32 = WS_TAB64 + 8192;
constexpr size_t WS_RTW = 3 * MiB;
constexpr size_t WS_TOKW = 4 * MiB;
constexpr size_t WS_SSQ = 5 * MiB;
constexpr size_t WS_STATS = 7 * MiB;
constexpr size_t WS_LIST = 8 * MiB;
constexpr size_t WS_WSMALL = 16 * MiB;
constexpr size_t W_A_IN = WS_WSMALL;
constexpr size_t W_A_OUT = W_A_IN + 2ull * 1536 * 1024 * 2;
constexpr size_t W_B_IN = W_A_OUT + 2ull * 1024 * 1024 * 2;
constexpr size_t W_B_UQ = W_B_IN + 1024ull * 1024 * 2;
constexpr size_t W_B_UKV = W_B_UQ + 1536ull * 512 * 2;
constexpr size_t W_B_OUT = W_B_UKV + 2048ull * 256 * 2;
constexpr size_t W_C_IN = W_B_OUT + 1024ull * 1024 * 2;
constexpr size_t W_C_OUT = W_C_IN + 3072ull * 1024 * 2;
constexpr size_t WS_WGU = 48 * MiB;
constexpr size_t WS_WD = WS_WGU + 4ull * 32 * 1024 * 1024 * 2;
constexpr size_t WS_X = WS_WD + 4ull * 32 * 1024 * 512 * 2;
constexpr size_t WS_H = WS_X + (size_t)T * 1024 * 4;
constexpr size_t WS_O = WS_H + (size_t)T * 1024 * 2;
constexpr size_t WS_R1 = WS_O + (size_t)T * 1024 * 2;
static_assert(W_C_OUT + 1024ull * 1024 * 2 <= WS_WGU, "small weights fit");
constexpr size_t R_QA = 0, R_KA = R_QA + (size_t)T * 1024 * 2, R_VTA = R_KA + (size_t)T * 256 * 2;
constexpr size_t R_CQ = 0, R_CKV = R_CQ + (size_t)T * 512 * 2, R_KR = R_CKV + (size_t)T * 256 * 2, R_QB = R_KR + (size_t)T * 32 * 2,
                 R_KN = R_QB + (size_t)T * 1536 * 2, R_VTB = R_KN + (size_t)T * 1024 * 2, R_ENDB = R_VTB + (size_t)NB * 16 * 64 * NKEY * 2;
constexpr size_t R_QC = 0, R_KC = R_QC + (size_t)T * 1024 * 2, R_VTC = R_KC + (size_t)T * 1024 * 2;
constexpr int NPOS = 2 * T + NE * 256;
constexpr size_t R_ACT = 0, R_Y2 = R_ACT + (size_t)NPOS * 512 * 2, R_ENDM = R_Y2 + (size_t)T * 2 * 1024 * 2;
constexpr size_t R_Y = R_ENDM, R_ENDY = R_Y + (size_t)T * 1024 * 2;
static_assert(R_ENDY <= R_ENDB, "MoE region + y inside R1");
constexpr size_t WS_END = WS_R1 + R_ENDB;

constexpr int LDS_BYTES = 147456;
constexpr int MISC_OFF = 146432;

#define XB_TMO      128
#define XB_XCNT(j)  (256  + 64 * (j))
#define XB_XSUB(j)  (1280 + 64 * (j))
#define XB_XGEN(j)  (2304 + 64 * (j))
#define XB_TOP      3328
#define XB_TOPGEN   3392
#define XCD_BAR_WORDS 3456
#define XB_SPIN_CAP (1u << 18)
__device__ __forceinline__ unsigned xb_ld(unsigned* p)              { return __hip_atomic_load(p, __ATOMIC_RELAXED, __HIP_MEMORY_SCOPE_AGENT); }
__device__ __forceinline__ unsigned xb_add(unsigned* p, unsigned v) { return __hip_atomic_fetch_add(p, v, __ATOMIC_RELAXED, __HIP_MEMORY_SCOPE_AGENT); }
__device__ __forceinline__ unsigned xb_xcc_id() { return (unsigned)__builtin_amdgcn_s_getreg((3 << 11) | 20) & 0xFu; }
#define XB_SPIN(cond, bar) do { unsigned _sp = 0; while (cond) { __builtin_amdgcn_s_sleep(1); \
    if ((++_sp & 255u) == 0u) { if (xb_ld(&(bar)[XB_TMO])) break; if (_sp > XB_SPIN_CAP) { atomicAdd(&(bar)[XB_TMO], 1u); break; } } } } while (0)
struct XcdBarrier { unsigned* bar; unsigned x; volatile LAS unsigned* st; };
__device__ __forceinline__ XcdBarrier xcd_barrier_post(unsigned* bar, volatile LAS unsigned* st) {
    XcdBarrier b; b.bar = bar; b.x = xb_xcc_id(); b.st = st;
    if (threadIdx.x == 0) (void)xb_add(&bar[XB_XCNT(b.x)], 1u);
    return b;
}
__device__ __forceinline__ void xcd_barrier_complete(unsigned* bar, unsigned x, unsigned& nloc, unsigned& nx) {
    const unsigned G = gridDim.x * gridDim.y * gridDim.z;
    unsigned sum, cnt, mine, sp = 0u;
    for (;;) {
        sum = 0u; cnt = 0u; mine = 0u;
#pragma unroll
        for (unsigned j = 0; j < 16; ++j) { const unsigned c = xb_ld(&bar[XB_XCNT(j)]); sum += c; cnt += (c > 0u) ? 1u : 0u; mine = (j == x) ? c : mine; }
        if (sum == G) break;
        __builtin_amdgcn_s_sleep(1);
        if ((++sp & 255u) == 0u) { if (xb_ld(&bar[XB_TMO])) break; if (sp > XB_SPIN_CAP) { atomicAdd(&bar[XB_TMO], 1u); break; } }
    }
    nloc = mine > 0u ? mine : 1u; nx = cnt > 0u ? cnt : 1u;
}
__device__ __forceinline__ void xcd_barrier(const XcdBarrier& b) {
    asm volatile("s_waitcnt vmcnt(0)" ::: "memory");
    __syncthreads();
    if (threadIdx.x == 0) {
        unsigned* bar = b.bar;
        __builtin_amdgcn_s_waitcnt(0);
        unsigned nloc = b.st[0], nx = b.st[1];
        if (nloc == 0u) { xcd_barrier_complete(bar, b.x, nloc, nx); b.st[0] = nloc; b.st[1] = nx; }
        const unsigned old = xb_add(&bar[XB_XSUB(b.x)], 1u);
        const unsigned gen = old / nloc;
        if (old + 1u == (gen + 1u) * nloc) {
            __builtin_amdgcn_fence(__ATOMIC_RELEASE, "agent");
            asm volatile("s_waitcnt vmcnt(0)" ::: "memory");
            const unsigned og = xb_add(&bar[XB_TOP], 1u);
            const unsigned tg = og / nx;
            if (og + 1u == (tg + 1u) * nx) xb_add(&bar[XB_TOPGEN], 1u);
            else XB_SPIN(xb_ld(&bar[XB_TOPGEN]) == tg, bar);
            __builtin_amdgcn_fence(__ATOMIC_ACQUIRE, "agent");
            xb_add(&bar[XB_XGEN(b.x)], 1u);
            asm volatile("s_waitcnt vmcnt(0)" ::: "memory");
        } else {
            XB_SPIN(xb_ld(&bar[XB_XGEN(b.x)]) == gen, bar);
            __builtin_amdgcn_fence(__ATOMIC_ACQUIRE, "agent");
            asm volatile("s_waitcnt vmcnt(0)" ::: "memory");
        }
    }
    __syncthreads();
}

namespace pg8 {
constexpr int BM = 256, BK = 64, HALF = 128, HTB = HALF * BK * 2, STAGE_BYTES = 8 * HTB, NXCD = 8, WGM = 2;
__host__ __device__ __forceinline__ int lds_byte(int r, int c) { const int st = (r >> 4) * 2 + (c >> 5), rr = r & 15, cc = c & 31, ob = rr * 64 + cc * 2; return st * 1024 + (ob ^ (((ob >> 9) & 1) << 5)); }
__host__ __device__ __forceinline__ void stage_rc(int b, int& R, int& C) { const int st = b / 1024, sb = b % 1024, swz = sb ^ (((sb >> 9) & 1) << 5); R = (st >> 1) * 16 + swz / 64; C = (st & 1) * 32 + (swz % 64) / 2; }
__host__ __device__ __forceinline__ int perm32(int rho) { const int n = rho >> 4, i = rho & 15; return 8 * (i >> 2) + 4 * n + (i & 3); }

struct Unit { int pm, pn, e, t, r0, nai; };
struct Gemm { const bf16_t* A; const bf16_t* Bt; int K; };

struct StaticOrder {
    static constexpr bool GATHER = false;
    int nM, nN, nwg, G, c;
    __device__ void init(int M, int N, int G_, int c_) { asm volatile("" : "+s"(G_), "+s"(c_));
        nM = M / BM; nN = N / BM; nwg = nM * nN; G = G_; c = c_; }
    __device__ bool next(int i, Unit& u) const {
        const int nfull = (nwg / G) * G, rem = nwg - nfull; const bool halves = rem > 0 && 2 * rem <= G;
        long Lx = (long)i * G + c; u.r0 = 0; u.nai = 2;
        if (Lx >= nfull && halves) { if (i * G != nfull || c >= 2 * rem) return false; Lx = nfull + (c >> 1); u.r0 = (c & 1) * HALF; u.nai = 1; }
        if (Lx >= nwg) return false;
        int wgid = (int)Lx; { const int q = nwg / NXCD, r = nwg % NXCD, xcd = wgid % NXCD, off = wgid / NXCD; wgid = (xcd < r ? xcd * (q + 1) : r * (q + 1) + (xcd - r) * q) + off; }
        const int nig = WGM * nN, gid = wgid / nig, fm = gid * WGM, gsz = (nM - fm) < WGM ? (nM - fm) : WGM;
        u.pm = fm + ((wgid % nig) % gsz); u.pn = (wgid % nig) / gsz; u.e = 0; u.t = 0; return true;
    }
    __device__ __forceinline__ int arow(const Unit& u, int r) const { return u.pm * BM + u.r0 + r; }
};

template <class Epi, class Sched, bool ALIGN_EPI>
__device__ __forceinline__ void gemm_phase(LAS unsigned char* lds, const Gemm g, const Sched& S, const Epi& E) {
    int tid_ = threadIdx.x; asm volatile("" : "+v"(tid_));
    const int tid = tid_, wid = __builtin_amdgcn_readfirstlane(tid >> 6), lane = tid & 63, wr = wid >> 2, wc = wid & 3, fr = lane & 15, fq = lane >> 4;
    const int K = g.K, nt = K / BK;
    unsigned voffB[2];
#pragma unroll
    for (int i = 0; i < 2; ++i) { int R, C; stage_rc(tid * 16 + i * 8192, R, C); const int Rb = Epi::PERM ? ((R & ~31) + perm32(R & 31)) : R;
        voffB[i] = (unsigned)(Rb * K + C) * 2u; }
    const size_t kstep = (size_t)(BK * 2);
    const size_t hstep = (size_t)HALF * K * 2;
    const size_t tstep = 2 * hstep;
    const unsigned ldsw = (unsigned)wid * 1024u;
    const int aoff = lds_byte(wr * 64 + fr, fq * 8), boff = lds_byte(wc * 32 + fr, fq * 8);
#define PG8_SA(b, h) (((b) * 2 + (h)) * HTB)
#define PG8_SB(b, h) ((4 + (b) * 2 + (h)) * HTB)
#define PG8_STAGE(bufoff, gbase, voff) do { _Pragma("unroll") for (int _i = 0; _i < 2; ++_i) \
        __builtin_amdgcn_global_load_lds((const unsigned*)((const char*)(gbase) + (voff)[_i]), (LAS unsigned*)(lds + (bufoff) + ldsw + _i * 8192), 16, 0, 0); } while (0)
#define PG8_LDA(dst, b, h) do { _Pragma("unroll") for (int m = 0; m < 4; ++m) _Pragma("unroll") for (int k = 0; k < 2; ++k) dst[m][k] = *(const LAS bf16x8*)(lds + PG8_SA(b, h) + aoff + m * 2048 + k * 1024); } while (0)
#define PG8_LDB(dst, b, h) do { _Pragma("unroll") for (int n = 0; n < 2; ++n) _Pragma("unroll") for (int k = 0; k < 2; ++k) dst[n][k] = *(const LAS bf16x8*)(lds + PG8_SB(b, h) + boff + n * 2048 + k * 1024); } while (0)
#define PG8_MMA(ai, bj, At, Bt) do { __builtin_amdgcn_s_setprio(1); _Pragma("unroll") for (int m = 0; m < 4; ++m) _Pragma("unroll") for (int n = 0; n < 2; ++n) _Pragma("unroll") for (int k = 0; k < 2; ++k) \
        acc[ai][bj][m][n] = __builtin_amdgcn_mfma_f32_16x16x32_bf16(Bt[n][k], At[m][k], acc[ai][bj][m][n], 0, 0, 0); __builtin_amdgcn_s_setprio(0); } while (0)
#define PG8_WAIT_V(n) asm volatile("s_waitcnt vmcnt(" #n ")" ::: "memory")
#define PG8_WAIT_L(n) asm volatile("s_waitcnt lgkmcnt(" #n ")" ::: "memory")
#define PG8_BAR __builtin_amdgcn_s_barrier()
#define PG8_SCHED __builtin_amdgcn_sched_barrier(0)
#define PG8_AOFF(dst, u) do { _Pragma("unroll") for (int _i = 0; _i < 2; ++_i) { int R_, C_; stage_rc(tid * 16 + _i * 8192, R_, C_); \
        _Pragma("unroll") for (int _h = 0; _h < 2; ++_h) dst[_h][_i] = (unsigned)(S.arow(u, _h * HALF + R_) * K + C_) * 2u; } } while (0)
    Unit cur, nxt; int ui = 0;
    if (!S.next(0, cur)) return;
    f32x4 acc[2][2][4][2];
#pragma unroll
    for (int a = 0; a < 2; ++a)
#pragma unroll
        for (int b = 0; b < 2; ++b)
#pragma unroll
            for (int m = 0; m < 4; ++m)
#pragma unroll
                for (int n = 0; n < 2; ++n) acc[a][b][m][n] = (f32x4){0.f, 0.f, 0.f, 0.f};
    bf16x8 At[4][2], B0[2][2], B1[2][2];
    unsigned voffA[2]; unsigned vA[2][2], nA_[2][2];
    const char* cA = (const char*)g.A; const char* nAp = cA;
    if constexpr (Sched::GATHER) { PG8_AOFF(vA, cur); }
    else {
#pragma unroll
        for (int i = 0; i < 2; ++i) { int R, C; stage_rc(tid * 16 + i * 8192, R, C); voffA[i] = (unsigned)(R * K + C) * 2u; }
        cA = (const char*)g.A + (size_t)cur.pm * tstep + (size_t)cur.r0 * K * 2;
    }
#define PG8_STA(bufoff, kptr, h, offs) do { if constexpr (Sched::GATHER) { PG8_STAGE(bufoff, kptr, offs[h]); } else { PG8_STAGE(bufoff, (kptr) + (h) * hstep, voffA); } } while (0)
    const char* cB = (const char*)g.Bt + (size_t)cur.pn * tstep;
    PG8_STAGE(PG8_SB(0, 0), cB, voffB); PG8_STAGE(PG8_SB(0, 1), cB + hstep, voffB); PG8_STA(PG8_SA(0, 0), cA, 0, vA); PG8_STA(PG8_SA(0, 1), cA, 1, vA);
    if (wr == 1) PG8_BAR;
    PG8_WAIT_V(2); PG8_BAR;
    PG8_STAGE(PG8_SB(1, 0), cB + kstep, voffB); PG8_STA(PG8_SA(1, 0), cA + kstep, 0, vA); PG8_STAGE(PG8_SB(1, 1), cB + hstep + kstep, voffB);
    PG8_WAIT_V(6); PG8_BAR;
    for (;;) {
        const bool has_next = S.next(ui + 1, nxt);
        if constexpr (Sched::GATHER) {
            if (has_next) { PG8_AOFF(nA_, nxt); } else {
#pragma unroll
                for (int _h = 0; _h < 2; ++_h)
#pragma unroll
                    for (int _i = 0; _i < 2; ++_i) nA_[_h][_i] = vA[_h][_i]; }
        } else { nAp = has_next ? (const char*)g.A + (size_t)nxt.pm * tstep + (size_t)nxt.r0 * K * 2 : cA; }
        const char* nB = has_next ? (const char*)g.Bt + (size_t)nxt.pn * tstep : cB;
        const bool full = cur.nai == 2;
#pragma unroll 1
        for (int t = 0; t < nt; t += 2) {
            const bool last = (t == nt - 2);
            const char* a1 = cA + (size_t)(t + 1) * kstep;
            const char* a2 = last ? nAp : cA + (size_t)(t + 2) * kstep; const char* b2 = last ? nB : cB + (size_t)(t + 2) * kstep;
            const char* a3 = a2 + kstep; const char* b3 = b2 + kstep;
            unsigned wq[2][2];
            if constexpr (Sched::GATHER) {
#pragma unroll
                for (int _h = 0; _h < 2; ++_h)
#pragma unroll
                    for (int _i = 0; _i < 2; ++_i) wq[_h][_i] = last ? nA_[_h][_i] : vA[_h][_i];
            }
            PG8_LDB(B0, 0, 0); PG8_LDB(B1, 0, 1); PG8_SCHED; PG8_LDA(At, 0, 0); PG8_STA(PG8_SA(1, 1), a1, 1, vA);
            PG8_WAIT_V(8); PG8_WAIT_L(0); PG8_BAR; PG8_MMA(0, 0, At, B0); PG8_MMA(0, 1, At, B1); PG8_BAR; PG8_SCHED;
            PG8_LDA(At, 0, 1); PG8_STAGE(PG8_SB(0, 0), b2, voffB); PG8_STAGE(PG8_SB(0, 1), b2 + hstep, voffB); PG8_STA(PG8_SA(0, 0), a2, 0, wq);
            PG8_WAIT_V(8); PG8_WAIT_L(0); PG8_BAR; if (full) { PG8_MMA(1, 0, At, B0); PG8_MMA(1, 1, At, B1); } PG8_BAR; PG8_SCHED;
            PG8_LDB(B0, 1, 0); PG8_LDB(B1, 1, 1); PG8_SCHED; PG8_LDA(At, 1, 0); PG8_STA(PG8_SA(0, 1), a2, 1, wq);
            PG8_WAIT_V(8); PG8_WAIT_L(0); PG8_BAR; PG8_MMA(0, 0, At, B0); PG8_MMA(0, 1, At, B1); PG8_BAR; PG8_SCHED;
            PG8_LDA(At, 1, 1); PG8_STAGE(PG8_SB(1, 0), b3, voffB); PG8_STAGE(PG8_SB(1, 1), b3 + hstep, voffB); PG8_STA(PG8_SA(1, 0), a3, 0, wq);
            PG8_WAIT_V(8); PG8_WAIT_L(0); PG8_BAR; if (full) { PG8_MMA(1, 0, At, B0); PG8_MMA(1, 1, At, B1); } PG8_BAR; PG8_SCHED;
        }
        if constexpr (ALIGN_EPI) { if (wr == 0) PG8_BAR; }
        E(acc, cur, wr, wc, fr, fq);
        if (!has_next) break;
#pragma unroll
        for (int a = 0; a < 2; ++a)
#pragma unroll
            for (int b = 0; b < 2; ++b)
#pragma unroll
                for (int m = 0; m < 4; ++m)
#pragma unroll
                    for (int n = 0; n < 2; ++n) acc[a][b][m][n] = (f32x4){0.f, 0.f, 0.f, 0.f};
        cur = nxt; cB = nB; ++ui;
        if constexpr (Sched::GATHER) {
#pragma unroll
            for (int _h = 0; _h < 2; ++_h)
#pragma unroll
                for (int _i = 0; _i < 2; ++_i) vA[_h][_i] = nA_[_h][_i];
        } else { cA = nAp; }
        if constexpr (ALIGN_EPI) { if (wr == 1) PG8_BAR; }
    }
    PG8_WAIT_V(0);
    if constexpr (!ALIGN_EPI) { if (wr == 0) PG8_BAR; }
    PG8_BAR;
#undef PG8_STA
#undef PG8_SA
#undef PG8_SB
#undef PG8_STAGE
#undef PG8_LDA
#undef PG8_LDB
#undef PG8_MMA
#undef PG8_WAIT_V
#undef PG8_WAIT_L
#undef PG8_BAR
#undef PG8_SCHED
#undef PG8_AOFF
}
}
namespace epi {
using pg8::Unit;
typedef float2 cs2;
__device__ __forceinline__ void rope8(f32x4& v0, f32x4& v1, const f32x4 c01, const f32x4 c23) {
    float a, b;
    a = v0[0]; b = v0[1]; v0[0] = a * c01[0] - b * c01[1]; v0[1] = b * c01[0] + a * c01[1];
    a = v0[2]; b = v0[3]; v0[2] = a * c01[2] - b * c01[3]; v0[3] = b * c01[2] + a * c01[3];
    a = v1[0]; b = v1[1]; v1[0] = a * c23[0] - b * c23[1]; v1[1] = b * c23[0] + a * c23[1];
    a = v1[2]; b = v1[3]; v1[2] = a * c23[2] - b * c23[3]; v1[3] = b * c23[2] + a * c23[3];
}
__device__ __forceinline__ u32x4 pack8(const f32x4 v0, const f32x4 v1) { u32x4 w; w.x = cvt_pk_bf16(v0[0], v0[1]); w.y = cvt_pk_bf16(v0[2], v0[3]); w.z = cvt_pk_bf16(v1[0], v1[1]); w.w = cvt_pk_bf16(v1[2], v1[3]); return w; }
__device__ __forceinline__ void store_vt(bf16_t* VT, int HV, int DV, int row, int vcol, const f32x4 v0, const f32x4 v1) {
    const int b = row < TL ? (row >> 12) : ((row - TL) >> 8), key = row < TL ? (row & 4095) : (S + ((row - TL) & 255));
    const int hv = vcol / DV, dv = vcol % DV;
    bf16_t* p = VT + ((size_t)(b * HV + hv) * DV + dv) * NKEY + key;
#pragma unroll
    for (int i = 0; i < 4; ++i) { p[(size_t)i * NKEY] = (bf16_t)f2bf(v0[i]); p[(size_t)(4 + i) * NKEY] = (bf16_t)f2bf(v1[i]); }
}

struct EpiQKV {
    static constexpr bool PERM = true;
    bf16_t* Q; int ldq; bf16_t* Kb; int ldk; bf16_t* VT; int HV, DV; int nQ, nK; float qscale; const float* tab64;
    __device__ __forceinline__ void operator()(const f32x4 (&acc)[2][2][4][2], const Unit& u, int wr, int wc, int fr, int fq) const {
        const int kindt = u.pn < nQ ? 0 : (u.pn < nQ + nK ? 1 : 2);
        const int tcol = (kindt == 0 ? u.pn : (kindt == 1 ? u.pn - nQ : u.pn - nQ - nK)) * 256 + wc * 32 + fq * 8;
#pragma unroll
        for (int ai = 0; ai < 2; ++ai) if (ai < u.nai)
#pragma unroll
            for (int m = 0; m < 4; ++m) {
                asm volatile("" ::: "memory");
                const int row = u.pm * 256 + u.r0 + ai * 128 + wr * 64 + m * 16 + fr;
                if (kindt == 2) {
#pragma unroll
                    for (int bj = 0; bj < 2; ++bj) store_vt(VT, HV, DV, row, tcol + bj * 128, acc[ai][bj][m][0], acc[ai][bj][m][1]);
                } else {
                    f32x4 c01 = (f32x4){1.f, 0.f, 1.f, 0.f}, c23 = c01;
                    if (row < TL) { const int s = row & 4095, pos = (wc & 1) ? (s & 63) : (s >> 6);
                        const f32x4* tp = (const f32x4*)(tab64 + ((size_t)pos * 16 + fq * 4) * 2); c01 = tp[0]; c23 = tp[1]; }
                    const float sc = kindt == 0 ? qscale : 1.f;
                    bf16_t* dst = (kindt == 0 ? Q + (size_t)row * ldq : Kb + (size_t)row * ldk) + tcol;
#pragma unroll
                    for (int bj = 0; bj < 2; ++bj) { f32x4 v0 = acc[ai][bj][m][0], v1 = acc[ai][bj][m][1]; rope8(v0, v1, c01, c23); v0 = v0 * sc; v1 = v1 * sc;
                        *(u32x4*)(dst + bj * 128) = pack8(v0, v1); }
                }
            }
    }
};
struct EpiB1 {
    static constexpr bool PERM = true;
    bf16_t* CQ; bf16_t* CKV; bf16_t* KR; float* SSQ; const float* tab32;
    __device__ __forceinline__ void operator()(const f32x4 (&acc)[2][2][4][2], const Unit& u, int wr, int wc, int fr, int fq) const {
#pragma unroll
        for (int ai = 0; ai < 2; ++ai) if (ai < u.nai)
#pragma unroll
            for (int m = 0; m < 4; ++m) {
                asm volatile("" ::: "memory");
                const int row = u.pm * 256 + u.r0 + ai * 128 + wr * 64 + m * 16 + fr;
                if (u.pn < 3) {
                    float ss = 0.f;
#pragma unroll
                    for (int bj = 0; bj < 2; ++bj)
#pragma unroll
                        for (int n = 0; n < 2; ++n) { const f32x4 v = acc[ai][bj][m][n]; ss += (v[0] * v[0] + v[1] * v[1]) + (v[2] * v[2] + v[3] * v[3]); }
                    ss = xor32_sum(xor16_sum(ss));
                    if (fq == 0) SSQ[(size_t)row * 12 + u.pn * 4 + wc] = ss;
                    bf16_t* dst = (u.pn < 2 ? CQ + (size_t)row * 512 + u.pn * 256 : CKV + (size_t)row * 256) + wc * 32 + fq * 8;
#pragma unroll
                    for (int bj = 0; bj < 2; ++bj) *(u32x4*)(dst + bj * 128) = pack8(acc[ai][bj][m][0], acc[ai][bj][m][1]);
                } else if (wc == 0) {
                    f32x4 v0 = acc[ai][0][m][0], v1 = acc[ai][0][m][1];
                    if (row < TL) { const int s = row & 4095, pos = (fq & 2) ? (s & 63) : (s >> 6);
                        const f32x4* tp = (const f32x4*)(tab32 + ((size_t)pos * 8 + (fq & 1) * 4) * 2); rope8(v0, v1, tp[0], tp[1]); }
                    *(u32x4*)(KR + (size_t)row * 32 + fq * 8) = pack8(v0, v1);
                }
            }
    }
};
struct EpiB2 {
    static constexpr bool PERM = true;
    bf16_t* QB; const float* SSQ; const float* tab32; float qscale;
    __device__ __forceinline__ void operator()(const f32x4 (&acc)[2][2][4][2], const Unit& u, int wr, int wc, int fr, int fq) const {
#pragma unroll
        for (int ai = 0; ai < 2; ++ai) if (ai < u.nai)
#pragma unroll
            for (int m = 0; m < 4; ++m) {
                asm volatile("" ::: "memory");
                const int row = u.pm * 256 + u.r0 + ai * 128 + wr * 64 + m * 16 + fr;
                const f32x4 s0 = *(const f32x4*)(SSQ + (size_t)row * 12), s1 = *(const f32x4*)(SSQ + (size_t)row * 12 + 4);
                const float ss = ((s0[0] + s0[1]) + (s0[2] + s0[3])) + ((s1[0] + s1[1]) + (s1[2] + s1[3]));
                const float sc = qscale / sqrtf(ss * (1.f / 512.f) + RMS_EPS);
#pragma unroll
                for (int bj = 0; bj < 2; ++bj) {
                    const int col = u.pn * 256 + bj * 128 + wc * 32 + fq * 8, w0 = col % 96;
                    f32x4 v0 = acc[ai][bj][m][0] * sc, v1 = acc[ai][bj][m][1] * sc;
                    if (w0 >= 64 && row < TL) { const int off = w0 - 64, s = row & 4095, pos = (off & 16) ? (s & 63) : (s >> 6);
                        const f32x4* tp = (const f32x4*)(tab32 + ((size_t)pos * 8 + ((off & 15) >> 1)) * 2); rope8(v0, v1, tp[0], tp[1]); }
                    *(u32x4*)(QB + (size_t)row * 1536 + col) = pack8(v0, v1);
                }
            }
    }
};
struct EpiB3 {
    static constexpr bool PERM = true;
    bf16_t* KN; bf16_t* VT; const float* SSQ;
    __device__ __forceinline__ void operator()(const f32x4 (&acc)[2][2][4][2], const Unit& u, int wr, int wc, int fr, int fq) const {
#pragma unroll
        for (int ai = 0; ai < 2; ++ai) if (ai < u.nai)
#pragma unroll
            for (int m = 0; m < 4; ++m) {
                asm volatile("" ::: "memory");
                const int row = u.pm * 256 + u.r0 + ai * 128 + wr * 64 + m * 16 + fr;
                const f32x4 s2 = *(const f32x4*)(SSQ + (size_t)row * 12 + 8);
                const float sc = 1.0f / sqrtf(((s2[0] + s2[1]) + (s2[2] + s2[3])) * (1.f / 256.f) + RMS_EPS);
#pragma unroll
                for (int bj = 0; bj < 2; ++bj) {
                    const f32x4 v0 = acc[ai][bj][m][0] * sc, v1 = acc[ai][bj][m][1] * sc;
                    const int tc = bj * 128 + wc * 32 + fq * 8;
                    if (u.pn < 4) *(u32x4*)(KN + (size_t)row * 1024 + u.pn * 256 + tc) = pack8(v0, v1);
                    else store_vt(VT, 16, 64, row, (u.pn - 4) * 256 + tc, v0, v1);
                }
            }
    }
};
struct EpiOut {
    static constexpr bool PERM = true;
    bf16_t* Y;
    __device__ __forceinline__ void operator()(const f32x4 (&acc)[2][2][4][2], const Unit& u, int wr, int wc, int fr, int fq) const {
#pragma unroll
        for (int ai = 0; ai < 2; ++ai) if (ai < u.nai)
#pragma unroll
            for (int m = 0; m < 4; ++m) {
                const int row = u.pm * 256 + u.r0 + ai * 128 + wr * 64 + m * 16 + fr;
#pragma unroll
                for (int bj = 0; bj < 2; ++bj)
                    *(u32x4*)(Y + (size_t)row * 1024 + u.pn * 256 + bj * 128 + wc * 32 + fq * 8) = pack8(acc[ai][bj][m][0], acc[ai][bj][m][1]);
            }
    }
};
struct EpiGU {
    static constexpr bool PERM = true;
    bf16_t* ACT;
    __device__ __forceinline__ void operator()(const f32x4 (&acc)[2][2][4][2], const Unit& u, int wr, int wc, int fr, int fq) const {
#pragma unroll
        for (int ai = 0; ai < 2; ++ai) if (ai < u.nai)
#pragma unroll
            for (int m = 0; m < 4; ++m) {
                asm volatile("" ::: "memory");
                const int row = u.pm * 256 + u.r0 + ai * 128 + wr * 64 + m * 16 + fr;
#pragma unroll
                for (int bj = 0; bj < 2; ++bj) {
                    const f32x4 g = acc[ai][bj][m][0], up = acc[ai][bj][m][1]; f32x4 a;
#pragma unroll
                    for (int i = 0; i < 4; ++i) a[i] = g[i] / (1.f + __expf(-g[i])) * up[i];
                    u32x2 w; w.x = cvt_pk_bf16(a[0], a[1]); w.y = cvt_pk_bf16(a[2], a[3]);
                    *(u32x2*)(ACT + (size_t)row * 512 + (u.pn & 3) * 128 + bj * 64 + wc * 16 + fq * 4) = w;
                }
            }
    }
};
struct EpiDown {
    static constexpr bool PERM = true;
    bf16_t* Y2; const int* list; const int* cnt; const float* tokw;
    __device__ __forceinline__ void operator()(const f32x4 (&acc)[2][2][4][2], const Unit& u, int wr, int wc, int fr, int fq) const {
        const int ne = cnt[u.e * 64];
#pragma unroll
        for (int ai = 0; ai < 2; ++ai) if (ai < u.nai)
#pragma unroll
            for (int m = 0; m < 4; ++m) {
                asm volatile("" ::: "memory");
                const int idx = u.t * 256 + u.r0 + ai * 128 + wr * 64 + m * 16 + fr;
                if (idx < ne) {
                    const int ent = list[(size_t)u.e * T + idx]; const float w = tokw[ent];
#pragma unroll
                    for (int bj = 0; bj < 2; ++bj)
                        *(u32x4*)(Y2 + (size_t)ent * 1024 + (u.pn & 3) * 256 + bj * 128 + wc * 32 + fq * 8) = pack8(acc[ai][bj][m][0] * w, acc[ai][bj][m][1] * w);
                }
            }
    }
};
}

template <bool GATHER_> struct MoeOrder {
    static constexpr bool GATHER = GATHER_;
    const LAS int* tp; const int* cnt; const int* list; int G, c;
    __device__ bool next(int i, pg8::Unit& u) const {
        const int nwg = tp[NE] * 4, nfull = (nwg / G) * G, rem = nwg - nfull; const bool halves = rem > 0 && 2 * rem <= G;
        int Lx = i * G + c; u.r0 = 0; u.nai = 2;
        if (Lx >= nfull && halves) { if (i * G != nfull || c >= 2 * rem) return false; Lx = nfull + (c >> 1); u.r0 = (c & 1) * 128; u.nai = 1; }
        if (Lx >= nwg) return false;
        const int tt = Lx >> 2;
        int e = 0;
#pragma unroll 1
        for (int k = 1; k < NE; ++k) e = (tp[k] <= tt) ? k : e;
        u.pm = tt; u.t = tt - tp[e]; u.e = e; u.pn = e * 4 + (Lx & 3); return true;
    }
    __device__ __forceinline__ int arow(const pg8::Unit& u, int r) const {
        if (!GATHER_) return u.pm * 256 + u.r0 + r;
        const int idx = u.t * 256 + u.r0 + r;
        return idx < cnt[u.e * 64] ? (list[(size_t)u.e * T + idx] >> 1) : 0;
    }
};
namespace attn {
struct Tensors {
    const bf16_t* Q; const bf16_t* K1; const bf16_t* K2; const bf16_t* VT; bf16_t* O;
    const float* sink; const float* lamp; const float* subln; float lambda_init;
};
__device__ __forceinline__ float max3f(float a, float b, float c) { float r; asm("v_max3_f32 %0, %1, %2, %3" : "=v"(r) : "v"(a), "v"(b), "v"(c)); return r; }
__device__ __forceinline__ float max32(const f32x16& a, const f32x16& b) {
    float r0 = max3f(a[0], a[1], a[2]), r1 = max3f(a[3], a[4], a[5]), r2 = max3f(a[6], a[7], a[8]), r3 = max3f(a[9], a[10], a[11]);
    r0 = max3f(r0, a[12], a[13]); r1 = max3f(r1, a[14], a[15]); r2 = max3f(r2, b[0], b[1]); r3 = max3f(r3, b[2], b[3]);
    r0 = max3f(r0, b[4], b[5]); r1 = max3f(r1, b[6], b[7]); r2 = max3f(r2, b[8], b[9]); r3 = max3f(r3, b[10], b[11]);
    r0 = max3f(r0, b[12], b[13]); r1 = max3f(r1, b[14], b[15]);
    return max3f(max3f(r0, r1, r2), r3, r3);
}
constexpr float ATT_THR = 10.f;
#define MFMA32(a, b, c) __builtin_amdgcn_mfma_f32_32x32x16_bf16((a), (b), (c), 0, 0, 0)

template <int KIND, bool PIPE = false, int VAR = 0>
__device__ __forceinline__ void phase(LAS unsigned char* lds, const Tensors P, int G, int cid, bool with_ctx) {
    asm volatile("" : "+s"(G), "+s"(cid));
    constexpr int NST = KIND == 1 ? 6 : 4, DV = KIND == 2 ? 128 : 64, NDV = DV / 32, KROWB = KIND == 0 ? 128 : 256, KCH = KIND == 0 ? 8 : (KIND == 1 ? 12 : 16);
    constexpr int KJ = (64 * KCH + 511) / 512, VJ = DV * 8 / 512, HV = KIND == 0 ? 4 : (KIND == 1 ? 16 : 8);
    constexpr int LDQ = KIND == 1 ? 1536 : 1024, LDK = KIND == 0 ? 256 : 1024;
    constexpr int KB0 = 0, VB0 = 32768, BUFSTEP = 16384, SCR = 65536;
    int tid_ = threadIdx.x; asm volatile("" : "+v"(tid_));
    const int tid = tid_, lane = tid & 63, w = __builtin_amdgcn_readfirstlane(tid >> 6), r = lane & 31, hh = lane >> 5;
    const int NU = 2048 + (with_ctx ? 128 : 0);
    constexpr int KPIECES = 64 * KROWB / 8192, VPIECES = DV * 128 / 8192;
    int ksrc[KPIECES], ksrb[KPIECES]; bool kpart2[KPIECES];
#pragma unroll
    for (int j = 0; j < KPIECES; ++j) {
        const int p = (j * 8 + w) * 1024 + lane * 16, kk = p / KROWB, pc = (p % KROWB) >> 4;
        int c = pc ^ (KROWB == 128 ? ((kk >> 1) & 7) : (kk & 15)); if (c >= KCH) c = 0;
        kpart2[j] = (KIND == 1) && c >= 8;
        ksrc[j] = kpart2[j] ? kk * 32 + (c - 8) * 8 : kk * LDK + c * 8;
        ksrb[j] = kpart2[j] ? 32 : LDK;
    }
    int vsrc[VPIECES];
#pragma unroll
    for (int j = 0; j < VPIECES; ++j) { const int p = (j * 8 + w) * 1024 + lane * 16, dv = p >> 7, pc = (p & 127) >> 4, c = pc ^ ((dv >> 1) & 7); vsrc[j] = dv * NKEY + c * 8; }
    const int rs = (r & ~12) | ((r & 4) << 1) | ((r & 8) >> 1);
    const int krow0 = rs * KROWB, krow1 = (32 + rs) * KROWB;
    const int ksw0 = KROWB == 128 ? ((rs >> 1) & 7) : (rs & 15), ksw1 = KROWB == 128 ? (((32 + rs) >> 1) & 7) : ((32 + rs) & 15);
    const int vsw = (r >> 1) & 7;
    float lam = 0.f;
    if (KIND == 2) { const float a = wave_sum(P.lamp[lane] * P.lamp[64 + lane]), b2 = wave_sum(P.lamp[128 + lane] * P.lamp[192 + lane]); lam = expf(a) - expf(b2) + P.lambda_init; }

#define ATT_DECL(X) int X##b = 0, X##hd = 0, X##qb = 0, X##qi = 0, X##wlo = 0, X##nwin = 0, X##nt = 0, X##ocol = 0, X##qcol = 0, X##kcol = 0, X##hv = 0, X##cmap = 0, X##qrow = 0, X##lat = 0
#define ATT_COPY(D_, S_) do { D_##b = S_##b; D_##hd = S_##hd; D_##qb = S_##qb; D_##qi = S_##qi; D_##wlo = S_##wlo; D_##nwin = S_##nwin; D_##nt = S_##nt; D_##ocol = S_##ocol; D_##qcol = S_##qcol; D_##kcol = S_##kcol; D_##hv = S_##hv; D_##cmap = S_##cmap; D_##qrow = S_##qrow; D_##lat = S_##lat; } while (0)
#define ATT_DECODE(U_, X) do { X##lat = (U_) < 2048; const int V_ = X##lat ? (U_) : (U_) - 2048; X##wlo = 0; X##nwin = 0; X##cmap = 0; int q0_; \
        if (KIND == 0) { \
            if (X##lat) { X##b = V_ >> 8; X##hd = (V_ >> 6) & 3; X##qb = V_ & 63; const int whi = X##qb + 2 > 63 ? 63 : X##qb + 2; X##wlo = X##qb - 2 < 0 ? 0 : X##qb - 2; X##nwin = whi - X##wlo + 1; } \
            else { X##b = V_ >> 4; X##hd = (V_ >> 2) & 3; X##qb = V_ & 3; } \
            q0_ = X##qb * 64; X##qi = q0_ + 32 * (w & 1) + r; const int hq = X##hd * 4 + (w >> 1); X##qcol = hq * 64; X##ocol = hq * 64; X##kcol = X##hd * 64; X##hv = X##hd; X##nt = X##nwin + 4; \
        } else if (KIND == 1) { \
            if (X##lat) { X##b = V_ >> 8; X##hd = (V_ >> 4) & 15; X##qb = V_ & 15; X##nt = 68; } else { X##b = V_ >> 4; X##hd = V_ & 15; X##qb = 0; X##nt = 4; } \
            q0_ = X##qb * 256; X##qi = q0_ + 32 * w + r; X##qcol = X##hd * 96; X##ocol = X##hd * 64; X##kcol = X##hd * 64; X##hv = X##hd; \
        } else { \
            if (X##lat) { X##b = V_ >> 8; X##hd = (V_ >> 5) & 7; X##qb = V_ & 31; X##nt = 68; } else { X##b = V_ >> 4; X##hd = (V_ >> 1) & 7; X##qb = V_ & 1; X##nt = 4; } \
            q0_ = X##qb * 128; X##qi = q0_ + 32 * (w & 3) + r; X##cmap = (w >> 2) * 8; X##qcol = (X##hd * 2 + (w >> 2)) * 64; X##ocol = X##hd * 128; X##kcol = X##hd * 128; X##hv = X##hd; \
        } \
        X##qrow = X##lat ? X##b * S + X##qi : TL + X##b * L + X##qi; } while (0)
#define ATT_TILE_KT(X, tt) ((KIND == 0) ? ((tt) < X##nwin ? X##wlo + (tt) : 64 + (tt) - X##nwin) : (X##lat ? (tt) : 64 + (tt)))
#define ATT_ISSUE(X, tt, buf_) do { const int kt_ = ATT_TILE_KT(X, tt); const int rb_ = kt_ < 64 ? X##b * S + 64 * kt_ : TL + X##b * L + 64 * (kt_ - 64); \
        const bf16_t* K1u_ = P.K1 + X##kcol; const bf16_t* VTu_ = P.VT + (size_t)(X##b * HV + X##hv) * DV * NKEY; \
        _Pragma("unroll") for (int j = 0; j < KPIECES; ++j) __builtin_amdgcn_global_load_lds((const unsigned*)((kpart2[j] ? P.K2 : K1u_) + (size_t)rb_ * ksrb[j] + ksrc[j]), (LAS unsigned*)(lds + KB0 + (buf_) * BUFSTEP + (j * 8 + w) * 1024), 16, 0, 0); \
        _Pragma("unroll") for (int j = 0; j < VPIECES; ++j) __builtin_amdgcn_global_load_lds((const unsigned*)(VTu_ + 64 * kt_ + vsrc[j]), (LAS unsigned*)(lds + VB0 + (buf_) * BUFSTEP + (j * 8 + w) * 1024), 16, 0, 0); } while (0)
#define ATT_QLOAD(dst, X) do { _Pragma("unroll") for (int st = 0; st < NST; ++st) dst[st] = *(const bf16x8*)(P.Q + (size_t)X##qrow * LDQ + X##qcol + 16 * st + 8 * hh); } while (0)
#define ATT_VFRAG(d, sub, sp) (*(const LAS bf16x8*)(vb + (32 * (d) + r) * 128 + 16 * ((4 * (sub) + 2 * (sp) + hh) ^ vsw)))
#define ATT_QX(SV, sp, lo, hi) do { _Pragma("unroll") for (int i_ = (lo); i_ < (hi); i_ += 2) { f32x2 t_; t_.x = __builtin_amdgcn_exp2f(SV[8 * (sp) + i_]); t_.y = __builtin_amdgcn_exp2f(SV[8 * (sp) + i_ + 1]); SV[8 * (sp) + i_] = t_.x; SV[8 * (sp) + i_ + 1] = t_.y; psv += t_; } } while (0)
#define ATT_QC(SV, sub, sp) do { u32x4 a_; a_.x = cvt_pk_bf16(SV[8 * (sp) + 0], SV[8 * (sp) + 1]); a_.y = cvt_pk_bf16(SV[8 * (sp) + 2], SV[8 * (sp) + 3]); a_.z = cvt_pk_bf16(SV[8 * (sp) + 4], SV[8 * (sp) + 5]); a_.w = cvt_pk_bf16(SV[8 * (sp) + 6], SV[8 * (sp) + 7]); pf[sub][sp] = __builtin_bit_cast(bf16x8, a_); } while (0)
#define ATT_TILE(tt, ISLAST) do { \
            const int buf = ((tt) + pb) & 1; \
            ATT_DECL(nx); if (ISLAST) { const int Un_ = U + G < NU ? U + G : U; ATT_DECODE(Un_, nx); ATT_ISSUE(nx, 0, buf ^ 1); } else { ATT_ISSUE(cu, (tt) + 1, buf ^ 1); } \
            const LAS unsigned char* kb = lds + KB0 + buf * BUFSTEP; const LAS unsigned char* vb = lds + VB0 + buf * BUFSTEP; \
            const float negm = -m; \
            f32x16 s0, s1; \
            _Pragma("unroll") for (int i = 0; i < 16; ++i) { s0[i] = negm; s1[i] = negm; } \
            { bf16x8 kf[NST][2]; \
              _Pragma("unroll") for (int st = 0; st < NST; ++st) { const int c = 2 * st + hh + cucmap; \
                  kf[st][0] = *(const LAS bf16x8*)(kb + krow0 + 16 * (c ^ ksw0)); kf[st][1] = *(const LAS bf16x8*)(kb + krow1 + 16 * (c ^ ksw1)); } \
              __builtin_amdgcn_sched_barrier(0); \
              __builtin_amdgcn_s_setprio(1); \
              _Pragma("unroll") for (int st = 0; st < NST; ++st) { s0 = MFMA32(kf[st][0], qf[st], s0); s1 = MFMA32(kf[st][1], qf[st], s1); } \
              __builtin_amdgcn_s_setprio(0); } \
            if (ISLAST) { __builtin_amdgcn_sched_barrier(0); ATT_QLOAD(qf, nx); }        \
            constexpr int NDVP = NDV < 2 ? NDV : 2; \
            bf16x8 vf[NDVP][2][2]; bf16x8 vq[2][4]; \
            if (NDV == 4) { _Pragma("unroll") for (int q = 0; q < 2; ++q) _Pragma("unroll") for (int d = 0; d < 4; ++d) vq[q][d] = ATT_VFRAG(d, 0, q); } \
            else { _Pragma("unroll") for (int d = 0; d < NDVP; ++d) _Pragma("unroll") for (int sub = 0; sub < 2; ++sub) _Pragma("unroll") for (int sp = 0; sp < 2; ++sp) vf[d][sub][sp] = ATT_VFRAG(d, sub, sp); } \
            __builtin_amdgcn_sched_barrier(0); \
            if (KIND == 0) { const int kt = ATT_TILE_KT(cu, tt); \
                if (kt < 64 && (kt == cuqb - 2 || kt == cuqb + 2)) { const int d0 = 64 * kt + 8 * hh - cuqi; \
                    _Pragma("unroll") for (int i = 0; i < 16; ++i) { const int da = d0 + (i & 7) + 16 * (i >> 3), db = da + 32; \
                        if (da < -128 || da > 128) s0[i] = -INFINITY; if (db < -128 || db > 128) s1[i] = -INFINITY; } } } \
            float mx = max32(s0, s1); \
            mx = xor32_max(mx); \
            const bool first = (KIND != 0) && (tt) == 0; \
            if (first || __any(mx > ATT_THR)) { \
                const float d = first ? mx : fmaxf(mx, 0.f), alpha = first ? 1.f : __builtin_amdgcn_exp2f(-d); \
                m += d; lsum *= alpha; \
                _Pragma("unroll") for (int dd = 0; dd < NDV; ++dd) o[dd] = o[dd] * alpha; \
                _Pragma("unroll") for (int i = 0; i < 16; ++i) { s0[i] -= d; s1[i] -= d; } } \
            f32x2 psv; psv.x = 0.f; psv.y = 0.f; \
            bf16x8 pf[2][2]; \
            ATT_QX(s0, 0, 0, 8); ATT_QC(s0, 0, 0); \
            __builtin_amdgcn_sched_barrier(0); \
            if (NDV == 4) { \
                  \
                o[0] = MFMA32(vq[0][0], pf[0][0], o[0]); o[1] = MFMA32(vq[0][1], pf[0][0], o[1]); __builtin_amdgcn_sched_barrier(0); ATT_QX(s0, 1, 0, 4); __builtin_amdgcn_sched_barrier(0); \
                o[2] = MFMA32(vq[0][2], pf[0][0], o[2]); o[3] = MFMA32(vq[0][3], pf[0][0], o[3]); __builtin_amdgcn_sched_barrier(0); ATT_QX(s0, 1, 4, 8); ATT_QC(s0, 0, 1); __builtin_amdgcn_sched_barrier(0); \
                _Pragma("unroll") for (int d = 0; d < 4; ++d) vq[0][d] = ATT_VFRAG(d, 1, 0); \
                __builtin_amdgcn_sched_barrier(0); \
                o[0] = MFMA32(vq[1][0], pf[0][1], o[0]); o[1] = MFMA32(vq[1][1], pf[0][1], o[1]); __builtin_amdgcn_sched_barrier(0); ATT_QX(s1, 0, 0, 4); __builtin_amdgcn_sched_barrier(0); \
                o[2] = MFMA32(vq[1][2], pf[0][1], o[2]); o[3] = MFMA32(vq[1][3], pf[0][1], o[3]); __builtin_amdgcn_sched_barrier(0); ATT_QX(s1, 0, 4, 8); ATT_QC(s1, 1, 0); __builtin_amdgcn_sched_barrier(0); \
                _Pragma("unroll") for (int d = 0; d < 4; ++d) vq[1][d] = ATT_VFRAG(d, 1, 1); \
                __builtin_amdgcn_sched_barrier(0); \
                o[0] = MFMA32(vq[0][0], pf[1][0], o[0]); o[1] = MFMA32(vq[0][1], pf[1][0], o[1]); __builtin_amdgcn_sched_barrier(0); ATT_QX(s1, 1, 0, 4); __builtin_amdgcn_sched_barrier(0); \
                o[2] = MFMA32(vq[0][2], pf[1][0], o[2]); o[3] = MFMA32(vq[0][3], pf[1][0], o[3]); __builtin_amdgcn_sched_barrier(0); ATT_QX(s1, 1, 4, 8); ATT_QC(s1, 1, 1); __builtin_amdgcn_sched_barrier(0); \
                o[0] = MFMA32(vq[1][0], pf[1][1], o[0]); o[1] = MFMA32(vq[1][1], pf[1][1], o[1]); o[2] = MFMA32(vq[1][2], pf[1][1], o[2]); o[3] = MFMA32(vq[1][3], pf[1][1], o[3]); \
            } else { \
                o[0] = MFMA32(vf[0][0][0], pf[0][0], o[0]); __builtin_amdgcn_sched_barrier(0); ATT_QX(s0, 1, 0, 4); __builtin_amdgcn_sched_barrier(0); \
                o[1] = MFMA32(vf[1][0][0], pf[0][0], o[1]); __builtin_amdgcn_sched_barrier(0); ATT_QX(s0, 1, 4, 8); ATT_QC(s0, 0, 1); __builtin_amdgcn_sched_barrier(0); \
                o[0] = MFMA32(vf[0][0][1], pf[0][1], o[0]); __builtin_amdgcn_sched_barrier(0); ATT_QX(s1, 0, 0, 4); __builtin_amdgcn_sched_barrier(0); \
                o[1] = MFMA32(vf[1][0][1], pf[0][1], o[1]); __builtin_amdgcn_sched_barrier(0); ATT_QX(s1, 0, 4, 8); ATT_QC(s1, 1, 0); __builtin_amdgcn_sched_barrier(0); \
                o[0] = MFMA32(vf[0][1][0], pf[1][0], o[0]); __builtin_amdgcn_sched_barrier(0); ATT_QX(s1, 1, 0, 4); __builtin_amdgcn_sched_barrier(0); \
                o[1] = MFMA32(vf[1][1][0], pf[1][0], o[1]); __builtin_amdgcn_sched_barrier(0); ATT_QX(s1, 1, 4, 8); ATT_QC(s1, 1, 1); __builtin_amdgcn_sched_barrier(0); \
                o[0] = MFMA32(vf[0][1][1], pf[1][1], o[0]); o[1] = MFMA32(vf[1][1][1], pf[1][1], o[1]); \
            } \
            lsum += psv.x + psv.y; \
            __syncthreads(); } while (0)

    int pb = 0;
    bf16x8 qf[NST];
    if (cid < NU) { ATT_DECL(cu); ATT_DECODE(cid, cu); ATT_QLOAD(qf, cu); ATT_ISSUE(cu, 0, 0); __syncthreads(); }
    for (int U = cid; U < NU; U += G) {
        ATT_DECL(cu); ATT_DECODE(U, cu);
        const int nt = cunt, qrow = cuqrow, ocol = cuocol;
        float m = 0.f, lsum = 0.f;
        if (KIND == 0) { m = P.sink[cuhd * 4 + (w >> 1)] * LOG2E; lsum = hh == 0 ? 1.f : 0.f; }
        f32x16 o[NDV];
#pragma unroll
        for (int d = 0; d < NDV; ++d)
#pragma unroll
            for (int i = 0; i < 16; ++i) o[d][i] = 0.f;
        for (int tt = 0; tt < nt - 1; ++tt) ATT_TILE(tt, 0);
        ATT_TILE(nt - 1, 1);
        pb = (nt + pb) & 1;
        const float inv = 1.f / (xor32_sum(lsum));
        if (KIND != 2) {
#pragma unroll
            for (int d = 0; d < NDV; ++d)
#pragma unroll
                for (int g4 = 0; g4 < 4; ++g4) {
                    u32x2 wv; wv.x = cvt_pk_bf16(o[d][4 * g4] * inv, o[d][4 * g4 + 1] * inv); wv.y = cvt_pk_bf16(o[d][4 * g4 + 2] * inv, o[d][4 * g4 + 3] * inv);
                    *(u32x2*)(P.O + (size_t)qrow * 1024 + ocol + 32 * d + 8 * g4 + 4 * hh) = wv;
                }
        } else {
            LAS float* scr = (LAS float*)(lds + SCR) + (size_t)(w & 3) * 64 * 64 + lane;
            if (w >= 4) {
#pragma unroll
                for (int d = 0; d < NDV; ++d)
#pragma unroll
                    for (int i = 0; i < 16; ++i) scr[(d * 16 + i) * 64] = o[d][i] * inv;
            }
            __syncthreads();
            if (w < 4) {
                float ss = 0.f;
#pragma unroll
                for (int d = 0; d < NDV; ++d)
#pragma unroll
                    for (int i = 0; i < 16; ++i) { const float v = o[d][i] * inv - lam * scr[(d * 16 + i) * 64]; o[d][i] = v; ss += v * v; }
                ss = xor32_sum(ss);
                const float rsn = (1.f - P.lambda_init) / sqrtf(ss * (1.f / 128.f) + RMS_EPS);
#pragma unroll
                for (int d = 0; d < NDV; ++d)
#pragma unroll
                    for (int g4 = 0; g4 < 4; ++g4) {
                        const int dv0 = 32 * d + 8 * g4 + 4 * hh; const f32x4 gv = *(const f32x4*)(P.subln + dv0);
                        u32x2 wv; wv.x = cvt_pk_bf16(o[d][4 * g4] * rsn * gv[0], o[d][4 * g4 + 1] * rsn * gv[1]); wv.y = cvt_pk_bf16(o[d][4 * g4 + 2] * rsn * gv[2], o[d][4 * g4 + 3] * rsn * gv[3]);
                        *(u32x2*)(P.O + (size_t)qrow * 1024 + ocol + dv0) = wv;
                    }
            }
        }
    }
#undef ATT_DECL
#undef ATT_COPY
#undef ATT_DECODE
#undef ATT_TILE_KT
#undef ATT_ISSUE
#undef ATT_QLOAD
#undef ATT_TILE
}
}
namespace thin {
__device__ __forceinline__ int sig64(int p) { return (p >> 5) * 32 + ((p & 31) >> 1) + 16 * (p & 1); }
__device__ __forceinline__ int sig32(int p) { return (p >> 4) * 16 + ((p & 15) >> 1) + 8 * (p & 1); }
__device__ __forceinline__ int src_col(int mode, int lim, int n, bool& second) {
    second = false;
    switch (mode) {
        case 1: return n < lim ? (n & ~63) + sig64(n & 63) : n;
        case 2: return n < 768 ? n : (n < 800 ? 768 + sig32(n - 768) : -1);
        case 3: { const int hq = n / 96, w = n % 96; return w < 64 ? n : hq * 96 + 64 + sig32(w - 64); }
        case 4: return n < 1024 ? (n >> 6) * 128 + (n & 63) : ((n - 1024) >> 6) * 128 + 64 + (n & 63);
        case 5: second = (n & 7) >= 4; return 4 * (n >> 3) + (n & 3);
        default: return n;
    }
}
__device__ __forceinline__ void conv_item(const float* src, const float* src2, const float* gain, int Nsrc, int K, int N, int mode, int lim, bf16_t* WT, int item, LAS float* scr, int lane) {
    const int nblk = N >> 6, kb = item / nblk, nb = item % nblk, k0 = kb * 64, n0 = nb * 64;
    bool second; const int col = src_col(mode, lim, n0 + lane, second);
    const float* sp = (second ? src2 : src) + (col < 0 ? 0 : col);
    float vv[64];
#pragma unroll
    for (int kk = 0; kk < 64; ++kk) vv[kk] = col < 0 ? 0.f : __builtin_nontemporal_load(sp + (size_t)(k0 + kk) * Nsrc);
    if (gain) {
#pragma unroll
        for (int kk = 0; kk < 64; ++kk) vv[kk] *= gain[k0 + kk];
    }
#pragma unroll
    for (int kk = 0; kk < 64; ++kk) scr[kk * 65 + lane] = vv[kk];
    asm volatile("s_waitcnt lgkmcnt(0)" ::: "memory");
    const int c = lane & 7;
#pragma unroll
    for (int j = 0; j < 8; ++j) { const int n = (lane >> 3) + 8 * j; const LAS float* s = scr + (8 * c) * 65 + n;
        u32x4 o; o.x = cvt_pk_bf16(s[0 * 65], s[1 * 65]); o.y = cvt_pk_bf16(s[2 * 65], s[3 * 65]); o.z = cvt_pk_bf16(s[4 * 65], s[5 * 65]); o.w = cvt_pk_bf16(s[6 * 65], s[7 * 65]);
        __builtin_nontemporal_store(o, (u32x4*)(WT + (size_t)(n0 + n) * K + k0 + 8 * c)); }
    asm volatile("s_waitcnt lgkmcnt(0)" ::: "memory");
}
constexpr int MOE_ITEMS = NE * 256 + NE * 128;
__device__ __forceinline__ void moe_fill(LAS unsigned char* lds, const float* w_gate, const float* w_up, const float* w_down, unsigned char* ws, int layer, int max_items, int* qctr) {
    int tid_ = threadIdx.x; asm volatile("" : "+v"(tid_));
    const int lane = tid_ & 63, w = __builtin_amdgcn_readfirstlane(tid_ >> 6);
    LAS float* scr = (LAS float*)lds + w * (64 * 65);
    for (int n = 0; n < max_items; ++n) {
        int it = 0; if (lane == 0) it = atomicAdd(qctr, 1);
        it = __builtin_amdgcn_readfirstlane(it);
        if (it >= MOE_ITEMS) break;
        if (it < NE * 256) { const int mi = layer * NE + (it >> 8), ii = it & 255;
            conv_item(w_gate + (size_t)mi * 1024 * 512, w_up + (size_t)mi * 1024 * 512, nullptr, 512, 1024, 1024, 5, 0, (bf16_t*)(ws + WS_WGU) + (size_t)mi * 1024 * 1024, ii, scr, lane); }
        else { const int r = it - NE * 256, mi = layer * NE + (r >> 7), ii = r & 127;
            conv_item(w_down + (size_t)mi * 512 * 1024, nullptr, nullptr, 1024, 512, 1024, 0, 0, (bf16_t*)(ws + WS_WD) + (size_t)mi * 1024 * 512, ii, scr, lane); }
    }
}
struct ProIn {
    const float *c, *c_ctx, *ada_w, *ada_b, *win_w_in, *win_w_out, *mla_w_in, *mla_q_norm, *mla_kv_norm, *mla_w_uq, *mla_w_ukv, *mla_w_out, *dif_w_in, *dif_w_out,
                *moe_w_grp, *moe_w_rt, *moe_w_gate, *moe_w_up, *moe_w_down;
    unsigned char* ws;
};
__device__ __forceinline__ void prologue(LAS unsigned char* lds, const ProIn& I, int G, int cid) {
    const int tid = threadIdx.x, lane = tid & 63, w = __builtin_amdgcn_readfirstlane(tid >> 6);
    unsigned char* ws = I.ws;
    {
        LAS float* scr = (LAS float*)lds + w * (64 * 65);
        const int gw = cid * NWAVES + w, NGW = G * NWAVES;
        constexpr int I_AIN = 16 * 24, I_SQ = 16 * 16, I_BUQ = 8 * 24, I_BUKV = 4 * 32, I_CIN = 16 * 48, I_GU = 16 * 16, I_D = 8 * 16;
        constexpr int NSMALL = 2 * I_AIN + 2 * I_SQ + I_SQ + I_BUQ + I_BUKV + I_SQ + I_CIN + I_SQ;
        constexpr int NITEMS = NSMALL + 128 * I_GU + 128 * I_D;
        for (int it = gw; it < NITEMS; it += NGW) {
            int r = it;
            if (r >= NSMALL) {
                r -= NSMALL;
                if (r < 128 * I_GU) { const int mi = r / I_GU, ii = r % I_GU;
                    conv_item(I.moe_w_gate + (size_t)mi * 1024 * 512, I.moe_w_up + (size_t)mi * 1024 * 512, nullptr, 512, 1024, 1024, 5, 0, (bf16_t*)(ws + WS_WGU) + (size_t)mi * 1024 * 1024, ii, scr, lane); }
                else { r -= 128 * I_GU; const int mi = r / I_D, ii = r % I_D;
                    conv_item(I.moe_w_down + (size_t)mi * 512 * 1024, nullptr, nullptr, 1024, 512, 1024, 0, 0, (bf16_t*)(ws + WS_WD) + (size_t)mi * 1024 * 512, ii, scr, lane); }
                continue;
            }
            if (r < 2 * I_AIN) { const int s = r / I_AIN; conv_item(I.win_w_in + (size_t)s * 1024 * 1536, nullptr, nullptr, 1536, 1024, 1536, 1, 1280, (bf16_t*)(ws + W_A_IN) + (size_t)s * 1536 * 1024, r % I_AIN, scr, lane); continue; } r -= 2 * I_AIN;
            if (r < 2 * I_SQ) { const int s = r / I_SQ; conv_item(I.win_w_out + (size_t)s * 1024 * 1024, nullptr, nullptr, 1024, 1024, 1024, 0, 0, (bf16_t*)(ws + W_A_OUT) + (size_t)s * 1024 * 1024, r % I_SQ, scr, lane); continue; } r -= 2 * I_SQ;
            if (r < I_SQ) { conv_item(I.mla_w_in, nullptr, nullptr, 800, 1024, 1024, 2, 0, (bf16_t*)(ws + W_B_IN), r, scr, lane); continue; } r -= I_SQ;
            if (r < I_BUQ) { conv_item(I.mla_w_uq, nullptr, I.mla_q_norm, 1536, 512, 1536, 3, 0, (bf16_t*)(ws + W_B_UQ), r, scr, lane); continue; } r -= I_BUQ;
            if (r < I_BUKV) { conv_item(I.mla_w_ukv, nullptr, I.mla_kv_norm, 2048, 256, 2048, 4, 0, (bf16_t*)(ws + W_B_UKV), r, scr, lane); continue; } r -= I_BUKV;
            if (r < I_SQ) { conv_item(I.mla_w_out, nullptr, nullptr, 1024, 1024, 1024, 0, 0, (bf16_t*)(ws + W_B_OUT), r, scr, lane); continue; } r -= I_SQ;
            if (r < I_CIN) { conv_item(I.dif_w_in, nullptr, nullptr, 3072, 1024, 3072, 1, 2048, (bf16_t*)(ws + W_C_IN), r, scr, lane); continue; } r -= I_CIN;
            conv_item(I.dif_w_out, nullptr, nullptr, 1024, 1024, 1024, 0, 0, (bf16_t*)(ws + W_C_OUT), r, scr, lane);
        }
    }
    __syncthreads();
    {
        LAS float* sc = (LAS float*)lds;
        LAS float* red = sc + 9 * 1024;
        for (int idx = tid; idx < 9 * 1024; idx += NTHREADS) { const int m = idx >> 10, k = idx & 1023; const float v = m < 8 ? I.c[m * 1024 + k] : I.c_ctx[k]; sc[idx] = v / (1.f + expf(-v)); }
        __syncthreads();
        float* mod = (float*)(ws + WS_MOD);
        for (int task = cid; task < DEPTH * 96; task += G) {
            const int layer = task / 96, j = (task % 96) * 64 + lane;
            float acc[9];
#pragma unroll
            for (int m = 0; m < 9; ++m) acc[m] = 0.f;
            const float* wp = I.ada_w + ((size_t)layer * 1024 + w * 128) * 6144 + j;
#pragma unroll 32
            for (int k = 0; k < 128; ++k) { const float wv = wp[(size_t)k * 6144];
#pragma unroll
                for (int m = 0; m < 9; ++m) acc[m] = fmaf(sc[m * 1024 + w * 128 + k], wv, acc[m]); }
#pragma unroll
            for (int m = 0; m < 9; ++m) red[(w * 9 + m) * 64 + lane] = acc[m];
            __syncthreads();
            for (int o = tid; o < 9 * 64; o += NTHREADS) { const int m = o >> 6, jl = o & 63; float s = 0.f;
#pragma unroll
                for (int ww = 0; ww < 8; ++ww) s += red[(ww * 9 + m) * 64 + jl];
                const int jj = (task % 96) * 64 + jl; mod[((size_t)layer * 9 + m) * 6144 + jj] = s + I.ada_b[layer * 6144 + jj]; }
            __syncthreads();
        }
    }
    {
        const int gt = cid * NTHREADS + tid, NGT = G * NTHREADS;
        float2* tab64 = (float2*)(ws + WS_TAB64); float2* tab32 = (float2*)(ws + WS_TAB32);
        for (int t = gt; t < 64 * 16 + 64 * 8; t += NGT) {
            if (t < 1024) { const int pos = t >> 4, j = t & 15; const float inv = (float)pow(10000.0, -(double)(2 * j) / 32.0), ang = (float)pos * inv;
                tab64[t] = make_float2((float)cos((double)ang), (float)sin((double)ang)); }
            else { const int u = t - 1024, pos = u >> 3, j = u & 7; const float inv = (float)pow(10000.0, -(double)(2 * j) / 16.0), ang = (float)pos * inv;
                tab32[u] = make_float2((float)cos((double)ang), (float)sin((double)ang)); }
        }
        bf16_t* rtw = (bf16_t*)(ws + WS_RTW);
        for (int t = gt; t < DEPTH * 64 * 1024; t += NGT) {
            const int layer = t >> 16, n = (t >> 10) & 63, k = t & 1023;
            float v = 0.f;
            if (n < 4) v = I.moe_w_grp[((size_t)layer * 1024 + k) * 4 + n]; else if (n < 36) v = I.moe_w_rt[((size_t)layer * 1024 + k) * 32 + (n - 4)];
            const unsigned hi = f2bf(v); const unsigned lo = f2bf(v - bf2f(hi));
            rtw[((size_t)layer * 2 + 0) * 65536 + n * 1024 + k] = (bf16_t)hi; rtw[((size_t)layer * 2 + 1) * 65536 + n * 1024 + k] = (bf16_t)lo;
        }
    }
}
__device__ __forceinline__ void phase_h0(const float* x, const float* ctx, const float* mod0, bf16_t* H, int G, int cid) {
    const int lane = threadIdx.x & 63, gw = cid * NWAVES + (threadIdx.x >> 6), NGW = G * NWAVES;
    for (int row0 = gw * 2; row0 < T; row0 += NGW * 2) {
        const float* src = row0 < TL ? x + (size_t)row0 * 1024 : ctx + (size_t)(row0 - TL) * 1024; const float* mp = mod0 + (size_t)mrow_of(row0) * 6144;
        f32x4 v[2][4];
#pragma unroll
        for (int rr = 0; rr < 2; ++rr)
#pragma unroll
            for (int i = 0; i < 4; ++i) v[rr][i] = *(const f32x4*)(src + rr * 1024 + i * 256 + lane * 4);
#pragma unroll
        for (int rr = 0; rr < 2; ++rr)
#pragma unroll
            for (int i = 0; i < 4; ++i) { const int c = i * 256 + lane * 4;
                const f32x4 sh = *(const f32x4*)(mp + c), sc = *(const f32x4*)(mp + 1024 + c);
                const f32x4 h = v[rr][i] * (sc + 1.f) + sh; u32x2 wv; wv.x = cvt_pk_bf16(h[0], h[1]); wv.y = cvt_pk_bf16(h[2], h[3]);
                *(u32x2*)(H + (size_t)(row0 + rr) * 1024 + c) = wv; }
    }
}
constexpr int CNT_STRIDE = 64;
struct LnrArgs { const float* Xl; const float* Xc; const bf16_t* Y; float* STATS; bf16_t* H; const float* modl; const float* gam; const float* bet; const bf16_t* rtw; const float* b_grp; const float* b_rt; int* cnt; int* list; float* tokw; int nrows; };
#define LBAR() do { asm volatile("s_waitcnt lgkmcnt(0)" ::: "memory"); __builtin_amdgcn_s_barrier(); asm volatile("" ::: "memory"); } while (0)
template <int VAR = 0, bool XBF = false>
__device__ __forceinline__ void phase_lnr(LAS unsigned char* lds, const LnrArgs A, int G, int cid) {
    asm volatile("" : "+s"(G), "+s"(cid));
    constexpr int TSTR = 2064;
    int tid_ = threadIdx.x; asm volatile("" : "+v"(tid_));
    const int tid = tid_, lane = tid & 63, w = __builtin_amdgcn_readfirstlane(tid >> 6), r = lane & 31, hh = lane >> 5;
    LAS unsigned char* THI = lds; LAS unsigned char* TLO = lds + 32 * TSTR;
    LAS float* PART = (LAS float*)lds;

    LAS int* bcnt = (LAS int*)(lds + 2 * 32 * TSTR);
    LAS int* bbase = bcnt + 32;
    LAS float* bias = (LAS float*)(bbase + 32);
    LAS int* ents = (LAS int*)(bias + 40);
    LAS float* LOG = (LAS float*)(ents + 16 * 64 * 2);
    const int ngroups = A.nrows >> 5;
    const int nfull = (ngroups / G) * G, rem = ngroups - nfull; const bool halves = rem > 0 && 2 * rem <= G;
    const int nitems = halves ? nfull + 2 * rem : ngroups;
#define LNR_ITEM(j, grp_, h_, nr_) const int grp_ = (j) < nfull || !halves ? (j) : nfull + (((j) - nfull) >> 1); const int h_ = (j) < nfull || !halves ? 0 : (((j) - nfull) & 1); const int nr_ = (j) < nfull || !halves ? 32 : 16
    if (tid < 32) bcnt[tid] = 0;
    if (tid < 36) bias[tid] = tid < 4 ? A.b_grp[tid] : A.b_rt[tid - 4];
    f32x4 z[4][4]; u32x2 zr[4][4]; u32x2 yv[4][4];
#define LNR_LOAD(j_) do { LNR_ITEM(j_, g__, h__, n__); \
        _Pragma("unroll") for (int t4 = 0; t4 < 4; ++t4) { const int tl_ = 4 * w + t4; const int row_ = g__ * 32 + h__ * 16 + (tl_ < n__ ? tl_ : tl_ - 16); \
        const float* xs_ = row_ < TL ? A.Xl + (size_t)row_ * 1024 : A.Xc + (size_t)(row_ - TL) * 1024; \
        const bf16_t* xb_ = row_ < TL ? (const bf16_t*)A.Xl + (size_t)row_ * 1024 : (const bf16_t*)A.Xc + (size_t)(row_ - TL) * 1024; \
        _Pragma("unroll") for (int i = 0; i < 4; ++i) { if (XBF) zr[t4][i] = *(const u32x2*)(xb_ + i * 256 + lane * 4); else z[t4][i] = *(const f32x4*)(xs_ + i * 256 + lane * 4); \
            yv[t4][i] = *(const u32x2*)(A.Y + (size_t)row_ * 1024 + i * 256 + lane * 4); } } } while (0)
    if (cid < nitems) LNR_LOAD(cid);
    int gi = 0;
    for (int item = cid; item < nitems; item += G, ++gi) {
        LNR_ITEM(item, grp, hsel, nrow);
        f32x4 pgv[4], pga[4], pbe[4], psc[4], psh[4];
        { const float* mq_ = A.modl + (size_t)mrow_of(grp * 32 + hsel * 16) * 6144;
#pragma unroll
          for (int i = 0; i < 4; ++i) { const int c_ = i * 256 + lane * 4;
              pgv[i] = *(const f32x4*)(mq_ + 2 * 1024 + c_); psc[i] = *(const f32x4*)(mq_ + 4 * 1024 + c_); psh[i] = *(const f32x4*)(mq_ + 3 * 1024 + c_);
              if (XBF) { pga[i] = *(const f32x4*)(A.gam + c_); pbe[i] = *(const f32x4*)(A.bet + c_); } } }
        __builtin_amdgcn_sched_barrier(0);
#pragma unroll
        for (int t4 = 0; t4 < 4; ++t4) {
            const int tl = 4 * w + t4, row = grp * 32 + hsel * 16 + (tl < nrow ? tl : tl - 16); const bool rvalid = tl < nrow; const float* mp = A.modl + (size_t)mrow_of(row) * 6144;
            float s = 0.f, q = 0.f;
            if (XBF) {
#pragma unroll
                for (int i = 0; i < 4; ++i) { const u32x2 xr = zr[t4][i]; z[t4][i][0] = f16lo(xr.x); z[t4][i][1] = f16hi(xr.x); z[t4][i][2] = f16lo(xr.y); z[t4][i][3] = f16hi(xr.y); }
            }
#pragma unroll
            for (int i = 0; i < 4; ++i) { const f32x4 gv = pgv[i]; const u32x2 yb = yv[t4][i];
                f32x4 y; y[0] = bf2f(yb.x & 0xffffu); y[1] = bf2f(yb.x >> 16); y[2] = bf2f(yb.y & 0xffffu); y[3] = bf2f(yb.y >> 16);
                const f32x4 v = z[t4][i] * DN_ALPHA + gv * y; z[t4][i] = v; s += (v[0] + v[1]) + (v[2] + v[3]); q += (v[0] * v[0] + v[1] * v[1]) + (v[2] * v[2] + v[3] * v[3]); }
            wave_sum2(s, q);
            const float mean = s * (1.f / 1024.f); const float var = fmaxf(q * (1.f / 1024.f) - mean * mean, 0.f);
            const float rstd = 1.0f / sqrtf(var + LN_EPS);
            if (lane == 0 && rvalid) *(f32x2*)(A.STATS + (size_t)row * 2) = (f32x2){mean, rstd};
#pragma unroll
            for (int i = 0; i < 4; ++i) { const int c = i * 256 + lane * 4;
                const f32x4 ga_ = XBF ? pga[i] : *(const f32x4*)(A.gam + c), be_ = XBF ? pbe[i] : *(const f32x4*)(A.bet + c);
                const f32x4 xo = (z[t4][i] - mean) * rstd * ga_ + be_;
                const f32x4 h = xo * (psc[i] + 1.f) + psh[i];
                u32x2 hi; hi.x = cvt_pk_bf16(h[0], h[1]); hi.y = cvt_pk_bf16(h[2], h[3]);
                if (rvalid) *(u32x2*)(A.H + (size_t)row * 1024 + c) = hi;
                f32x4 rem; rem[0] = h[0] - bf2f(hi.x & 0xffffu); rem[1] = h[1] - bf2f(hi.x >> 16); rem[2] = h[2] - bf2f(hi.y & 0xffffu); rem[3] = h[3] - bf2f(hi.y >> 16);
                u32x2 lo; lo.x = cvt_pk_bf16(rem[0], rem[1]); lo.y = cvt_pk_bf16(rem[2], rem[3]);
                *(LAS u32x2*)(THI + tl * TSTR + c * 2) = hi; *(LAS u32x2*)(TLO + tl * TSTR + c * 2) = lo; }
            if (XBF && item + G < nitems) { LNR_ITEM(item + G, g2_, h2_, n2_); const int row2 = g2_ * 32 + h2_ * 16 + (tl < n2_ ? tl : tl - 16);
                const bf16_t* xb2 = row2 < TL ? (const bf16_t*)A.Xl + (size_t)row2 * 1024 : (const bf16_t*)A.Xc + (size_t)(row2 - TL) * 1024;
#pragma unroll
                for (int i = 0; i < 4; ++i) { zr[t4][i] = *(const u32x2*)(xb2 + i * 256 + lane * 4); yv[t4][i] = *(const u32x2*)(A.Y + (size_t)row2 * 1024 + i * 256 + lane * 4); } }
        }
        LBAR();
        if (VAR == 1) { if (!XBF && item + G < nitems) LNR_LOAD(item + G); continue; }
        f32x16 acc, acc2, acc3;
#pragma unroll
        for (int i = 0; i < 16; ++i) { acc[i] = 0.f; acc2[i] = 0.f; acc3[i] = 0.f; }
        { const int ct = w & 1, ks = w >> 1; const bf16_t* bh = A.rtw + (size_t)(ct * 32 + r) * 1024 + ks * 256 + 8 * hh; const bf16_t* bl = bh + 65536;
          bf16x8 wh[16], wl[16];
#pragma unroll
          for (int st = 0; st < 16; ++st) { wh[st] = *(const bf16x8*)(bh + 16 * st); wl[st] = *(const bf16x8*)(bl + 16 * st); }
#pragma unroll
          for (int st = 0; st < 16; ++st) {
              const bf16x8 ah = *(const LAS bf16x8*)(THI + r * TSTR + (ks * 256 + 16 * st + 8 * hh) * 2), al = *(const LAS bf16x8*)(TLO + r * TSTR + (ks * 256 + 16 * st + 8 * hh) * 2);
              acc = MFMA32(ah, wh[st], acc); acc2 = MFMA32(ah, wl[st], acc2); acc3 = MFMA32(al, wh[st], acc3);
          }
          acc = acc + acc2 + acc3; }
        if (!XBF && item + G < nitems) LNR_LOAD(item + G);
        LBAR();
#pragma unroll
        for (int i = 0; i < 16; ++i) PART[(w * 32 + (i & 3) + 8 * (i >> 2) + 4 * hh) * 33 + r] = acc[i];
        LBAR();
        for (int o = tid; o < 32 * 36; o += NTHREADS) { const int tk = o / 36, n = o % 36, ct = n >> 5, nl = n & 31;
            float s = 0.f;
#pragma unroll
            for (int ks = 0; ks < 4; ++ks) s += PART[((ks * 2 + ct) * 32 + tk) * 33 + nl];
            LOG[tk * 40 + n] = s + bias[n]; }
        LBAR();
        if (VAR != 2 && tid < nrow) {
            const LAS float* lg = LOG + tid * 40; const int row = grp * 32 + hsel * 16 + tid;
            const float g0 = lg[0], g1 = lg[1], g2 = lg[2], g3 = lg[3];
            int gs = 0; float gm = g0;
            if (g1 > gm) { gm = g1; gs = 1; } if (g2 > gm) { gm = g2; gs = 2; } if (g3 > gm) { gm = g3; gs = 3; }
            const float pg = 1.f / (expf(g0 - gm) + expf(g1 - gm) + expf(g2 - gm) + expf(g3 - gm));
            int i1 = 0; float v1 = lg[4 + gs * 8];
            for (int j = 1; j < 8; ++j) { const float v = lg[4 + gs * 8 + j]; if (v > v1) { v1 = v; i1 = j; } }
            int i2 = -1; float v2 = -INFINITY;
            for (int j = 0; j < 8; ++j) { const float v = lg[4 + gs * 8 + j]; if (j != i1 && v > v2) { v2 = v; i2 = j; } }
            const int ea = gs * 8 + i1, eb = gs * 8 + i2;
            const int ra = __hip_atomic_fetch_add(bcnt + ea, 1, __ATOMIC_RELAXED, __HIP_MEMORY_SCOPE_WORKGROUP), rb = __hip_atomic_fetch_add(bcnt + eb, 1, __ATOMIC_RELAXED, __HIP_MEMORY_SCOPE_WORKGROUP);
            const float e2 = expf(v2 - v1), w1 = pg / (1.f + e2), w2 = pg * e2 / (1.f + e2);
            *(f32x2*)(A.tokw + (size_t)row * 2) = (f32x2){w1, w2};
            LAS int* ep = ents + (gi * 64 + tid * 2) * 2;
            ep[0] = (ea << 16) | ra; ep[1] = row * 2; ep[2] = (eb << 16) | rb; ep[3] = row * 2 + 1;
        } else if (VAR != 2 && tid < 32) {
            LAS int* ep = ents + (gi * 64 + tid * 2) * 2; ep[0] = -1; ep[2] = -1;
        }
    }
#undef LNR_LOAD
#undef LNR_ITEM
    if (tid < 32) { const int n = bcnt[tid]; bbase[tid] = n ? atomicAdd(&A.cnt[tid * CNT_STRIDE], n) : 0; }
    __syncthreads();
    if (VAR == 0) for (int i = tid; i < gi * 64; i += NTHREADS) { const int key = ents[2 * i], val = ents[2 * i + 1], e = key >> 16; if (key >= 0) A.list[(size_t)e * T + bbase[e] + (key & 0xffff)] = val; }
    __syncthreads();
}
struct LnfArgs { const float* Xl; const float* Xc; const bf16_t* Y; const float* STATS; const bf16_t* Y2; const float* modl; const float* gam1; const float* bet1; const float* gam; const float* bet; float* Xout; bf16_t* H; const float* modn; int nrows; };
template <bool XINBF = false, bool XOUTBF = false>
__device__ __forceinline__ void phase_lnf(const LnfArgs A, int G, int cid) {
    asm volatile("" : "+s"(G), "+s"(cid));
    int tid_ = threadIdx.x; asm volatile("" : "+v"(tid_));
    const int lane = tid_ & 63, gw = cid * NWAVES + (tid_ >> 6), NGW = G * NWAVES;
#define LNF_DECL(S) f32x4 S##z[2][4]; u32x2 S##zr[2][4], S##yv[2][4], S##ya[2][4], S##yb[2][4]; f32x2 S##st[2]
#define LNF_LOAD(S, R0) do { const int r0_ = (R0); \
        const float* xs = r0_ < TL ? A.Xl + (size_t)r0_ * 1024 : A.Xc + (size_t)(r0_ - TL) * 1024; \
        const bf16_t* xb = r0_ < TL ? (const bf16_t*)A.Xl + (size_t)r0_ * 1024 : (const bf16_t*)A.Xc + (size_t)(r0_ - TL) * 1024; \
        _Pragma("unroll") for (int rr = 0; rr < 2; ++rr) { \
            S##st[rr] = *(const f32x2*)(A.STATS + (size_t)(r0_ + rr) * 2); \
            _Pragma("unroll") for (int i = 0; i < 4; ++i) { const int c = i * 256 + lane * 4; const size_t row = (size_t)(r0_ + rr); \
                if (XINBF) S##zr[rr][i] = *(const u32x2*)(xb + rr * 1024 + c); else S##z[rr][i] = *(const f32x4*)(xs + rr * 1024 + c); \
                S##yv[rr][i] = *(const u32x2*)(A.Y + row * 1024 + c); \
                S##ya[rr][i] = *(const u32x2*)(A.Y2 + row * 2048 + c); S##yb[rr][i] = *(const u32x2*)(A.Y2 + row * 2048 + 1024 + c); } } } while (0)
#define LNF_COMPUTE(S, R0) do { const int r0_ = (R0); \
        const int mr = mrow_of(r0_); const float* gm = A.modl + (size_t)mr * 6144 + 2 * 1024; const float* gf = A.modl + (size_t)mr * 6144 + 5 * 1024;        \
          \
        f32x4 pg1[4], pg2[4], pa1[4], pb1[4], pa[4], pb[4], psc[4], psh[4]; \
        _Pragma("unroll") for (int i = 0; i < 4; ++i) { const int c = i * 256 + lane * 4; \
            pg1[i] = *(const f32x4*)(gm + c); pg2[i] = *(const f32x4*)(gf + c); pa1[i] = *(const f32x4*)(A.gam1 + c); pb1[i] = *(const f32x4*)(A.bet1 + c); \
            pa[i] = *(const f32x4*)(A.gam + c); pb[i] = *(const f32x4*)(A.bet + c); \
            if (XINBF && A.H) { const float* mp = A.modn + (size_t)mr * 6144; psc[i] = *(const f32x4*)(mp + 1024 + c); psh[i] = *(const f32x4*)(mp + c); } } \
        __builtin_amdgcn_sched_barrier(0); \
        _Pragma("unroll") for (int rr = 0; rr < 2; ++rr) { \
            const size_t row = (size_t)(r0_ + rr); \
            f32x4 zz[4]; float s = 0.f, q = 0.f; \
            _Pragma("unroll") for (int i = 0; i < 4; ++i) { \
                const u32x2 y1 = S##yv[rr][i], a = S##ya[rr][i], b = S##yb[rr][i]; \
                f32x4 xin; if (XINBF) { const u32x2 xr = S##zr[rr][i]; xin[0] = f16lo(xr.x); xin[1] = f16hi(xr.x); xin[2] = f16lo(xr.y); xin[3] = f16hi(xr.y); } else xin = S##z[rr][i]; \
                f32x4 ym; ym[0] = bf2f(y1.x & 0xffffu); ym[1] = bf2f(y1.x >> 16); ym[2] = bf2f(y1.y & 0xffffu); ym[3] = bf2f(y1.y >> 16); \
                const f32x4 x1 = ((xin * DN_ALPHA + pg1[i] * ym) - S##st[rr][0]) * S##st[rr][1] * pa1[i] + pb1[i]; \
                f32x4 y; y[0] = bf2f(a.x & 0xffffu) + bf2f(b.x & 0xffffu); y[1] = bf2f(a.x >> 16) + bf2f(b.x >> 16); y[2] = bf2f(a.y & 0xffffu) + bf2f(b.y & 0xffffu); y[3] = bf2f(a.y >> 16) + bf2f(b.y >> 16); \
                const f32x4 v = x1 * DN_ALPHA + pg2[i] * y; zz[i] = v; s += (v[0] + v[1]) + (v[2] + v[3]); q += (v[0] * v[0] + v[1] * v[1]) + (v[2] * v[2] + v[3] * v[3]); } \
            wave_sum2(s, q); \
            const float mean = s * (1.f / 1024.f); const float var = fmaxf(q * (1.f / 1024.f) - mean * mean, 0.f); \
            const float rstd = 1.0f / sqrtf(var + LN_EPS); \
            _Pragma("unroll") for (int i = 0; i < 4; ++i) { const int c = i * 256 + lane * 4; \
                const f32x4 xo = (zz[i] - mean) * rstd * pa[i] + pb[i]; \
                if (XOUTBF) { u32x2 xw; xw.x = pack_f16(xo[0], xo[1]); xw.y = pack_f16(xo[2], xo[3]); *(u32x2*)((bf16_t*)A.Xout + row * 1024 + c) = xw; } \
                else *(f32x4*)(A.Xout + row * 1024 + c) = xo; \
                if (A.H) { const float* mp = A.modn + (size_t)mr * 6144; const f32x4 sc_ = XINBF ? psc[i] : *(const f32x4*)(mp + 1024 + c), sh_ = XINBF ? psh[i] : *(const f32x4*)(mp + c);        \
                    const f32x4 h = xo * (sc_ + 1.f) + sh_; \
                    u32x2 wv; wv.x = cvt_pk_bf16(h[0], h[1]); wv.y = cvt_pk_bf16(h[2], h[3]); *(u32x2*)(A.H + row * 1024 + c) = wv; } } } } while (0)
    const int stride = NGW * 2;
    LNF_DECL(c_);
    for (int row0 = gw * 2; row0 < A.nrows; row0 += stride) { LNF_LOAD(c_, row0); LNF_COMPUTE(c_, row0); }
}
#undef LNF_DECL
#undef LNF_LOAD
#undef LNF_COMPUTE
}
#ifndef PH_MASK
#define PH_MASK 0xFFFF
#endif
#define PH_EN(k) ((PH_MASK >> (k)) & 1)
#ifndef PH_REPM
#define PH_REPM 0
#endif
#define NREP(k) (((PH_REPM >> (k)) & 1) ? 2 : 1)
#ifndef ATT_PIPE_A
#define ATT_PIPE_A false
#endif
#ifndef ATT_PIPE_B
#define ATT_PIPE_B false
#endif
#ifndef ATT_PIPE_C
#define ATT_PIPE_C false
#endif
#ifndef ONE_LAUNCH
#define ONE_LAUNCH 1
#endif
constexpr int NPH = 2 + 8 * DEPTH;
struct Params { const float* in[30]; float* out; unsigned char* ws; int ph_lo, ph_hi; };

__global__ void __launch_bounds__(NTHREADS, 2) k_run(Params p) {
    extern __shared__ __attribute__((aligned(16))) unsigned char lds_raw[];
    LAS unsigned char* lds = (LAS unsigned char*)lds_raw;
    volatile LAS unsigned* MISC = (volatile LAS unsigned*)(lds + MISC_OFF);
    const int G = gridDim.x;
    const int cid = (G % 8 == 0) ? ((int)blockIdx.x % 8) * (G / 8) + (int)blockIdx.x / 8 : (int)blockIdx.x;
    typedef const __attribute__((address_space(4))) Params* KP;
    KP pp = (KP)__builtin_amdgcn_kernarg_segment_ptr();
    unsigned char* ws = p.ws;
    for (int u = threadIdx.x; u < 256; u += NTHREADS) MISC[u] = 0u;
    __syncthreads();
    const int lo = p.ph_lo, hi = p.ph_hi;
    XcdBarrier bar; bar.bar = (unsigned*)(ws + WS_CTL) + CW_BAR; bar.x = 0; bar.st = nullptr;
    if (hi - lo > 1) bar = xcd_barrier_post((unsigned*)(ws + WS_CTL) + CW_BAR, MISC + 8);
#define IN(k) (lo <= (k) && (k) < hi)
#define SEAM(k) do { if (IN(k) && IN((k) + 1)) { xcd_barrier(bar); if (NREP(15) == 2) xcd_barrier(bar); } } while (0)

    if (PH_EN(0) && IN(0)) {
        thin::ProIn I; I.c = p.in[1]; I.c_ctx = p.in[3]; I.ada_w = p.in[4]; I.ada_b = p.in[5]; I.win_w_in = p.in[10]; I.win_w_out = p.in[11];
        I.mla_w_in = p.in[13]; I.mla_q_norm = p.in[14]; I.mla_kv_norm = p.in[15]; I.mla_w_uq = p.in[16]; I.mla_w_ukv = p.in[17]; I.mla_w_out = p.in[18];
        I.dif_w_in = p.in[19]; I.dif_w_out = p.in[22]; I.moe_w_grp = p.in[23]; I.moe_w_rt = p.in[25]; I.moe_w_gate = p.in[27]; I.moe_w_up = p.in[28]; I.moe_w_down = p.in[29]; I.ws = ws;
        for (int rep = 0; rep < NREP(0); ++rep) { thin::prologue(lds, I, G, cid); __syncthreads(); }
    }
    SEAM(0);
    if (PH_EN(1) && IN(1)) for (int rep = 0; rep < NREP(1); ++rep) thin::phase_h0(p.in[0], p.in[2], (const float*)(ws + WS_MOD), (bf16_t*)(ws + WS_H), G, cid);
    SEAM(1);

#pragma unroll 1
    for (int li = 0; li < DEPTH; ++li) {
        asm volatile("" : "+s"(pp));
        { size_t zoff = 0; asm volatile("" : "+s"(zoff)); ws = pp->ws + zoff; }
        const int base = 2 + 8 * li, kind = li % 3, slot = li / 3; const bool last = li == DEPTH - 1;
        float* mod = (float*)(ws + WS_MOD);
        const float* tab64 = (const float*)(ws + WS_TAB64); const float* tab32 = (const float*)(ws + WS_TAB32);
        float* X = (float*)(ws + WS_X); bf16_t* H = (bf16_t*)(ws + WS_H); bf16_t* O = (bf16_t*)(ws + WS_O);
        unsigned char* R1 = ws + WS_R1;
        int* list = (int*)(ws + WS_LIST); float* tokw = (float*)(ws + WS_TOKW); float* SSQ = (float*)(ws + WS_SSQ);
        const float* modl = mod + (size_t)li * 9 * 6144;
        const int Mpost = last ? TL : T;
        int* cnt = (int*)(ws + WS_CTL) + CW_CNT + li * NE * 64;
#define IDLE_FILL(nunits, myid, budget) do { if (li + 1 < DEPTH) { const int nu_ = (nunits), R_ = (nu_ + G - 1) / G - 1; if (R_ * G + (myid) >= nu_) { \
            thin::moe_fill(lds, pp->in[27], pp->in[28], pp->in[29], ws, li + 1, (budget), (int*)(ws + WS_CTL) + CW_Q + 64 * (li + 1)); __syncthreads(); } } } while (0)
        if (IN(base + 0)) {
            if (PH_EN(2) && kind == 0) {
                pg8::Gemm g{H, (const bf16_t*)(ws + W_A_IN) + (size_t)slot * 1536 * 1024, 1024}; pg8::StaticOrder So; So.init(T, 1536, G, (int)blockIdx.x);
                epi::EpiQKV E{(bf16_t*)(R1 + R_QA), 1024, (bf16_t*)(R1 + R_KA), 256, (bf16_t*)(R1 + R_VTA), 4, 64, 4, 1, 0.125f * LOG2E, tab64};
                for (int rep = 0; rep < NREP(2); ++rep) pg8::gemm_phase<epi::EpiQKV, pg8::StaticOrder, true>(lds, g, So, E);
            } else if (PH_EN(3) && kind == 1) {
                pg8::Gemm g{H, (const bf16_t*)(ws + W_B_IN), 1024}; pg8::StaticOrder So; So.init(T, 1024, G, (int)blockIdx.x);
                epi::EpiB1 E{(bf16_t*)(R1 + R_CQ), (bf16_t*)(R1 + R_CKV), (bf16_t*)(R1 + R_KR), SSQ, tab32};
                for (int rep = 0; rep < NREP(3); ++rep) pg8::gemm_phase<epi::EpiB1, pg8::StaticOrder, true>(lds, g, So, E);
            } else if (PH_EN(4) && kind == 2) {
                pg8::Gemm g{H, (const bf16_t*)(ws + W_C_IN), 1024}; pg8::StaticOrder So; So.init(T, 3072, G, (int)blockIdx.x);
                epi::EpiQKV E{(bf16_t*)(R1 + R_QC), 1024, (bf16_t*)(R1 + R_KC), 1024, (bf16_t*)(R1 + R_VTC), 8, 128, 4, 4, 0.125f * LOG2E, tab64};
                for (int rep = 0; rep < NREP(4); ++rep) pg8::gemm_phase<epi::EpiQKV, pg8::StaticOrder, true>(lds, g, So, E);
            }
        }
        SEAM(base + 0);
        if (PH_EN(5) && IN(base + 1) && kind == 1) {
            { pg8::Gemm g{(const bf16_t*)(R1 + R_CQ), (const bf16_t*)(ws + W_B_UQ), 512}; pg8::StaticOrder So; So.init(T, 1536, G, (int)blockIdx.x);
              epi::EpiB2 E{(bf16_t*)(R1 + R_QB), SSQ, tab32, 0.10206207261596575f * LOG2E};
              for (int rep = 0; rep < NREP(5); ++rep) pg8::gemm_phase<epi::EpiB2, pg8::StaticOrder, true>(lds, g, So, E); }
            { pg8::Gemm g{(const bf16_t*)(R1 + R_CKV), (const bf16_t*)(ws + W_B_UKV), 256}; pg8::StaticOrder So; So.init(T, 2048, G, (int)blockIdx.x);
              epi::EpiB3 E{(bf16_t*)(R1 + R_KN), (bf16_t*)(R1 + R_VTB), SSQ};
              for (int rep = 0; rep < NREP(5); ++rep) pg8::gemm_phase<epi::EpiB3, pg8::StaticOrder, true>(lds, g, So, E); }
        }
        if (kind == 1) SEAM(base + 1);
#ifdef CLK_PROBE
        if (li == 1 && IN(base + 2)) {
            f32x16 c0; bf16x8 fa, fb;
#pragma unroll
            for (int i = 0; i < 16; ++i) c0[i] = 0.f;
#pragma unroll
            for (int i = 0; i < 8; ++i) { fa[i] = (short)(0x3c00 + tid + i); fb[i] = (short)(0x3d00 + i); }
#pragma unroll 1
            for (int it = 0; it < 16384 / 8; ++it) {
#pragma unroll
                for (int u = 0; u < 8; ++u) c0 = MFMA32(fa, fb, c0);
            }
            float sres = 0.f;
#pragma unroll
            for (int i = 0; i < 16; ++i) sres += c0[i];
            ((float*)pp->out)[blockIdx.x * NTHREADS + tid] = sres;
        }
#endif
        if (IN(base + 2)) {
            attn::Tensors At; At.O = O; At.sink = nullptr; At.lamp = nullptr; At.subln = nullptr; At.lambda_init = 0.f; At.K2 = nullptr;
            if (PH_EN(6) && kind == 0) { At.Q = (const bf16_t*)(R1 + R_QA); At.K1 = (const bf16_t*)(R1 + R_KA); At.VT = (const bf16_t*)(R1 + R_VTA); At.sink = pp->in[12] + slot * 16;
                for (int rep = 0; rep < NREP(6); ++rep) attn::phase<0, ATT_PIPE_A>(lds, At, G, cid, !last); }
            else if (PH_EN(7) && kind == 1) { At.Q = (const bf16_t*)(R1 + R_QB); At.K1 = (const bf16_t*)(R1 + R_KN); At.K2 = (const bf16_t*)(R1 + R_KR); At.VT = (const bf16_t*)(R1 + R_VTB);
#ifdef ATT_PROBE
                { attn::Tensors At2 = At; At2.O = (bf16_t*)pp->out; attn::phase<1, ATT_PIPE_B, ATT_PROBE>(lds, At2, G, cid, !last); }
#endif
                for (int rep = 0; rep < NREP(7); ++rep) attn::phase<1, ATT_PIPE_B>(lds, At, G, cid, !last); }
            else if (PH_EN(8) && kind == 2) { At.Q = (const bf16_t*)(R1 + R_QC); At.K1 = (const bf16_t*)(R1 + R_KC); At.VT = (const bf16_t*)(R1 + R_VTC); At.lamp = pp->in[20] + slot * 256; At.subln = pp->in[21] + slot * 128;
                At.lambda_init = 0.8f - 0.6f * expf(-0.3f * (float)li);
                for (int rep = 0; rep < NREP(8); ++rep) attn::phase<2, ATT_PIPE_C>(lds, At, G, cid, !last); }
        }
        SEAM(base + 2);
        if (PH_EN(9) && IN(base + 3)) {
            const bf16_t* Wt = kind == 0 ? (const bf16_t*)(ws + W_A_OUT) + (size_t)slot * 1024 * 1024 : (kind == 1 ? (const bf16_t*)(ws + W_B_OUT) : (const bf16_t*)(ws + W_C_OUT));
            pg8::Gemm g{O, Wt, 1024}; pg8::StaticOrder So; So.init(Mpost, 1024, G, (int)blockIdx.x);
            epi::EpiOut E{(bf16_t*)(R1 + R_Y)};
            if (NREP(9) == 2) pg8::gemm_phase<epi::EpiOut, pg8::StaticOrder, true>(lds, g, So, E);
            pg8::gemm_phase<epi::EpiOut, pg8::StaticOrder, true>(lds, g, So, E);
        }
        SEAM(base + 3);
        if (PH_EN(10) && IN(base + 4)) {
            const float* Xl = li == 0 ? pp->in[0] : X; const float* Xc = li == 0 ? pp->in[2] : (const float*)((const bf16_t*)X + (size_t)TL * 1024);
            thin::LnrArgs A{Xl, Xc, (const bf16_t*)(R1 + R_Y), (float*)(ws + WS_STATS), H, modl, pp->in[6] + li * 1024, pp->in[7] + li * 1024, (const bf16_t*)(ws + WS_RTW) + (size_t)li * 2 * 65536, pp->in[24] + li * 4, pp->in[26] + li * 32, cnt, list, tokw, Mpost};
            if (NREP(10) == 2) { thin::LnrArgs A2 = A; A2.STATS = (float*)R1; A2.H = (bf16_t*)(R1 + (size_t)T * 4096); A2.cnt = (int*)(ws + WS_CTL) + CW_CNT + 4 * NE * 64; A2.list = (int*)(R1 + (size_t)T * 6144); A2.tokw = (float*)(R1 + (size_t)T * 6144 + (size_t)NE * T * 4);
#ifdef LNR_PROBE
            thin::phase_lnr<LNR_PROBE>(lds, A2, G, cid);
#else
            thin::phase_lnr(lds, A2, G, cid);
#endif
            }
            if (li == 0) thin::phase_lnr<0, false>(lds, A, G, cid); else thin::phase_lnr<0, true>(lds, A, G, cid);
        }
        SEAM(base + 4);
        if (IN(base + 5) || IN(base + 6)) {
            if (threadIdx.x == 0) { int a = 0; for (int e = 0; e < NE; ++e) { MISC[16 + e] = (unsigned)a; a += (cnt[e * 64] + 255) >> 8; } MISC[16 + NE] = (unsigned)a; }
            __syncthreads();
        }
        if (PH_EN(11) && IN(base + 5)) {
            pg8::Gemm g{H, (const bf16_t*)(ws + WS_WGU) + (size_t)li * NE * 1024 * 1024, 1024};
            MoeOrder<true> So{(const LAS int*)(lds + MISC_OFF + 64), cnt, list, G, cid};
            epi::EpiGU E{(bf16_t*)(R1 + R_ACT)};
            for (int rep = 0; rep < NREP(11); ++rep) pg8::gemm_phase<epi::EpiGU, MoeOrder<true>, true>(lds, g, So, E);
        }
        SEAM(base + 5);
        if (PH_EN(12) && IN(base + 6)) {
            pg8::Gemm g{(const bf16_t*)(R1 + R_ACT), (const bf16_t*)(ws + WS_WD) + (size_t)li * NE * 1024 * 512, 512};
            MoeOrder<false> So{(const LAS int*)(lds + MISC_OFF + 64), cnt, list, G, cid};
            epi::EpiDown E{(bf16_t*)(R1 + R_Y2), list, cnt, tokw};
            for (int rep = 0; rep < NREP(12); ++rep) pg8::gemm_phase<epi::EpiDown, MoeOrder<false>, true>(lds, g, So, E);
        }
        SEAM(base + 6);
        if (PH_EN(13) && IN(base + 7)) {
            const float* Xl = li == 0 ? pp->in[0] : X; const float* Xc = li == 0 ? pp->in[2] : (const float*)((const bf16_t*)X + (size_t)TL * 1024);
            thin::LnfArgs A{Xl, Xc, (const bf16_t*)(R1 + R_Y), (const float*)(ws + WS_STATS), (const bf16_t*)(R1 + R_Y2), modl, pp->in[6] + li * 1024, pp->in[7] + li * 1024, pp->in[8] + li * 1024, pp->in[9] + li * 1024, last ? pp->out : X, last ? nullptr : H, last ? nullptr : mod + (size_t)(li + 1) * 9 * 6144, Mpost};
            if (NREP(13) == 2 && !last) { thin::LnfArgs A2 = A; A2.Xout = pp->out; A2.H = O; A2.nrows = TL; thin::phase_lnf(A2, G, cid); }
            if (li == 0) thin::phase_lnf<false, true>(A, G, cid); else if (!last) thin::phase_lnf<true, true>(A, G, cid); else thin::phase_lnf<true, false>(A, G, cid);
        }
        if (!last) SEAM(base + 7);
    }
#undef IN
#undef SEAM
}

extern "C" void kernel_launch(void* const* d_in, const int* in_sizes, int n_in, void* d_out, int out_size, void* d_ws, size_t ws_size, hipStream_t stream) {
    static int grid = 0;
    if (grid == 0) {
        if (n_in != 30 || ws_size < WS_END) { grid = -1; return; }
        int dev = 0, cus = 0;
        if (hipGetDevice(&dev) != hipSuccess || hipDeviceGetAttribute(&cus, hipDeviceAttributeMultiprocessorCount, dev) != hipSuccess) { grid = -1; return; }
        if (hipFuncSetAttribute((const void*)k_run, hipFuncAttributeMaxDynamicSharedMemorySize, LDS_BYTES) != hipSuccess) { grid = -1; return; }
        int per_cu = 0;
        if (hipOccupancyMaxActiveBlocksPerMultiprocessor(&per_cu, (const void*)k_run, NTHREADS, LDS_BYTES) != hipSuccess || per_cu < 1) { (void)hipGetLastError(); grid = -1; return; }
        grid = cus;
    }
    if (grid < 0) return;
    (void)hipMemsetAsync((char*)d_ws + WS_CTL, 0, CTL_ZERO_BYTES, stream);
    Params p{};
    for (int i = 0; i < 30; ++i) p.in[i] = (const float*)d_in[i];
    p.out = (float*)d_out; p.ws = (unsigned char*)d_ws;
#if ONE_LAUNCH
    p.ph_lo = 0; p.ph_hi = NPH;
    k_run<<<dim3(grid), dim3(NTHREADS), LDS_BYTES, stream>>>(p);
#else
    for (int ph = 0; ph < NPH; ++ph) {
        if (ph >= 2 && ((ph - 2) % 8) == 1 && (((ph - 2) / 8) % 3) != 1) continue;
        p.ph_lo = ph; p.ph_hi = ph + 1;
        k_run<<<dim3(grid), dim3(NTHREADS), LDS_BYTES, stream>>>(p);
    }
#endif
}
```

```cpp
#include <hip/hip_runtime.h>
#include <stdint.h>
#include <math.h>

constexpr int D = 1024, NB = 8, S = 4096, L = 256, DEPTH = 4;
constexpr int TL = NB * S, TC = NB * L, T = TL + TC;
constexpr int NKEY = S + L;
constexpr int NE = 32, DE = 512;
constexpr float LN_EPS = 1e-5f, RMS_EPS = 1e-6f;
constexpr float DN_ALPHA = 1.6817928305074290861f;
constexpr float LOG2E = 1.4426950408889634f;
constexpr int NWAVES = 8, NTHREADS = 512;

#define LAS __attribute__((address_space(3)))
typedef unsigned short bf16_t;
typedef short bf16x8 __attribute__((ext_vector_type(8)));
typedef float f32x4 __attribute__((ext_vector_type(4)));
typedef float f32x2 __attribute__((ext_vector_type(2)));
typedef float f32x16 __attribute__((ext_vector_type(16)));
typedef unsigned u32x4 __attribute__((ext_vector_type(4)));
typedef unsigned u32x2 __attribute__((ext_vector_type(2)));

__device__ __forceinline__ unsigned cvt_pk_bf16(float lo, float hi) { unsigned r; asm volatile("v_cvt_pk_bf16_f32 %0, %1, %2" : "=v"(r) : "v"(lo), "v"(hi)); return r; }
__device__ __forceinline__ unsigned f2bf(float f) { unsigned u = __builtin_bit_cast(unsigned, f); return (u + 0x7fffu + ((u >> 16) & 1u)) >> 16; }
__device__ __forceinline__ float bf2f(unsigned h) { return __builtin_bit_cast(float, h << 16); }
__device__ __forceinline__ int mrow_of(int r) { return r < TL ? (r >> 12) : NB; }
__device__ __forceinline__ float dpp_add(float v, unsigned x, const int ctrl_unused) { return v; }
#define DPP_ADD_STEP(v, CTRL) v += __uint_as_float(__builtin_amdgcn_update_dpp(0u, __float_as_uint(v), CTRL, 0xF, 0xF, true))
__device__ __forceinline__ float xor16_sum(float v) { const unsigned x = __float_as_uint(v); auto r = __builtin_amdgcn_permlane16_swap(x, x, false, false); return __uint_as_float(r[0]) + __uint_as_float(r[1]); }
__device__ __forceinline__ float xor32_sum(float v) { const unsigned x = __float_as_uint(v); auto r = __builtin_amdgcn_permlane32_swap(x, x, false, false); return __uint_as_float(r[0]) + __uint_as_float(r[1]); }
typedef _Float16 f16x2 __attribute__((ext_vector_type(2)));
__device__ __forceinline__ unsigned pack_f16(float a, float b) { a = __builtin_fminf(__builtin_fmaxf(a, -65504.f), 65504.f); b = __builtin_fminf(__builtin_fmaxf(b, -65504.f), 65504.f);
    f16x2 h; h.x = (_Float16)a; h.y = (_Float16)b; return __builtin_bit_cast(unsigned, h); }
__device__ __forceinline__ float f16lo(unsigned u) { return (float)__builtin_bit_cast(f16x2, u).x; }
__device__ __forceinline__ float f16hi(unsigned u) { return (float)__builtin_bit_cast(f16x2, u).y; }
__device__ __forceinline__ float xor32_max(float v) { const unsigned x = __float_as_uint(v); auto r = __builtin_amdgcn_permlane32_swap(x, x, false, false); return fmaxf(__uint_as_float(r[0]), __uint_as_float(r[1])); }
__device__ __forceinline__ float wave_sum(float v) {
    DPP_ADD_STEP(v, 0xB1); DPP_ADD_STEP(v, 0x4E); DPP_ADD_STEP(v, 0x141); DPP_ADD_STEP(v, 0x140);
    return xor32_sum(xor16_sum(v));
}
__device__ __forceinline__ void wave_sum2(float& a, float& b) {
    DPP_ADD_STEP(a, 0xB1); DPP_ADD_STEP(b, 0xB1); DPP_ADD_STEP(a, 0x4E); DPP_ADD_STEP(b, 0x4E); DPP_ADD_STEP(a, 0x141); DPP_ADD_STEP(b, 0x141); DPP_ADD_STEP(a, 0x140); DPP_ADD_STEP(b, 0x140);
    a = xor16_sum(a); b = xor16_sum(b); a = xor32_sum(a); b = xor32_sum(b);
}

constexpr size_t MiB = 1u << 20;
constexpr size_t WS_CTL = 0, CTL_ZERO_BYTES = 128 * 1024;
constexpr int CW_Q = 512;
constexpr int CW_BAR = 1024;
constexpr int CW_CNT = 8192;
constexpr size_t WS_MOD = 1 * MiB;
constexpr size_t WS_TAB64 = 2 * MiB, WS_TAB32 = WS_TAB64 + 8192;
constexpr size_t WS_RTW = 3 * MiB;
constexpr size_t WS_TOKW = 4 * MiB;
constexpr size_t WS_SSQ = 5 * MiB;
constexpr size_t WS_STATS = 7 * MiB;
constexpr size_t WS_LIST = 8 * MiB;
constexpr size_t WS_WSMALL = 16 * MiB;
constexpr size_t W_A_IN = WS_WSMALL;
constexpr size_t W_A_OUT = W_A_IN + 2ull * 1536 * 1024 * 2;
constexpr size_t W_B_IN = W_A_OUT + 2ull * 1024 * 1024 * 2;
constexpr size_t W_B_UQ = W_B_IN + 1024ull * 1024 * 2;
constexpr size_t W_B_UKV = W_B_UQ + 1536ull * 512 * 2;
constexpr size_t W_B_OUT = W_B_UKV + 2048ull * 256 * 2;
constexpr size_t W_C_IN = W_B_OUT + 1024ull * 1024 * 2;
constexpr size_t W_C_OUT = W_C_IN + 3072ull * 1024 * 2;
constexpr size_t WS_WGU = 48 * MiB;
constexpr size_t WS_WD = WS_WGU + 4ull * 32 * 1024 * 1024 * 2;
constexpr size_t WS_X = WS_WD + 4ull * 32 * 1024 * 512 * 2;
constexpr size_t WS_H = WS_X + (size_t)T * 1024 * 4;
constexpr size_t WS_O = WS_H + (size_t)T * 1024 * 2;
constexpr size_t WS_R1 = WS_O + (size_t)T * 1024 * 2;
static_assert(W_C_OUT + 1024ull * 1024 * 2 <= WS_WGU, "small weights fit");
constexpr size_t R_QA = 0, R_KA = R_QA + (size_t)T * 1024 * 2, R_VTA = R_KA + (size_t)T * 256 * 2;
constexpr size_t R_CQ = 0, R_CKV = R_CQ + (size_t)T * 512 * 2, R_KR = R_CKV + (size_t)T * 256 * 2, R_QB = R_KR + (size_t)T * 32 * 2,
                 R_KN = R_QB + (size_t)T * 1536 * 2, R_VTB = R_KN + (size_t)T * 1024 * 2, R_ENDB = R_VTB + (size_t)NB * 16 * 64 * NKEY * 2;
constexpr size_t R_QC = 0, R_KC = R_QC + (size_t)T * 1024 * 2, R_VTC = R_KC + (size_t)T * 1024 * 2;
constexpr int NPOS = 2 * T + NE * 256;
constexpr size_t R_ACT = 0, R_Y2 = R_ACT + (size_t)NPOS * 512 * 2, R_ENDM = R_Y2 + (size_t)T * 2 * 1024 * 2;
constexpr size_t R_Y = R_ENDM, R_ENDY = R_Y + (size_t)T * 1024 * 2;
static_assert(R_ENDY <= R_ENDB, "MoE region + y inside R1");
constexpr size_t WS_END = WS_R1 + R_ENDB;

constexpr int LDS_BYTES = 147456;
constexpr int MISC_OFF = 146432;

#define XB_TMO      128
#define XB_XCNT(j)  (256  + 64 * (j))
#define XB_XSUB(j)  (1280 + 64 * (j))
#define XB_XGEN(j)  (2304 + 64 * (j))
#define XB_TOP      3328
#define XB_TOPGEN   3392
#define XCD_BAR_WORDS 3456
#define XB_SPIN_CAP (1u << 18)
__device__ __forceinline__ unsigned xb_ld(unsigned* p)              { return __hip_atomic_load(p, __ATOMIC_RELAXED, __HIP_MEMORY_SCOPE_AGENT); }
__device__ __forceinline__ unsigned xb_add(unsigned* p, unsigned v) { return __hip_atomic_fetch_add(p, v, __ATOMIC_RELAXED, __HIP_MEMORY_SCOPE_AGENT); }
__device__ __forceinline__ unsigned xb_xcc_id() { return (unsigned)__builtin_amdgcn_s_getreg((3 << 11) | 20) & 0xFu; }
#define XB_SPIN(cond, bar) do { unsigned _sp = 0; while (cond) { __builtin_amdgcn_s_sleep(1); \
    if ((++_sp & 255u) == 0u) { if (xb_ld(&(bar)[XB_TMO])) break; if (_sp > XB_SPIN_CAP) { atomicAdd(&(bar)[XB_TMO], 1u); break; } } } } while (0)
struct XcdBarrier { unsigned* bar; unsigned x; volatile LAS unsigned* st; };
__device__ __forceinline__ XcdBarrier xcd_barrier_post(unsigned* bar, volatile LAS unsigned* st) {
    XcdBarrier b; b.bar = bar; b.x = xb_xcc_id(); b.st = st;
    if (threadIdx.x == 0) (void)xb_add(&bar[XB_XCNT(b.x)], 1u);
    return b;
}
__device__ __forceinline__ void xcd_barrier_complete(unsigned* bar, unsigned x, unsigned& nloc, unsigned& nx) {
    const unsigned G = gridDim.x * gridDim.y * gridDim.z;
    unsigned sum, cnt, mine, sp = 0u;
    for (;;) {
        sum = 0u; cnt = 0u; mine = 0u;
#pragma unroll
        for (unsigned j = 0; j < 16; ++j) { const unsigned c = xb_ld(&bar[XB_XCNT(j)]); sum += c; cnt += (c > 0u) ? 1u : 0u; mine = (j == x) ? c : mine; }
        if (sum == G) break;
        __builtin_amdgcn_s_sleep(1);
        if ((++sp & 255u) == 0u) { if (xb_ld(&bar[XB_TMO])) break; if (sp > XB_SPIN_CAP) { atomicAdd(&bar[XB_TMO], 1u); break; } }
    }
    nloc = mine > 0u ? mine : 1u; nx = cnt > 0u ? cnt : 1u;
}
__device__ __forceinline__ void xcd_barrier(const XcdBarrier& b) {
    asm volatile("s_waitcnt vmcnt(0)" ::: "memory");
    __syncthreads();
    if (threadIdx.x == 0) {
        unsigned* bar = b.bar;
        __builtin_amdgcn_s_waitcnt(0);
        unsigned nloc = b.st[0], nx = b.st[1];
        if (nloc == 0u) { xcd_barrier_complete(bar, b.x, nloc, nx); b.st[0] = nloc; b.st[1] = nx; }
        const unsigned old = xb_add(&bar[XB_XSUB(b.x)], 1u);
        const unsigned gen = old / nloc;
        if (old + 1u == (gen + 1u) * nloc) {
            __builtin_amdgcn_fence(__ATOMIC_RELEASE, "agent");
            asm volatile("s_waitcnt vmcnt(0)" ::: "memory");
            const unsigned og = xb_add(&bar[XB_TOP], 1u);
            const unsigned tg = og / nx;
            if (og + 1u == (tg + 1u) * nx) xb_add(&bar[XB_TOPGEN], 1u);
            else XB_SPIN(xb_ld(&bar[XB_TOPGEN]) == tg, bar);
            __builtin_amdgcn_fence(__ATOMIC_ACQUIRE, "agent");
            xb_add(&bar[XB_XGEN(b.x)], 1u);
            asm volatile("s_waitcnt vmcnt(0)" ::: "memory");
        } else {
            XB_SPIN(xb_ld(&bar[XB_XGEN(b.x)]) == gen, bar);
            __builtin_amdgcn_fence(__ATOMIC_ACQUIRE, "agent");
            asm volatile("s_waitcnt vmcnt(0)" ::: "memory");
        }
    }
    __syncthreads();
}

namespace pg8 {
constexpr int BM = 256, BK = 64, HALF = 128, HTB = HALF * BK * 2, STAGE_BYTES = 8 * HTB, NXCD = 8, WGM = 2;
__host__ __device__ __forceinline__ int lds_byte(int r, int c) { const int st = (r >> 4) * 2 + (c >> 5), rr = r & 15, cc = c & 31, ob = rr * 64 + cc * 2; return st * 1024 + (ob ^ (((ob >> 9) & 1) << 5)); }
__host__ __device__ __forceinline__ void stage_rc(int b, int& R, int& C) { const int st = b / 1024, sb = b % 1024, swz = sb ^ (((sb >> 9) & 1) << 5); R = (st >> 1) * 16 + swz / 64; C = (st & 1) * 32 + (swz % 64) / 2; }
__host__ __device__ __forceinline__ int perm32(int rho) { const int n = rho >> 4, i = rho & 15; return 8 * (i >> 2) + 4 * n + (i & 3); }

struct Unit { int pm, pn, e, t, r0, nai; };
struct Gemm { const bf16_t* A; const bf16_t* Bt; int K; };

struct StaticOrder {
    static constexpr bool GATHER = false;
    int nM, nN, nwg, G, c;
    __device__ void init(int M, int N, int G_, int c_) { asm volatile("" : "+s"(G_), "+s"(c_));
        nM = M / BM; nN = N / BM; nwg = nM * nN; G = G_; c = c_; }
    __device__ bool next(int i, Unit& u) const {
        const int nfull = (nwg / G) * G, rem = nwg - nfull; const bool halves = rem > 0 && 2 * rem <= G;
        long Lx = (long)i * G + c; u.r0 = 0; u.nai = 2;
        if (Lx >= nfull && halves) { if (i * G != nfull || c >= 2 * rem) return false; Lx = nfull + (c >> 1); u.r0 = (c & 1) * HALF; u.nai = 1; }
        if (Lx >= nwg) return false;
        int wgid = (int)Lx; { const int q = nwg / NXCD, r = nwg % NXCD, xcd = wgid % NXCD, off = wgid / NXCD; wgid = (xcd < r ? xcd * (q + 1) : r * (q + 1) + (xcd - r) * q) + off; }
        const int nig = WGM * nN, gid = wgid / nig, fm = gid * WGM, gsz = (nM - fm) < WGM ? (nM - fm) : WGM;
        u.pm = fm + ((wgid % nig) % gsz); u.pn = (wgid % nig) / gsz; u.e = 0; u.t = 0; return true;
    }
    __device__ __forceinline__ int arow(const Unit& u, int r) const { return u.pm * BM + u.r0 + r; }
};

template <class Epi, class Sched, bool ALIGN_EPI>
__device__ __forceinline__ void gemm_phase(LAS unsigned char* lds, const Gemm g, const Sched& S, const Epi& E) {
    int tid_ = threadIdx.x; asm volatile("" : "+v"(tid_));
    const int tid = tid_, wid = __builtin_amdgcn_readfirstlane(tid >> 6), lane = tid & 63, wr = wid >> 2, wc = wid & 3, fr = lane & 15, fq = lane >> 4;
    const int K = g.K, nt = K / BK;
    unsigned voffB[2];
#pragma unroll
    for (int i = 0; i < 2; ++i) { int R, C; stage_rc(tid * 16 + i * 8192, R, C); const int Rb = Epi::PERM ? ((R & ~31) + perm32(R & 31)) : R;
        voffB[i] = (unsigned)(Rb * K + C) * 2u; }
    const size_t kstep = (size_t)(BK * 2);
    const size_t hstep = (size_t)HALF * K * 2;
    const size_t tstep = 2 * hstep;
    const unsigned ldsw = (unsigned)wid * 1024u;
    const int aoff = lds_byte(wr * 64 + fr, fq * 8), boff = lds_byte(wc * 32 + fr, fq * 8);
#define PG8_SA(b, h) (((b) * 2 + (h)) * HTB)
#define PG8_SB(b, h) ((4 + (b) * 2 + (h)) * HTB)
#define PG8_STAGE(bufoff, gbase, voff) do { _Pragma("unroll") for (int _i = 0; _i < 2; ++_i) \
        __builtin_amdgcn_global_load_lds((const unsigned*)((const char*)(gbase) + (voff)[_i]), (LAS unsigned*)(lds + (bufoff) + ldsw + _i * 8192), 16, 0, 0); } while (0)
#define PG8_LDA(dst, b, h) do { _Pragma("unroll") for (int m = 0; m < 4; ++m) _Pragma("unroll") for (int k = 0; k < 2; ++k) dst[m][k] = *(const LAS bf16x8*)(lds + PG8_SA(b, h) + aoff + m * 2048 + k * 1024); } while (0)
#define PG8_LDB(dst, b, h) do { _Pragma("unroll") for (int n = 0; n < 2; ++n) _Pragma("unroll") for (int k = 0; k < 2; ++k) dst[n][k] = *(const LAS bf16x8*)(lds + PG8_SB(b, h) + boff + n * 2048 + k * 1024); } while (0)
#define PG8_MMA(ai, bj, At, Bt) do { __builtin_amdgcn_s_setprio(1); _Pragma("unroll") for (int m = 0; m < 4; ++m) _Pragma("unroll") for (int n = 0; n < 2; ++n) _Pragma("unroll") for (int k = 0; k < 2; ++k) \
        acc[ai][bj][m][n] = __builtin_amdgcn_mfma_f32_16x16x32_bf16(Bt[n][k], At[m][k], acc[ai][bj][m][n], 0, 0, 0); __builtin_amdgcn_s_setprio(0); } while (0)
#define PG8_WAIT_V(n) asm volatile("s_waitcnt vmcnt(" #n ")" ::: "memory")
#define PG8_WAIT_L(n) asm volatile("s_waitcnt lgkmcnt(" #n ")" ::: "memory")
#define PG8_BAR __builtin_amdgcn_s_barrier()
#define PG8_SCHED __builtin_amdgcn_sched_barrier(0)
#define PG8_AOFF(dst, u) do { _Pragma("unroll") for (int _i = 0; _i < 2; ++_i) { int R_, C_; stage_rc(tid * 16 + _i * 8192, R_, C_); \
        _Pragma("unroll") for (int _h = 0; _h < 2; ++_h) dst[_h][_i] = (unsigned)(S.arow(u, _h * HALF + R_) * K + C_) * 2u; } } while (0)
    Unit cur, nxt; int ui = 0;
    if (!S.next(0, cur)) return;
    f32x4 acc[2][2][4][2];
#pragma unroll
    for (int a = 0; a < 2; ++a)
#pragma unroll
        for (int b = 0; b < 2; ++b)
#pragma unroll
            for (int m = 0; m < 4; ++m)
#pragma unroll
                for (int n = 0; n < 2; ++n) acc[a][b][m][n] = (f32x4){0.f, 0.f, 0.f, 0.f};
    bf16x8 At[4][2], B0[2][2], B1[2][2];
    unsigned voffA[2]; unsigned vA[2][2], nA_[2][2];
    const char* cA = (const char*)g.A; const char* nAp = cA;
    if constexpr (Sched::GATHER) { PG8_AOFF(vA, cur); }
    else {
#pragma unroll
        for (int i = 0; i < 2; ++i) { int R, C; stage_rc(tid * 16 + i * 8192, R, C); voffA[i] = (unsigned)(R * K + C) * 2u; }
        cA = (const char*)g.A + (size_t)cur.pm * tstep + (size_t)cur.r0 * K * 2;
    }
#define PG8_STA(bufoff, kptr, h, offs) do { if constexpr (Sched::GATHER) { PG8_STAGE(bufoff, kptr, offs[h]); } else { PG8_STAGE(bufoff, (kptr) + (h) * hstep, voffA); } } while (0)
    const char* cB = (const char*)g.Bt + (size_t)cur.pn * tstep;
    PG8_STAGE(PG8_SB(0, 0), cB, voffB); PG8_STAGE(PG8_SB(0, 1), cB + hstep, voffB); PG8_STA(PG8_SA(0, 0), cA, 0, vA); PG8_STA(PG8_SA(0, 1), cA, 1, vA);
    if (wr == 1) PG8_BAR;
    PG8_WAIT_V(2); PG8_BAR;
    PG8_STAGE(PG8_SB(1, 0), cB + kstep, voffB); PG8_STA(PG8_SA(1, 0), cA + kstep, 0, vA); PG8_STAGE(PG8_SB(1, 1), cB + hstep + kstep, voffB);
    PG8_WAIT_V(6); PG8_BAR;
    for (;;) {
        const bool has_next = S.next(ui + 1, nxt);
        if constexpr (Sched::GATHER) {
            if (has_next) { PG8_AOFF(nA_, nxt); } else {
#pragma unroll
                for (int _h = 0; _h < 2; ++_h)
#pragma unroll
                    for (int _i = 0; _i < 2; ++_i) nA_[_h][_i] = vA[_h][_i]; }
        } else { nAp = has_next ? (const char*)g.A + (size_t)nxt.pm * tstep + (size_t)nxt.r0 * K * 2 : cA; }
        const char* nB = has_next ? (const char*)g.Bt + (size_t)nxt.pn * tstep : cB;
        const bool full = cur.nai == 2;
#pragma unroll 1
        for (int t = 0; t < nt; t += 2) {
            const bool last = (t == nt - 2);
            const char* a1 = cA + (size_t)(t + 1) * kstep;
            const char* a2 = last ? nAp : cA + (size_t)(t + 2) * kstep; const char* b2 = last ? nB : cB + (size_t)(t + 2) * kstep;
            const char* a3 = a2 + kstep; const char* b3 = b2 + kstep;
            unsigned wq[2][2];
            if constexpr (Sched::GATHER) {
#pragma unroll
                for (int _h = 0; _h < 2; ++_h)
#pragma unroll
                    for (int _i = 0; _i < 2; ++_i) wq[_h][_i] = last ? nA_[_h][_i] : vA[_h][_i];
            }
            PG8_LDB(B0, 0, 0); PG8_LDB(B1, 0, 1); PG8_SCHED; PG8_LDA(At, 0, 0); PG8_STA(PG8_SA(1, 1), a1, 1, vA);
            PG8_WAIT_V(8); PG8_WAIT_L(0); PG8_BAR; PG8_MMA(0, 0, At, B0); PG8_MMA(0, 1, At, B1); PG8_BAR; PG8_SCHED;
            PG8_LDA(At, 0, 1); PG8_STAGE(PG8_SB(0, 0), b2, voffB); PG8_STAGE(PG8_SB(0, 1), b2 + hstep, voffB); PG8_STA(PG8_SA(0, 0), a2, 0, wq);
            PG8_WAIT_V(8); PG8_WAIT_L(0); PG8_BAR; if (full) { PG8_MMA(1, 0, At, B0); PG8_MMA(1, 1, At, B1); } PG8_BAR; PG8_SCHED;
            PG8_LDB(B0, 1, 0); PG8_LDB(B1, 1, 1); PG8_SCHED; PG8_LDA(At, 1, 0); PG8_STA(PG8_SA(0, 1), a2, 1, wq);
            PG8_WAIT_V(8); PG8_WAIT_L(0); PG8_BAR; PG8_MMA(0, 0, At, B0); PG8_MMA(0, 1, At, B1); PG8_BAR; PG8_SCHED;
            PG8_LDA(At, 1, 1); PG8_STAGE(PG8_SB(1, 0), b3, voffB); PG8_STAGE(PG8_SB(1, 1), b3 + hstep, voffB); PG8_STA(PG8_SA(1, 0), a3, 0, wq);
            PG8_WAIT_V(8); PG8_WAIT_L(0); PG8_BAR; if (full) { PG8_MMA(1, 0, At, B0); PG8_MMA(1, 1, At, B1); } PG8_BAR; PG8_SCHED;
        }
        if constexpr (ALIGN_EPI) { if (wr == 0) PG8_BAR; }
        E(acc, cur, wr, wc, fr, fq);
        if (!has_next) break;
#pragma unroll
        for (int a = 0; a < 2; ++a)
#pragma unroll
            for (int b = 0; b < 2; ++b)
#pragma unroll
                for (int m = 0; m < 4; ++m)
#pragma unroll
                    for (int n = 0; n < 2; ++n) acc[a][b][m][n] = (f32x4){0.f, 0.f, 0.f, 0.f};
        cur = nxt; cB = nB; ++ui;
        if constexpr (Sched::GATHER) {
#pragma unroll
            for (int _h = 0; _h < 2; ++_h)
#pragma unroll
                for (int _i = 0; _i < 2; ++_i) vA[_h][_i] = nA_[_h][_i];
        } else { cA = nAp; }
        if constexpr (ALIGN_EPI) { if (wr == 1) PG8_BAR; }
    }
    PG8_WAIT_V(0);
    if constexpr (!ALIGN_EPI) { if (wr == 0) PG8_BAR; }
    PG8_BAR;
#undef PG8_STA
#undef PG8_SA
#undef PG8_SB
#undef PG8_STAGE
#undef PG8_LDA
#undef PG8_LDB
#undef PG8_MMA
#undef PG8_WAIT_V
#undef PG8_WAIT_L
#undef PG8_BAR
#undef PG8_SCHED
#undef PG8_AOFF
}
}
namespace epi {
using pg8::Unit;
typedef float2 cs2;
__device__ __forceinline__ void rope8(f32x4& v0, f32x4& v1, const f32x4 c01, const f32x4 c23) {
    float a, b;
    a = v0[0]; b = v0[1]; v0[0] = a * c01[0] - b * c01[1]; v0[1] = b * c01[0] + a * c01[1];
    a = v0[2]; b = v0[3]; v0[2] = a * c01[2] - b * c01[3]; v0[3] = b * c01[2] + a * c01[3];
    a = v1[0]; b = v1[1]; v1[0] = a * c23[0] - b * c23[1]; v1[1] = b * c23[0] + a * c23[1];
    a = v1[2]; b = v1[3]; v1[2] = a * c23[2] - b * c23[3]; v1[3] = b * c23[2] + a * c23[3];
}
__device__ __forceinline__ u32x4 pack8(const f32x4 v0, const f32x4 v1) { u32x4 w; w.x = cvt_pk_bf16(v0[0], v0[1]); w.y = cvt_pk_bf16(v0[2], v0[3]); w.z = cvt_pk_bf16(v1[0], v1[1]); w.w = cvt_pk_bf16(v1[2], v1[3]); return w; }
__device__ __forceinline__ void store_vt(bf16_t* VT, int HV, int DV, int row, int vcol, const f32x4 v0, const f32x4 v1) {
    const int b = row < TL ? (row >> 12) : ((row - TL) >> 8), key = row < TL ? (row & 4095) : (S + ((row - TL) & 255));
    const int hv = vcol / DV, dv = vcol % DV;
    bf16_t* p = VT + ((size_t)(b * HV + hv) * DV + dv) * NKEY + key;
#pragma unroll
    for (int i = 0; i < 4; ++i) { p[(size_t)i * NKEY] = (bf16_t)f2bf(v0[i]); p[(size_t)(4 + i) * NKEY] = (bf16_t)f2bf(v1[i]); }
}

struct EpiQKV {
    static constexpr bool PERM = true;
    bf16_t* Q; int ldq; bf16_t* Kb; int ldk; bf16_t* VT; int HV, DV; int nQ, nK; float qscale; const float* tab64;
    __device__ __forceinline__ void operator()(const f32x4 (&acc)[2][2][4][2], const Unit& u, int wr, int wc, int fr, int fq) const {
        const int kindt = u.pn < nQ ? 0 : (u.pn < nQ + nK ? 1 : 2);
        const int tcol = (kindt == 0 ? u.pn : (kindt == 1 ? u.pn - nQ : u.pn - nQ - nK)) * 256 + wc * 32 + fq * 8;
#pragma unroll
        for (int ai = 0; ai < 2; ++ai) if (ai < u.nai)
#pragma unroll
            for (int m = 0; m < 4; ++m) {
                asm volatile("" ::: "memory");
                const int row = u.pm * 256 + u.r0 + ai * 128 + wr * 64 + m * 16 + fr;
                if (kindt == 2) {
#pragma unroll
                    for (int bj = 0; bj < 2; ++bj) store_vt(VT, HV, DV, row, tcol + bj * 128, acc[ai][bj][m][0], acc[ai][bj][m][1]);
                } else {
                    f32x4 c01 = (f32x4){1.f, 0.f, 1.f, 0.f}, c23 = c01;
                    if (row < TL) { const int s = row & 4095, pos = (wc & 1) ? (s & 63) : (s >> 6);
                        const f32x4* tp = (const f32x4*)(tab64 + ((size_t)pos * 16 + fq * 4) * 2); c01 = tp[0]; c23 = tp[1]; }
                    const float sc = kindt == 0 ? qscale : 1.f;
                    bf16_t* dst = (kindt == 0 ? Q + (size_t)row * ldq : Kb + (size_t)row * ldk) + tcol;
#pragma unroll
                    for (int bj = 0; bj < 2; ++bj) { f32x4 v0 = acc[ai][bj][m][0], v1 = acc[ai][bj][m][1]; rope8(v0, v1, c01, c23); v0 = v0 * sc; v1 = v1 * sc;
                        *(u32x4*)(dst + bj * 128) = pack8(v0, v1); }
                }
            }
    }
};
struct EpiB1 {
    static constexpr bool PERM = true;
    bf16_t* CQ; bf16_t* CKV; bf16_t* KR; float* SSQ; const float* tab32;
    __device__ __forceinline__ void operator()(const f32x4 (&acc)[2][2][4][2], const Unit& u, int wr, int wc, int fr, int fq) const {
#pragma unroll
        for (int ai = 0; ai < 2; ++ai) if (ai < u.nai)
#pragma unroll
            for (int m = 0; m < 4; ++m) {
                asm volatile("" ::: "memory");
                const int row = u.pm * 256 + u.r0 + ai * 128 + wr * 64 + m * 16 + fr;
                if (u.pn < 3) {
                    float ss = 0.f;
#pragma unroll
                    for (int bj = 0; bj < 2; ++bj)
#pragma unroll
                        for (int n = 0; n < 2; ++n) { const f32x4 v = acc[ai][bj][m][n]; ss += (v[0] * v[0] + v[1] * v[1]) + (v[2] * v[2] + v[3] * v[3]); }
                    ss = xor32_sum(xor16_sum(ss));
                    if (fq == 0) SSQ[(size_t)row * 12 + u.pn * 4 + wc] = ss;
                    bf16_t* dst = (u.pn < 2 ? CQ + (size_t)row * 512 + u.pn * 256 : CKV + (size_t)row * 256) + wc * 32 + fq * 8;
#pragma unroll
                    for (int bj = 0; bj < 2; ++bj) *(u32x4*)(dst + bj * 128) = pack8(acc[ai][bj][m][0], acc[ai][bj][m][1]);
                } else if (wc == 0) {
                    f32x4 v0 = acc[ai][0][m][0], v1 = acc[ai][0][m][1];
                    if (row < TL) { const int s = row & 4095, pos = (fq & 2) ? (s & 63) : (s >> 6);
                        const f32x4* tp = (const f32x4*)(tab32 + ((size_t)pos * 8 + (fq & 1) * 4) * 2); rope8(v0, v1, tp[0], tp[1]); }
                    *(u32x4*)(KR + (size_t)row * 32 + fq * 8) = pack8(v0, v1);
                }
            }
    }
};
struct EpiB2 {
    static constexpr bool PERM = true;
    bf16_t* QB; const float* SSQ; const float* tab32; float qscale;
    __device__ __forceinline__ void operator()(const f32x4 (&acc)[2][2][4][2], const Unit& u, int wr, int wc, int fr, int fq) const {
#pragma unroll
        for (int ai = 0; ai < 2; ++ai) if (ai < u.nai)
#pragma unroll
            for (int m = 0; m < 4; ++m) {
                asm volatile("" ::: "memory");
                const int row = u.pm * 256 + u.r0 + ai * 128 + wr * 64 + m * 16 + fr;
                const f32x4 s0 = *(const f32x4*)(SSQ + (size_t)row * 12), s1 = *(const f32x4*)(SSQ + (size_t)row * 12 + 4);
                const float ss = ((s0[0] + s0[1]) + (s0[2] + s0[3])) + ((s1[0] + s1[1]) + (s1[2] + s1[3]));
                const float sc = qscale / sqrtf(ss * (1.f / 512.f) + RMS_EPS);
#pragma unroll
                for (int bj = 0; bj < 2; ++bj) {
                    const int col = u.pn * 256 + bj * 128 + wc * 32 + fq * 8, w0 = col % 96;
                    f32x4 v0 = acc[ai][bj][m][0] * sc, v1 = acc[ai][bj][m][1] * sc;
                    if (w0 >= 64 && row < TL) { const int off = w0 - 64, s = row & 4095, pos = (off & 16) ? (s & 63) : (s >> 6);
                        const f32x4* tp = (const f32x4*)(tab32 + ((size_t)pos * 8 + ((off & 15) >> 1)) * 2); rope8(v0, v1, tp[0], tp[1]); }
                    *(u32x4*)(QB + (size_t)row * 1536 + col) = pack8(v0, v1);
                }
            }
    }
};
struct EpiB3 {
    static constexpr bool PERM = true;
    bf16_t* KN; bf16_t* VT; const float* SSQ;
    __device__ __forceinline__ void operator()(const f32x4 (&acc)[2][2][4][2], const Unit& u, int wr, int wc, int fr, int fq) const {
#pragma unroll
        for (int ai = 0; ai < 2; ++ai) if (ai < u.nai)
#pragma unroll
            for (int m = 0; m < 4; ++m) {
                asm volatile("" ::: "memory");
                const int row = u.pm * 256 + u.r0 + ai * 128 + wr * 64 + m * 16 + fr;
                const f32x4 s2 = *(const f32x4*)(SSQ + (size_t)row * 12 + 8);
                const float sc = 1.0f / sqrtf(((s2[0] + s2[1]) + (s2[2] + s2[3])) * (1.f / 256.f) + RMS_EPS);
#pragma unroll
                for (int bj = 0; bj < 2; ++bj) {
                    const f32x4 v0 = acc[ai][bj][m][0] * sc, v1 = acc[ai][bj][m][1] * sc;
                    const int tc = bj * 128 + wc * 32 + fq * 8;
                    if (u.pn < 4) *(u32x4*)(KN + (size_t)row * 1024 + u.pn * 256 + tc) = pack8(v0, v1);
                    else store_vt(VT, 16, 64, row, (u.pn - 4) * 256 + tc, v0, v1);
                }
            }
    }
};
struct EpiOut {
    static constexpr bool PERM = true;
    bf16_t* Y;
    __device__ __forceinline__ void operator()(const f32x4 (&acc)[2][2][4][2], const Unit& u, int wr, int wc, int fr, int fq) const {
#pragma unroll
        for (int ai = 0; ai < 2; ++ai) if (ai < u.nai)
#pragma unroll
            for (int m = 0; m < 4; ++m) {
                const int row = u.pm * 256 + u.r0 + ai * 128 + wr * 64 + m * 16 + fr;
#pragma unroll
                for (int bj = 0; bj < 2; ++bj)
                    *(u32x4*)(Y + (size_t)row * 1024 + u.pn * 256 + bj * 128 + wc * 32 + fq * 8) = pack8(acc[ai][bj][m][0], acc[ai][bj][m][1]);
            }
    }
};
struct EpiGU {
    static constexpr bool PERM = true;
    bf16_t* ACT;
    __device__ __forceinline__ void operator()(const f32x4 (&acc)[2][2][4][2], const Unit& u, int wr, int wc, int fr, int fq) const {
#pragma unroll
        for (int ai = 0; ai < 2; ++ai) if (ai < u.nai)
#pragma unroll
            for (int m = 0; m < 4; ++m) {
                asm volatile("" ::: "memory");
                const int row = u.pm * 256 + u.r0 + ai * 128 + wr * 64 + m * 16 + fr;
#pragma unroll
                for (int bj = 0; bj < 2; ++bj) {
                    const f32x4 g = acc[ai][bj][m][0], up = acc[ai][bj][m][1]; f32x4 a;
#pragma unroll
                    for (int i = 0; i < 4; ++i) a[i] = g[i] * __builtin_amdgcn_rcpf(1.f + __builtin_amdgcn_exp2f(-LOG2E * g[i])) * up[i];
                    u32x2 w; w.x = cvt_pk_bf16(a[0], a[1]); w.y = cvt_pk_bf16(a[2], a[3]);
                    *(u32x2*)(ACT + (size_t)row * 512 + (u.pn & 3) * 128 + bj * 64 + wc * 16 + fq * 4) = w;
                }
            }
    }
};
struct EpiDown {
    static constexpr bool PERM = true;
    bf16_t* Y2; const int* list; const int* cnt; const float* tokw;
    __device__ __forceinline__ void operator()(const f32x4 (&acc)[2][2][4][2], const Unit& u, int wr, int wc, int fr, int fq) const {
        const int ne = cnt[u.e * 64];
#pragma unroll
        for (int ai = 0; ai < 2; ++ai) if (ai < u.nai)
#pragma unroll
            for (int m = 0; m < 4; ++m) {
                asm volatile("" ::: "memory");
                const int idx = u.t * 256 + u.r0 + ai * 128 + wr * 64 + m * 16 + fr;
                if (idx < ne) {
                    const int ent = list[(size_t)u.e * T + idx]; const float w = tokw[ent];
#pragma unroll
                    for (int bj = 0; bj < 2; ++bj)
                        *(u32x4*)(Y2 + (size_t)ent * 1024 + (u.pn & 3) * 256 + bj * 128 + wc * 32 + fq * 8) = pack8(acc[ai][bj][m][0] * w, acc[ai][bj][m][1] * w);
                }
            }
    }
};
}

template <bool GATHER_> struct MoeOrder {
    static constexpr bool GATHER = GATHER_;
    const LAS int* tp; const int* cnt; const int* list; int G, c;
    __device__ bool next(int i, pg8::Unit& u) const {
        const int nwg = tp[NE] * 4, nfull = (nwg / G) * G, rem = nwg - nfull; const bool halves = rem > 0 && 2 * rem <= G;
        int Lx = i * G + c; u.r0 = 0; u.nai = 2;
        if (Lx >= nfull && halves) { if (i * G != nfull || c >= 2 * rem) return false; Lx = nfull + (c >> 1); u.r0 = (c & 1) * 128; u.nai = 1; }
        if (Lx >= nwg) return false;
        const int tt = Lx >> 2;
        const int ln_ = __builtin_amdgcn_mbcnt_hi(~0u, __builtin_amdgcn_mbcnt_lo(~0u, 0u));
        const int tv_ = tp[ln_ & (NE - 1)];
        const int e = __popcll(__ballot(ln_ >= 1 && ln_ < NE && tv_ <= tt));
        u.pm = tt; u.t = tt - tp[e]; u.e = e; u.pn = e * 4 + (Lx & 3); return true;
    }
    __device__ __forceinline__ int arow(const pg8::Unit& u, int r) const {
        if (!GATHER_) return u.pm * 256 + u.r0 + r;
        const int idx = u.t * 256 + u.r0 + r;
        return idx < cnt[u.e * 64] ? (list[(size_t)u.e * T + idx] >> 1) : 0;
    }
};
namespace attn {
struct Tensors {
    const bf16_t* Q; const bf16_t* K1; const bf16_t* K2; const bf16_t* VT; bf16_t* O;
    const float* sink; const float* lamp; const float* subln; float lambda_init;
};
__device__ __forceinline__ float max3f(float a, float b, float c) { float r; asm("v_max3_f32 %0, %1, %2, %3" : "=v"(r) : "v"(a), "v"(b), "v"(c)); return r; }
__device__ __forceinline__ float max32(const f32x16& a, const f32x16& b) {
    float r0 = max3f(a[0], a[1], a[2]), r1 = max3f(a[3], a[4], a[5]), r2 = max3f(a[6], a[7], a[8]), r3 = max3f(a[9], a[10], a[11]);
    r0 = max3f(r0, a[12], a[13]); r1 = max3f(r1, a[14], a[15]); r2 = max3f(r2, b[0], b[1]); r3 = max3f(r3, b[2], b[3]);
    r0 = max3f(r0, b[4], b[5]); r1 = max3f(r1, b[6], b[7]); r2 = max3f(r2, b[8], b[9]); r3 = max3f(r3, b[10], b[11]);
    r0 = max3f(r0, b[12], b[13]); r1 = max3f(r1, b[14], b[15]);
    return max3f(max3f(r0, r1, r2), r3, r3);
}
constexpr float ATT_THR = 10.f;
#define MFMA32(a, b, c) __builtin_amdgcn_mfma_f32_32x32x16_bf16((a), (b), (c), 0, 0, 0)

template <int KIND, bool PIPE = false, int VAR = 0>
__device__ __forceinline__ void phase(LAS unsigned char* lds, const Tensors P, int G, int cid, bool with_ctx) {
    asm volatile("" : "+s"(G), "+s"(cid));
    constexpr int NST = KIND == 1 ? 6 : 4, DV = KIND == 2 ? 128 : 64, NDV = DV / 32, KROWB = KIND == 0 ? 128 : 256, KCH = KIND == 0 ? 8 : (KIND == 1 ? 12 : 16);
    constexpr int KJ = (64 * KCH + 511) / 512, VJ = DV * 8 / 512, HV = KIND == 0 ? 4 : (KIND == 1 ? 16 : 8);
    constexpr int LDQ = KIND == 1 ? 1536 : 1024, LDK = KIND == 0 ? 256 : 1024;
    constexpr int KB0 = 0, VB0 = 32768, BUFSTEP = 16384, SCR = 65536;
    int tid_ = threadIdx.x; asm volatile("" : "+v"(tid_));
    const int tid = tid_, lane = tid & 63, w = __builtin_amdgcn_readfirstlane(tid >> 6), r = lane & 31, hh = lane >> 5;
    const int NU = 2048 + (with_ctx ? 128 : 0);
    constexpr int KPIECES = 64 * KROWB / 8192, VPIECES = DV * 128 / 8192;
    int ksrc[KPIECES], ksrb[KPIECES]; bool kpart2[KPIECES];
#pragma unroll
    for (int j = 0; j < KPIECES; ++j) {
        const int p = (j * 8 + w) * 1024 + lane * 16, kk = p / KROWB, pc = (p % KROWB) >> 4;
        int c = pc ^ (KROWB == 128 ? ((kk >> 1) & 7) : (kk & 15)); if (c >= KCH) c = 0;
        kpart2[j] = (KIND == 1) && c >= 8;
        ksrc[j] = kpart2[j] ? kk * 32 + (c - 8) * 8 : kk * LDK + c * 8;
        ksrb[j] = kpart2[j] ? 32 : LDK;
    }
    int vsrc[VPIECES];
#pragma unroll
    for (int j = 0; j < VPIECES; ++j) { const int p = (j * 8 + w) * 1024 + lane * 16, dv = p >> 7, pc = (p & 127) >> 4, c = pc ^ ((dv >> 1) & 7); vsrc[j] = dv * NKEY + c * 8; }
    const int rs = (r & ~12) | ((r & 4) << 1) | ((r & 8) >> 1);
    const int krow0 = rs * KROWB, krow1 = (32 + rs) * KROWB;
    const int ksw0 = KROWB == 128 ? ((rs >> 1) & 7) : (rs & 15), ksw1 = KROWB == 128 ? (((32 + rs) >> 1) & 7) : ((32 + rs) & 15);
    const int vsw = (r >> 1) & 7;
    float lam = 0.f;
    if (KIND == 2) { const float a = wave_sum(P.lamp[lane] * P.lamp[64 + lane]), b2 = wave_sum(P.lamp[128 + lane] * P.lamp[192 + lane]); lam = expf(a) - expf(b2) + P.lambda_init; }

#define ATT_DECL(X) int X##b = 0, X##hd = 0, X##qb = 0, X##qi = 0, X##wlo = 0, X##nwin = 0, X##nt = 0, X##ocol = 0, X##qcol = 0, X##kcol = 0, X##hv = 0, X##cmap = 0, X##qrow = 0, X##lat = 0
#define ATT_COPY(D_, S_) do { D_##b = S_##b; D_##hd = S_##hd; D_##qb = S_##qb; D_##qi = S_##qi; D_##wlo = S_##wlo; D_##nwin = S_##nwin; D_##nt = S_##nt; D_##ocol = S_##ocol; D_##qcol = S_##qcol; D_##kcol = S_##kcol; D_##hv = S_##hv; D_##cmap = S_##cmap; D_##qrow = S_##qrow; D_##lat = S_##lat; } while (0)
#define ATT_DECODE(U_, X) do { X##lat = (U_) < 2048; const int V_ = X##lat ? (U_) : (U_) - 2048; X##wlo = 0; X##nwin = 0; X##cmap = 0; int q0_; \
        if (KIND == 0) { \
            if (X##lat) { X##b = V_ >> 8; X##hd = (V_ >> 6) & 3; X##qb = V_ & 63; const int whi = X##qb + 2 > 63 ? 63 : X##qb + 2; X##wlo = X##qb - 2 < 0 ? 0 : X##qb - 2; X##nwin = whi - X##wlo + 1; } \
            else { X##b = V_ >> 4; X##hd = (V_ >> 2) & 3; X##qb = V_ & 3; } \
            q0_ = X##qb * 64; X##qi = q0_ + 32 * (w & 1) + r; const int hq = X##hd * 4 + (w >> 1); X##qcol = hq * 64; X##ocol = hq * 64; X##kcol = X##hd * 64; X##hv = X##hd; X##nt = X##nwin + 4; \
        } else if (KIND == 1) { \
            if (X##lat) { X##b = V_ >> 8; X##hd = (V_ >> 4) & 15; X##qb = V_ & 15; X##nt = 68; } else { X##b = V_ >> 4; X##hd = V_ & 15; X##qb = 0; X##nt = 4; } \
            q0_ = X##qb * 256; X##qi = q0_ + 32 * w + r; X##qcol = X##hd * 96; X##ocol = X##hd * 64; X##kcol = X##hd * 64; X##hv = X##hd; \
        } else { \
            if (X##lat) { X##b = V_ >> 8; X##hd = (V_ >> 5) & 7; X##qb = V_ & 31; X##nt = 68; } else { X##b = V_ >> 4; X##hd = (V_ >> 1) & 7; X##qb = V_ & 1; X##nt = 4; } \
            q0_ = X##qb * 128; X##qi = q0_ + 32 * (w & 3) + r; X##cmap = (w >> 2) * 8; X##qcol = (X##hd * 2 + (w >> 2)) * 64; X##ocol = X##hd * 128; X##kcol = X##hd * 128; X##hv = X##hd; \
        } \
        X##qrow = X##lat ? X##b * S + X##qi : TL + X##b * L + X##qi; } while (0)
#define ATT_TILE_KT(X, tt) ((KIND == 0) ? ((tt) < X##nwin ? X##wlo + (tt) : 64 + (tt) - X##nwin) : (X##lat ? (tt) : 64 + (tt)))
#define ATT_ISSUE(X, tt, buf_) do { const int kt_ = ATT_TILE_KT(X, tt); const int rb_ = kt_ < 64 ? X##b * S + 64 * kt_ : TL + X##b * L + 64 * (kt_ - 64); \
        const bf16_t* K1u_ = P.K1 + X##kcol; const bf16_t* VTu_ = P.VT + (size_t)(X##b * HV + X##hv) * DV * NKEY; \
        _Pragma("unroll") for (int j = 0; j < KPIECES; ++j) __builtin_amdgcn_global_load_lds((const unsigned*)((kpart2[j] ? P.K2 : K1u_) + (size_t)rb_ * ksrb[j] + ksrc[j]), (LAS unsigned*)(lds + KB0 + (buf_) * BUFSTEP + (j * 8 + w) * 1024), 16, 0, 0); \
        _Pragma("unroll") for (int j = 0; j < VPIECES; ++j) __builtin_amdgcn_global_load_lds((const unsigned*)(VTu_ + 64 * kt_ + vsrc[j]), (LAS unsigned*)(lds + VB0 + (buf_) * BUFSTEP + (j * 8 + w) * 1024), 16, 0, 0); } while (0)
#define ATT_QLOAD(dst, X) do { _Pragma("unroll") for (int st = 0; st < NST; ++st) dst[st] = *(const bf16x8*)(P.Q + (size_t)X##qrow * LDQ + X##qcol + 16 * st + 8 * hh); } while (0)
#define ATT_VFRAG(d, sub, sp) (*(const LAS bf16x8*)(vb + (32 * (d) + r) * 128 + 16 * ((4 * (sub) + 2 * (sp) + hh) ^ vsw)))
#define ATT_QX(SV, sp, lo, hi) do { _Pragma("unroll") for (int i_ = (lo); i_ < (hi); i_ += 2) { f32x2 t_; t_.x = __builtin_amdgcn_exp2f(SV[8 * (sp) + i_]); t_.y = __builtin_amdgcn_exp2f(SV[8 * (sp) + i_ + 1]); SV[8 * (sp) + i_] = t_.x; SV[8 * (sp) + i_ + 1] = t_.y; psv += t_; } } while (0)
#define ATT_QC(SV, sub, sp) do { u32x4 a_; a_.x = cvt_pk_bf16(SV[8 * (sp) + 0], SV[8 * (sp) + 1]); a_.y = cvt_pk_bf16(SV[8 * (sp) + 2], SV[8 * (sp) + 3]); a_.z = cvt_pk_bf16(SV[8 * (sp) + 4], SV[8 * (sp) + 5]); a_.w = cvt_pk_bf16(SV[8 * (sp) + 6], SV[8 * (sp) + 7]); pf[sub][sp] = __builtin_bit_cast(bf16x8, a_); } while (0)
#define ATT_TILE(tt, ISLAST) do { \
            const int buf = ((tt) + pb) & 1; \
            ATT_DECL(nx); if (ISLAST) { const int Un_ = U + G < NU ? U + G : U; ATT_DECODE(Un_, nx); ATT_ISSUE(nx, 0, buf ^ 1); } else { ATT_ISSUE(cu, (tt) + 1, buf ^ 1); } \
            const LAS unsigned char* kb = lds + KB0 + buf * BUFSTEP; const LAS unsigned char* vb = lds + VB0 + buf * BUFSTEP; \
            const float negm = -m; \
            f32x16 s0, s1; \
            _Pragma("unroll") for (int i = 0; i < 16; ++i) { s0[i] = negm; s1[i] = negm; } \
            { bf16x8 kf[NST][2]; \
              _Pragma("unroll") for (int st = 0; st < NST; ++st) { const int c = 2 * st + hh + cucmap; \
                  kf[st][0] = *(const LAS bf16x8*)(kb + krow0 + 16 * (c ^ ksw0)); kf[st][1] = *(const LAS bf16x8*)(kb + krow1 + 16 * (c ^ ksw1)); } \
              __builtin_amdgcn_sched_barrier(0); \
              __builtin_amdgcn_s_setprio(1); \
              _Pragma("unroll") for (int st = 0; st < NST; ++st) { s0 = MFMA32(kf[st][0], qf[st], s0); s1 = MFMA32(kf[st][1], qf[st], s1); } \
              __builtin_amdgcn_s_setprio(0); } \
            if (ISLAST) { __builtin_amdgcn_sched_barrier(0); ATT_QLOAD(qf, nx); }        \
            constexpr int NDVP = NDV < 2 ? NDV : 2; \
            bf16x8 vf[NDVP][2][2]; bf16x8 vq[2][4]; \
            if (NDV == 4) { _Pragma("unroll") for (int q = 0; q < 2; ++q) _Pragma("unroll") for (int d = 0; d < 4; ++d) vq[q][d] = ATT_VFRAG(d, 0, q); } \
            else { _Pragma("unroll") for (int d = 0; d < NDVP; ++d) _Pragma("unroll") for (int sub = 0; sub < 2; ++sub) _Pragma("unroll") for (int sp = 0; sp < 2; ++sp) vf[d][sub][sp] = ATT_VFRAG(d, sub, sp); } \
            __builtin_amdgcn_sched_barrier(0); \
            if (KIND == 0) { const int kt = ATT_TILE_KT(cu, tt); \
                if (kt < 64 && (kt == cuqb - 2 || kt == cuqb + 2)) { const int d0 = 64 * kt + 8 * hh - cuqi; \
                    _Pragma("unroll") for (int i = 0; i < 16; ++i) { const int da = d0 + (i & 7) + 16 * (i >> 3), db = da + 32; \
                        if (da < -128 || da > 128) s0[i] = -INFINITY; if (db < -128 || db > 128) s1[i] = -INFINITY; } } } \
            float mx = max32(s0, s1); \
            mx = xor32_max(mx); \
            const bool first = (KIND != 0) && (tt) == 0; \
            if (first || __any(mx > ATT_THR)) { \
                const float d = first ? mx : fmaxf(mx, 0.f), alpha = first ? 1.f : __builtin_amdgcn_exp2f(-d); \
                m += d; lsum *= alpha; \
                _Pragma("unroll") for (int dd = 0; dd < NDV; ++dd) o[dd] = o[dd] * alpha; \
                _Pragma("unroll") for (int i = 0; i < 16; ++i) { s0[i] -= d; s1[i] -= d; } } \
            f32x2 psv; psv.x = 0.f; psv.y = 0.f; \
            bf16x8 pf[2][2]; \
            ATT_QX(s0, 0, 0, 8); ATT_QC(s0, 0, 0); \
            __builtin_amdgcn_sched_barrier(0); \
            if (NDV == 4) { \
                  \
                o[0] = MFMA32(vq[0][0], pf[0][0], o[0]); o[1] = MFMA32(vq[0][1], pf[0][0], o[1]); __builtin_amdgcn_sched_barrier(0); ATT_QX(s0, 1, 0, 4); __builtin_amdgcn_sched_barrier(0); \
                o[2] = MFMA32(vq[0][2], pf[0][0], o[2]); o[3] = MFMA32(vq[0][3], pf[0][0], o[3]); __builtin_amdgcn_sched_barrier(0); ATT_QX(s0, 1, 4, 8); ATT_QC(s0, 0, 1); __builtin_amdgcn_sched_barrier(0); \
                _Pragma("unroll") for (int d = 0; d < 4; ++d) vq[0][d] = ATT_VFRAG(d, 1, 0); \
                __builtin_amdgcn_sched_barrier(0); \
                o[0] = MFMA32(vq[1][0], pf[0][1], o[0]); o[1] = MFMA32(vq[1][1], pf[0][1], o[1]); __builtin_amdgcn_sched_barrier(0); ATT_QX(s1, 0, 0, 4); __builtin_amdgcn_sched_barrier(0); \
                o[2] = MFMA32(vq[1][2], pf[0][1], o[2]); o[3] = MFMA32(vq[1][3], pf[0][1], o[3]); __builtin_amdgcn_sched_barrier(0); ATT_QX(s1, 0, 4, 8); ATT_QC(s1, 1, 0); __builtin_amdgcn_sched_barrier(0); \
                _Pragma("unroll") for (int d = 0; d < 4; ++d) vq[1][d] = ATT_VFRAG(d, 1, 1); \
                __builtin_amdgcn_sched_barrier(0); \
                o[0] = MFMA32(vq[0][0], pf[1][0], o[0]); o[1] = MFMA32(vq[0][1], pf[1][0], o[1]); __builtin_amdgcn_sched_barrier(0); ATT_QX(s1, 1, 0, 4); __builtin_amdgcn_sched_barrier(0); \
                o[2] = MFMA32(vq[0][2], pf[1][0], o[2]); o[3] = MFMA32(vq[0][3], pf[1][0], o[3]); __builtin_amdgcn_sched_barrier(0); ATT_QX(s1, 1, 4, 8); ATT_QC(s1, 1, 1); __builtin_amdgcn_sched_barrier(0); \
                o[0] = MFMA32(vq[1][0], pf[1][1], o[0]); o[1] = MFMA32(vq[1][1], pf[1][1], o[1]); o[2] = MFMA32(vq[1][2], pf[1][1], o[2]); o[3] = MFMA32(vq[1][3], pf[1][1], o[3]); \
            } else { \
                o[0] = MFMA32(vf[0][0][0], pf[0][0], o[0]); __builtin_amdgcn_sched_barrier(0); ATT_QX(s0, 1, 0, 4); __builtin_amdgcn_sched_barrier(0); \
                o[1] = MFMA32(vf[1][0][0], pf[0][0], o[1]); __builtin_amdgcn_sched_barrier(0); ATT_QX(s0, 1, 4, 8); ATT_QC(s0, 0, 1); __builtin_amdgcn_sched_barrier(0); \
                o[0] = MFMA32(vf[0][0][1], pf[0][1], o[0]); __builtin_amdgcn_sched_barrier(0); ATT_QX(s1, 0, 0, 4); __builtin_amdgcn_sched_barrier(0); \
                o[1] = MFMA32(vf[1][0][1], pf[0][1], o[1]); __builtin_amdgcn_sched_barrier(0); ATT_QX(s1, 0, 4, 8); ATT_QC(s1, 1, 0); __builtin_amdgcn_sched_barrier(0); \
                o[0] = MFMA32(vf[0][1][0], pf[1][0], o[0]); __builtin_amdgcn_sched_barrier(0); ATT_QX(s1, 1, 0, 4); __builtin_amdgcn_sched_barrier(0); \
                o[1] = MFMA32(vf[1][1][0], pf[1][0], o[1]); __builtin_amdgcn_sched_barrier(0); ATT_QX(s1, 1, 4, 8); ATT_QC(s1, 1, 1); __builtin_amdgcn_sched_barrier(0); \
                o[0] = MFMA32(vf[0][1][1], pf[1][1], o[0]); o[1] = MFMA32(vf[1][1][1], pf[1][1], o[1]); \
            } \
            lsum += psv.x + psv.y; \
            __syncthreads(); } while (0)

    int pb = 0;
    bf16x8 qf[NST];
    if (cid < NU) { ATT_DECL(cu); ATT_DECODE(cid, cu); ATT_QLOAD(qf, cu); ATT_ISSUE(cu, 0, 0); __syncthreads(); }
    for (int U = cid; U < NU; U += G) {
        ATT_DECL(cu); ATT_DECODE(U, cu);
        const int nt = cunt, qrow = cuqrow, ocol = cuocol;
        float m = 0.f, lsum = 0.f;
        if (KIND == 0) { m = P.sink[cuhd * 4 + (w >> 1)] * LOG2E; lsum = hh == 0 ? 1.f : 0.f; }
        f32x16 o[NDV];
#pragma unroll
        for (int d = 0; d < NDV; ++d)
#pragma unroll
            for (int i = 0; i < 16; ++i) o[d][i] = 0.f;
        for (int tt = 0; tt < nt - 1; ++tt) ATT_TILE(tt, 0);
        ATT_TILE(nt - 1, 1);
        pb = (nt + pb) & 1;
        const float inv = 1.f / (xor32_sum(lsum));
        if (KIND != 2) {
#pragma unroll
            for (int d = 0; d < NDV; ++d)
#pragma unroll
                for (int g4 = 0; g4 < 4; ++g4) {
                    u32x2 wv; wv.x = cvt_pk_bf16(o[d][4 * g4] * inv, o[d][4 * g4 + 1] * inv); wv.y = cvt_pk_bf16(o[d][4 * g4 + 2] * inv, o[d][4 * g4 + 3] * inv);
                    *(u32x2*)(P.O + (size_t)qrow * 1024 + ocol + 32 * d + 8 * g4 + 4 * hh) = wv;
                }
        } else {
            LAS float* scr = (LAS float*)(lds + SCR) + (size_t)(w & 3) * 64 * 64 + lane;
            if (w >= 4) {
#pragma unroll
                for (int d = 0; d < NDV; ++d)
#pragma unroll
                    for (int i = 0; i < 16; ++i) scr[(d * 16 + i) * 64] = o[d][i] * inv;
            }
            __syncthreads();
            if (w < 4) {
                float ss = 0.f;
#pragma unroll
                for (int d = 0; d < NDV; ++d)
#pragma unroll
                    for (int i = 0; i < 16; ++i) { const float v = o[d][i] * inv - lam * scr[(d * 16 + i) * 64]; o[d][i] = v; ss += v * v; }
                ss = xor32_sum(ss);
                const float rsn = (1.f - P.lambda_init) / sqrtf(ss * (1.f / 128.f) + RMS_EPS);
#pragma unroll
                for (int d = 0; d < NDV; ++d)
#pragma unroll
                    for (int g4 = 0; g4 < 4; ++g4) {
                        const int dv0 = 32 * d + 8 * g4 + 4 * hh; const f32x4 gv = *(const f32x4*)(P.subln + dv0);
                        u32x2 wv; wv.x = cvt_pk_bf16(o[d][4 * g4] * rsn * gv[0], o[d][4 * g4 + 1] * rsn * gv[1]); wv.y = cvt_pk_bf16(o[d][4 * g4 + 2] * rsn * gv[2], o[d][4 * g4 + 3] * rsn * gv[3]);
                        *(u32x2*)(P.O + (size_t)qrow * 1024 + ocol + dv0) = wv;
                    }
            }
        }
    }
#undef ATT_DECL
#undef ATT_COPY
#undef ATT_DECODE
#undef ATT_TILE_KT
#undef ATT_ISSUE
#undef ATT_QLOAD
#undef ATT_TILE
}
}
namespace thin {
__device__ __forceinline__ int sig64(int p) { return (p >> 5) * 32 + ((p & 31) >> 1) + 16 * (p & 1); }
__device__ __forceinline__ int sig32(int p) { return (p >> 4) * 16 + ((p & 15) >> 1) + 8 * (p & 1); }
__device__ __forceinline__ int src_col(int mode, int lim, int n, bool& second) {
    second = false;
    switch (mode) {
        case 1: return n < lim ? (n & ~63) + sig64(n & 63) : n;
        case 2: return n < 768 ? n : (n < 800 ? 768 + sig32(n - 768) : -1);
        case 3: { const int hq = n / 96, w = n % 96; return w < 64 ? n : hq * 96 + 64 + sig32(w - 64); }
        case 4: return n < 1024 ? (n >> 6) * 128 + (n & 63) : ((n - 1024) >> 6) * 128 + 64 + (n & 63);
        case 5: second = (n & 7) >= 4; return 4 * (n >> 3) + (n & 3);
        default: return n;
    }
}
__device__ __forceinline__ void conv_item(const float* src, const float* src2, const float* gain, int Nsrc, int K, int N, int mode, int lim, bf16_t* WT, int item, LAS float* scr, int lane) {
    const int nblk = N >> 6, kb = item / nblk, nb = item % nblk, k0 = kb * 64, n0 = nb * 64;
    bool second; const int col = src_col(mode, lim, n0 + lane, second);
    const float* sp = (second ? src2 : src) + (col < 0 ? 0 : col);
    float vv[64];
#pragma unroll
    for (int kk = 0; kk < 64; ++kk) vv[kk] = col < 0 ? 0.f : __builtin_nontemporal_load(sp + (size_t)(k0 + kk) * Nsrc);
    if (gain) {
#pragma unroll
        for (int kk = 0; kk < 64; ++kk) vv[kk] *= gain[k0 + kk];
    }
#pragma unroll
    for (int kk = 0; kk < 64; ++kk) scr[kk * 65 + lane] = vv[kk];
    asm volatile("s_waitcnt lgkmcnt(0)" ::: "memory");
    const int c = lane & 7;
#pragma unroll
    for (int j = 0; j < 8; ++j) { const int n = (lane >> 3) + 8 * j; const LAS float* s = scr + (8 * c) * 65 + n;
        u32x4 o; o.x = cvt_pk_bf16(s[0 * 65], s[1 * 65]); o.y = cvt_pk_bf16(s[2 * 65], s[3 * 65]); o.z = cvt_pk_bf16(s[4 * 65], s[5 * 65]); o.w = cvt_pk_bf16(s[6 * 65], s[7 * 65]);
        __builtin_nontemporal_store(o, (u32x4*)(WT + (size_t)(n0 + n) * K + k0 + 8 * c)); }
    asm volatile("s_waitcnt lgkmcnt(0)" ::: "memory");
}
constexpr int MOE_ITEMS = NE * 256 + NE * 128;
__device__ __forceinline__ void moe_fill(LAS unsigned char* lds, const float* w_gate, const float* w_up, const float* w_down, unsigned char* ws, int layer, int max_items, int* qctr) {
    int tid_ = threadIdx.x; asm volatile("" : "+v"(tid_));
    const int lane = tid_ & 63, w = __builtin_amdgcn_readfirstlane(tid_ >> 6);
    LAS float* scr = (LAS float*)lds + w * (64 * 65);
    for (int n = 0; n < max_items; ++n) {
        int it = 0; if (lane == 0) it = atomicAdd(qctr, 1);
        it = __builtin_amdgcn_readfirstlane(it);
        if (it >= MOE_ITEMS) break;
        if (it < NE * 256) { const int mi = layer * NE + (it >> 8), ii = it & 255;
            conv_item(w_gate + (size_t)mi * 1024 * 512, w_up + (size_t)mi * 1024 * 512, nullptr, 512, 1024, 1024, 5, 0, (bf16_t*)(ws + WS_WGU) + (size_t)mi * 1024 * 1024, ii, scr, lane); }
        else { const int r = it - NE * 256, mi = layer * NE + (r >> 7), ii = r & 127;
            conv_item(w_down + (size_t)mi * 512 * 1024, nullptr, nullptr, 1024, 512, 1024, 0, 0, (bf16_t*)(ws + WS_WD) + (size_t)mi * 1024 * 512, ii, scr, lane); }
    }
}
struct ProIn {
    const float *c, *c_ctx, *ada_w, *ada_b, *win_w_in, *win_w_out, *mla_w_in, *mla_q_norm, *mla_kv_norm, *mla_w_uq, *mla_w_ukv, *mla_w_out, *dif_w_in, *dif_w_out,
                *moe_w_grp, *moe_w_rt, *moe_w_gate, *moe_w_up, *moe_w_down;
    unsigned char* ws;
};
__device__ __forceinline__ void prologue(LAS unsigned char* lds, const ProIn& I, int G, int cid) {
    const int tid = threadIdx.x, lane = tid & 63, w = __builtin_amdgcn_readfirstlane(tid >> 6);
    unsigned char* ws = I.ws;
    {
        LAS float* scr = (LAS float*)lds + w * (64 * 65);
        const int gw = cid * NWAVES + w, NGW = G * NWAVES;
        constexpr int I_AIN = 16 * 24, I_SQ = 16 * 16, I_BUQ = 8 * 24, I_BUKV = 4 * 32, I_CIN = 16 * 48, I_GU = 16 * 16, I_D = 8 * 16;
        constexpr int NSMALL = 2 * I_AIN + 2 * I_SQ + I_SQ + I_BUQ + I_BUKV + I_SQ + I_CIN + I_SQ;
        constexpr int NITEMS = NSMALL + 128 * I_GU + 128 * I_D;
        for (int it = gw; it < NITEMS; it += NGW) {
            int r = it;
            if (r >= NSMALL) {
                r -= NSMALL;
                if (r < 128 * I_GU) { const int mi = r / I_GU, ii = r % I_GU;
                    conv_item(I.moe_w_gate + (size_t)mi * 1024 * 512, I.moe_w_up + (size_t)mi * 1024 * 512, nullptr, 512, 1024, 1024, 5, 0, (bf16_t*)(ws + WS_WGU) + (size_t)mi * 1024 * 1024, ii, scr, lane); }
                else { r -= 128 * I_GU; const int mi = r / I_D, ii = r % I_D;
                    conv_item(I.moe_w_down + (size_t)mi * 512 * 1024, nullptr, nullptr, 1024, 512, 1024, 0, 0, (bf16_t*)(ws + WS_WD) + (size_t)mi * 1024 * 512, ii, scr, lane); }
                continue;
            }
            if (r < 2 * I_AIN) { const int s = r / I_AIN; conv_item(I.win_w_in + (size_t)s * 1024 * 1536, nullptr, nullptr, 1536, 1024, 1536, 1, 1280, (bf16_t*)(ws + W_A_IN) + (size_t)s * 1536 * 1024, r % I_AIN, scr, lane); continue; } r -= 2 * I_AIN;
            if (r < 2 * I_SQ) { const int s = r / I_SQ; conv_item(I.win_w_out + (size_t)s * 1024 * 1024, nullptr, nullptr, 1024, 1024, 1024, 0, 0, (bf16_t*)(ws + W_A_OUT) + (size_t)s * 1024 * 1024, r % I_SQ, scr, lane); continue; } r -= 2 * I_SQ;
            if (r < I_SQ) { conv_item(I.mla_w_in, nullptr, nullptr, 800, 1024, 1024, 2, 0, (bf16_t*)(ws + W_B_IN), r, scr, lane); continue; } r -= I_SQ;
            if (r < I_BUQ) { conv_item(I.mla_w_uq, nullptr, I.mla_q_norm, 1536, 512, 1536, 3, 0, (bf16_t*)(ws + W_B_UQ), r, scr, lane); continue; } r -= I_BUQ;
            if (r < I_BUKV) { conv_item(I.mla_w_ukv, nullptr, I.mla_kv_norm, 2048, 256, 2048, 4, 0, (bf16_t*)(ws + W_B_UKV), r, scr, lane); continue; } r -= I_BUKV;
            if (r < I_SQ) { conv_item(I.mla_w_out, nullptr, nullptr, 1024, 1024, 1024, 0, 0, (bf16_t*)(ws + W_B_OUT), r, scr, lane); continue; } r -= I_SQ;
            if (r < I_CIN) { conv_item(I.dif_w_in, nullptr, nullptr, 3072, 1024, 3072, 1, 2048, (bf16_t*)(ws + W_C_IN), r, scr, lane); continue; } r -= I_CIN;
            conv_item(I.dif_w_out, nullptr, nullptr, 1024, 1024, 1024, 0, 0, (bf16_t*)(ws + W_C_OUT), r, scr, lane);
        }
    }
    __syncthreads();
    {
        LAS float* sc = (LAS float*)lds;
        LAS float* red = sc + 9 * 1024;
        for (int idx = tid; idx < 9 * 1024; idx += NTHREADS) { const int m = idx >> 10, k = idx & 1023; const float v = m < 8 ? I.c[m * 1024 + k] : I.c_ctx[k]; sc[idx] = v / (1.f + expf(-v)); }
        __syncthreads();
        float* mod = (float*)(ws + WS_MOD);
        for (int task = cid; task < DEPTH * 96; task += G) {
            const int layer = task / 96, j = (task % 96) * 64 + lane;
            float acc[9];
#pragma unroll
            for (int m = 0; m < 9; ++m) acc[m] = 0.f;
            const float* wp = I.ada_w + ((size_t)layer * 1024 + w * 128) * 6144 + j;
#pragma unroll 32
            for (int k = 0; k < 128; ++k) { const float wv = wp[(size_t)k * 6144];
#pragma unroll
                for (int m = 0; m < 9; ++m) acc[m] = fmaf(sc[m * 1024 + w * 128 + k], wv, acc[m]); }
#pragma unroll
            for (int m = 0; m < 9; ++m) red[(w * 9 + m) * 64 + lane] = acc[m];
            __syncthreads();
            for (int o = tid; o < 9 * 64; o += NTHREADS) { const int m = o >> 6, jl = o & 63; float s = 0.f;
#pragma unroll
                for (int ww = 0; ww < 8; ++ww) s += red[(ww * 9 + m) * 64 + jl];
                const int jj = (task % 96) * 64 + jl; mod[((size_t)layer * 9 + m) * 6144 + jj] = s + I.ada_b[layer * 6144 + jj]; }
            __syncthreads();
        }
    }
    {
        const int gt = cid * NTHREADS + tid, NGT = G * NTHREADS;
        float2* tab64 = (float2*)(ws + WS_TAB64); float2* tab32 = (float2*)(ws + WS_TAB32);
        for (int t = gt; t < 64 * 16 + 64 * 8; t += NGT) {
            if (t < 1024) { const int pos = t >> 4, j = t & 15; const float inv = (float)pow(10000.0, -(double)(2 * j) / 32.0), ang = (float)pos * inv;
                tab64[t] = make_float2((float)cos((double)ang), (float)sin((double)ang)); }
            else { const int u = t - 1024, pos = u >> 3, j = u & 7; const float inv = (float)pow(10000.0, -(double)(2 * j) / 16.0), ang = (float)pos * inv;
                tab32[u] = make_float2((float)cos((double)ang), (float)sin((double)ang)); }
        }
        bf16_t* rtw = (bf16_t*)(ws + WS_RTW);
        for (int t = gt; t < DEPTH * 64 * 1024; t += NGT) {
            const int layer = t >> 16, n = (t >> 10) & 63, k = t & 1023;
            float v = 0.f;
            if (n < 4) v = I.moe_w_grp[((size_t)layer * 1024 + k) * 4 + n]; else if (n < 36) v = I.moe_w_rt[((size_t)layer * 1024 + k) * 32 + (n - 4)];
            const unsigned hi = f2bf(v); const unsigned lo = f2bf(v - bf2f(hi));
            const int pos = ((((n >> 5) * 4 + (k >> 8)) * 16 + ((k >> 4) & 15)) * 64 + ((k >> 3) & 1) * 32 + (n & 31)) * 8 + (k & 7);
            rtw[((size_t)layer * 2 + 0) * 65536 + pos] = (bf16_t)hi; rtw[((size_t)layer * 2 + 1) * 65536 + pos] = (bf16_t)lo;
        }
    }
}
__device__ __forceinline__ void phase_h0(const float* x, const float* ctx, const float* mod0, bf16_t* H, int G, int cid) {
    const int lane = threadIdx.x & 63, gw = cid * NWAVES + (threadIdx.x >> 6), NGW = G * NWAVES;
    for (int row0 = gw * 2; row0 < T; row0 += NGW * 2) {
        const float* src = row0 < TL ? x + (size_t)row0 * 1024 : ctx + (size_t)(row0 - TL) * 1024; const float* mp = mod0 + (size_t)mrow_of(row0) * 6144;
        f32x4 v[2][4];
#pragma unroll
        for (int rr = 0; rr < 2; ++rr)
#pragma unroll
            for (int i = 0; i < 4; ++i) v[rr][i] = *(const f32x4*)(src + rr * 1024 + i * 256 + lane * 4);
#pragma unroll
        for (int rr = 0; rr < 2; ++rr)
#pragma unroll
            for (int i = 0; i < 4; ++i) { const int c = i * 256 + lane * 4;
                const f32x4 sh = *(const f32x4*)(mp + c), sc = *(const f32x4*)(mp + 1024 + c);
                const f32x4 h = v[rr][i] * (sc + 1.f) + sh; u32x2 wv; wv.x = cvt_pk_bf16(h[0], h[1]); wv.y = cvt_pk_bf16(h[2], h[3]);
                *(u32x2*)(H + (size_t)(row0 + rr) * 1024 + c) = wv; }
    }
}
constexpr int CNT_STRIDE = 64;
struct LnrArgs { const float* Xl; const float* Xc; const bf16_t* Y; float* STATS; bf16_t* H; const float* modl; const float* gam; const float* bet; const bf16_t* rtw; const float* b_grp; const float* b_rt; int* cnt; int* list; float* tokw; int nrows; };
#define LBAR() do { asm volatile("s_waitcnt lgkmcnt(0)" ::: "memory"); __builtin_amdgcn_s_barrier(); asm volatile("" ::: "memory"); } while (0)
template <int VAR = 0, bool XBF = false>
__device__ __forceinline__ void phase_lnr(LAS unsigned char* lds, const LnrArgs A, int G, int cid) {
    asm volatile("" : "+s"(G), "+s"(cid));
    constexpr int TSTR = 2064;
    int tid_ = threadIdx.x; asm volatile("" : "+v"(tid_));
    const int tid = tid_, lane = tid & 63, w = __builtin_amdgcn_readfirstlane(tid >> 6), r = lane & 31, hh = lane >> 5;
    LAS unsigned char* THI = lds; LAS unsigned char* TLO = lds + 32 * TSTR;
    LAS float* PART = (LAS float*)lds;

    LAS int* bcnt = (LAS int*)(lds + 2 * 32 * TSTR);
    LAS int* bbase = bcnt + 32;
    LAS float* bias = (LAS float*)(bbase + 32);
    LAS int* ents = (LAS int*)(bias + 40);
    LAS float* LOG = (LAS float*)(ents + 16 * 64 * 2);
    const int ngroups = A.nrows >> 5;
    const int nfull = (ngroups / G) * G, rem = ngroups - nfull; const bool halves = rem > 0 && 2 * rem <= G;
    const int nitems = halves ? nfull + 2 * rem : ngroups;
#define LNR_ITEM(j, grp_, h_, nr_) const int grp_ = (j) < nfull || !halves ? (j) : nfull + (((j) - nfull) >> 1); const int h_ = (j) < nfull || !halves ? 0 : (((j) - nfull) & 1); const int nr_ = (j) < nfull || !halves ? 32 : 16
    if (tid < 32) bcnt[tid] = 0;
    if (tid < 36) bias[tid] = tid < 4 ? A.b_grp[tid] : A.b_rt[tid - 4];
    f32x4 z[4][4]; u32x2 zr[4][4]; u32x2 yv[4][4];
#define LNR_LOAD(j_) do { LNR_ITEM(j_, g__, h__, n__); \
        _Pragma("unroll") for (int t4 = 0; t4 < 4; ++t4) { const int tl_ = 4 * w + t4; const int row_ = g__ * 32 + h__ * 16 + (tl_ < n__ ? tl_ : tl_ - 16); \
        const float* xs_ = row_ < TL ? A.Xl + (size_t)row_ * 1024 : A.Xc + (size_t)(row_ - TL) * 1024; \
        const bf16_t* xb_ = row_ < TL ? (const bf16_t*)A.Xl + (size_t)row_ * 1024 : (const bf16_t*)A.Xc + (size_t)(row_ - TL) * 1024; \
        _Pragma("unroll") for (int i = 0; i < 4; ++i) { if (XBF) zr[t4][i] = __builtin_nontemporal_load((const u32x2*)(xb_ + i * 256 + lane * 4)); else z[t4][i] = __builtin_nontemporal_load((const f32x4*)(xs_ + i * 256 + lane * 4)); \
            yv[t4][i] = __builtin_nontemporal_load((const u32x2*)(A.Y + (size_t)row_ * 1024 + i * 256 + lane * 4)); } } } while (0)
    if (cid < nitems) LNR_LOAD(cid);
    int gi = 0;
    for (int item = cid; item < nitems; item += G, ++gi) {
        LNR_ITEM(item, grp, hsel, nrow);
        f32x4 pgv[4], pga[4], pbe[4], psc[4], psh[4];
        { const float* mq_ = A.modl + (size_t)mrow_of(grp * 32 + hsel * 16) * 6144;
#pragma unroll
          for (int i = 0; i < 4; ++i) { const int c_ = i * 256 + lane * 4;
              pgv[i] = *(const f32x4*)(mq_ + 2 * 1024 + c_); psc[i] = *(const f32x4*)(mq_ + 4 * 1024 + c_); psh[i] = *(const f32x4*)(mq_ + 3 * 1024 + c_);
              if (XBF) { pga[i] = *(const f32x4*)(A.gam + c_); pbe[i] = *(const f32x4*)(A.bet + c_); } } }
        __builtin_amdgcn_sched_barrier(0);
#pragma unroll
        for (int t4 = 0; t4 < 4; ++t4) {
            const int tl = 4 * w + t4, row = grp * 32 + hsel * 16 + (tl < nrow ? tl : tl - 16); const bool rvalid = tl < nrow; const float* mp = A.modl + (size_t)mrow_of(row) * 6144;
            float s = 0.f, q = 0.f;
            if (XBF) {
#pragma unroll
                for (int i = 0; i < 4; ++i) { const u32x2 xr = zr[t4][i]; z[t4][i][0] = f16lo(xr.x); z[t4][i][1] = f16hi(xr.x); z[t4][i][2] = f16lo(xr.y); z[t4][i][3] = f16hi(xr.y); }
            }
#pragma unroll
            for (int i = 0; i < 4; ++i) { const f32x4 gv = pgv[i]; const u32x2 yb = yv[t4][i];
                f32x4 y; y[0] = bf2f(yb.x & 0xffffu); y[1] = bf2f(yb.x >> 16); y[2] = bf2f(yb.y & 0xffffu); y[3] = bf2f(yb.y >> 16);
                const f32x4 v = z[t4][i] * DN_ALPHA + gv * y; z[t4][i] = v; s += (v[0] + v[1]) + (v[2] + v[3]); q += (v[0] * v[0] + v[1] * v[1]) + (v[2] * v[2] + v[3] * v[3]); }
            wave_sum2(s, q);
            const float mean = s * (1.f / 1024.f); const float var = fmaxf(q * (1.f / 1024.f) - mean * mean, 0.f);
            const float rstd = 1.0f / sqrtf(var + LN_EPS);
            if (lane == 0 && rvalid) *(f32x2*)(A.STATS + (size_t)row * 2) = (f32x2){mean, rstd};
#pragma unroll
            for (int i = 0; i < 4; ++i) { const int c = i * 256 + lane * 4;
                const f32x4 ga_ = XBF ? pga[i] : *(const f32x4*)(A.gam + c), be_ = XBF ? pbe[i] : *(const f32x4*)(A.bet + c);
                const f32x4 xo = (z[t4][i] - mean) * rstd * ga_ + be_;
                const f32x4 h = xo * (psc[i] + 1.f) + psh[i];
                u32x2 hi; hi.x = cvt_pk_bf16(h[0], h[1]); hi.y = cvt_pk_bf16(h[2], h[3]);
                if (rvalid) *(u32x2*)(A.H + (size_t)row * 1024 + c) = hi;
                f32x4 rem; rem[0] = h[0] - bf2f(hi.x & 0xffffu); rem[1] = h[1] - bf2f(hi.x >> 16); rem[2] = h[2] - bf2f(hi.y & 0xffffu); rem[3] = h[3] - bf2f(hi.y >> 16);
                u32x2 lo; lo.x = cvt_pk_bf16(rem[0], rem[1]); lo.y = cvt_pk_bf16(rem[2], rem[3]);
                *(LAS u32x2*)(THI + tl * TSTR + c * 2) = hi; *(LAS u32x2*)(TLO + tl * TSTR + c * 2) = lo; }
            if (XBF && item + G < nitems) { LNR_ITEM(item + G, g2_, h2_, n2_); const int row2 = g2_ * 32 + h2_ * 16 + (tl < n2_ ? tl : tl - 16);
                const bf16_t* xb2 = row2 < TL ? (const bf16_t*)A.Xl + (size_t)row2 * 1024 : (const bf16_t*)A.Xc + (size_t)(row2 - TL) * 1024;
#pragma unroll
                for (int i = 0; i < 4; ++i) { zr[t4][i] = __builtin_nontemporal_load((const u32x2*)(xb2 + i * 256 + lane * 4)); yv[t4][i] = __builtin_nontemporal_load((const u32x2*)(A.Y + (size_t)row2 * 1024 + i * 256 + lane * 4)); } }
        }
        LBAR();
        if (VAR == 1) { if (!XBF && item + G < nitems) LNR_LOAD(item + G); continue; }
        f32x16 acc, acc2, acc3;
#pragma unroll
        for (int i = 0; i < 16; ++i) { acc[i] = 0.f; acc2[i] = 0.f; acc3[i] = 0.f; }
        { const int ct = w & 1, ks = w >> 1; const unsigned lo16 = (unsigned)lane * 16u;
          const int ub = __builtin_amdgcn_readfirstlane((ct * 4 + ks) * 16384);
          bf16x8 wh[16], wl[16];
#pragma unroll
          for (int st = 0; st < 16; ++st) { const char* sh_ = (const char*)A.rtw + (unsigned)(ub + 1024 * st); const char* sl_ = (const char*)A.rtw + (unsigned)(ub + 131072 + 1024 * st);
              wh[st] = *(const bf16x8*)(sh_ + lo16); wl[st] = *(const bf16x8*)(sl_ + lo16); }
#pragma unroll
          for (int st = 0; st < 16; ++st) {
              const bf16x8 ah = *(const LAS bf16x8*)(THI + r * TSTR + (ks * 256 + 16 * st + 8 * hh) * 2), al = *(const LAS bf16x8*)(TLO + r * TSTR + (ks * 256 + 16 * st + 8 * hh) * 2);
              acc = MFMA32(ah, wh[st], acc); acc2 = MFMA32(ah, wl[st], acc2); acc3 = MFMA32(al, wh[st], acc3);
          }
          acc = acc + acc2 + acc3; }
        if (!XBF && item + G < nitems) LNR_LOAD(item + G);
        LBAR();
#pragma unroll
        for (int i = 0; i < 16; ++i) PART[(w * 32 + (i & 3) + 8 * (i >> 2) + 4 * hh) * 33 + r] = acc[i];
        LBAR();
        for (int o = tid; o < 32 * 36; o += NTHREADS) { const int tk = o / 36, n = o % 36, ct = n >> 5, nl = n & 31;
            float s = 0.f;
#pragma unroll
            for (int ks = 0; ks < 4; ++ks) s += PART[((ks * 2 + ct) * 32 + tk) * 33 + nl];
            LOG[tk * 40 + n] = s + bias[n]; }
        LBAR();
        if (VAR != 2 && tid < nrow) {
            const LAS float* lg = LOG + tid * 40; const int row = grp * 32 + hsel * 16 + tid;
            const float g0 = lg[0], g1 = lg[1], g2 = lg[2], g3 = lg[3];
            int gs = 0; float gm = g0;
            if (g1 > gm) { gm = g1; gs = 1; } if (g2 > gm) { gm = g2; gs = 2; } if (g3 > gm) { gm = g3; gs = 3; }
            const float pg = 1.f / (expf(g0 - gm) + expf(g1 - gm) + expf(g2 - gm) + expf(g3 - gm));
            int i1 = 0; float v1 = lg[4 + gs * 8];
            for (int j = 1; j < 8; ++j) { const float v = lg[4 + gs * 8 + j]; if (v > v1) { v1 = v; i1 = j; } }
            int i2 = -1; float v2 = -INFINITY;
            for (int j = 0; j < 8; ++j) { const float v = lg[4 + gs * 8 + j]; if (j != i1 && v > v2) { v2 = v; i2 = j; } }
            const int ea = gs * 8 + i1, eb = gs * 8 + i2;
            const int ra = __hip_atomic_fetch_add(bcnt + ea, 1, __ATOMIC_RELAXED, __HIP_MEMORY_SCOPE_WORKGROUP), rb = __hip_atomic_fetch_add(bcnt + eb, 1, __ATOMIC_RELAXED, __HIP_MEMORY_SCOPE_WORKGROUP);
            const float e2 = expf(v2 - v1), w1 = pg / (1.f + e2), w2 = pg * e2 / (1.f + e2);
            *(f32x2*)(A.tokw + (size_t)row * 2) = (f32x2){w1, w2};
            LAS int* ep = ents + (gi * 64 + tid * 2) * 2;
            ep[0] = (ea << 16) | ra; ep[1] = row * 2; ep[2] = (eb << 16) | rb; ep[3] = row * 2 + 1;
        } else if (VAR != 2 && tid < 32) {
            LAS int* ep = ents + (gi * 64 + tid * 2) * 2; ep[0] = -1; ep[2] = -1;
        }
    }
#undef LNR_LOAD
#undef LNR_ITEM
    if (tid < 32) { const int n = bcnt[tid]; bbase[tid] = n ? atomicAdd(&A.cnt[tid * CNT_STRIDE], n) : 0; }
    __syncthreads();
    if (VAR == 0) for (int i = tid; i < gi * 64; i += NTHREADS) { const int key = ents[2 * i], val = ents[2 * i + 1], e = key >> 16; if (key >= 0) A.list[(size_t)e * T + bbase[e] + (key & 0xffff)] = val; }
    __syncthreads();
}
struct LnfArgs { const float* Xl; const float* Xc; const bf16_t* Y; const float* STATS; const bf16_t* Y2; const float* modl; const float* gam1; const float* bet1; const float* gam; const float* bet; float* Xout; bf16_t* H; const float* modn; int nrows; };
template <bool XINBF = false, bool XOUTBF = false>
__device__ __forceinline__ void phase_lnf(const LnfArgs A, int G, int cid) {
    asm volatile("" : "+s"(G), "+s"(cid));
    int tid_ = threadIdx.x; asm volatile("" : "+v"(tid_));
    const int lane = tid_ & 63, gw = cid * NWAVES + (tid_ >> 6), NGW = G * NWAVES;
#define LNF_DECL(S) f32x4 S##z[2][4]; u32x2 S##zr[2][4], S##yv[2][4], S##ya[2][4], S##yb[2][4]; f32x2 S##st[2]
#define LNF_LOAD(S, R0) do { const int r0_ = (R0); \
        const float* xs = r0_ < TL ? A.Xl + (size_t)r0_ * 1024 : A.Xc + (size_t)(r0_ - TL) * 1024; \
        const bf16_t* xb = r0_ < TL ? (const bf16_t*)A.Xl + (size_t)r0_ * 1024 : (const bf16_t*)A.Xc + (size_t)(r0_ - TL) * 1024; \
        _Pragma("unroll") for (int rr = 0; rr < 2; ++rr) { \
            S##st[rr] = *(const f32x2*)(A.STATS + (size_t)(r0_ + rr) * 2); \
            _Pragma("unroll") for (int i = 0; i < 4; ++i) { const int c = i * 256 + lane * 4; const size_t row = (size_t)(r0_ + rr); \
                if (XINBF) S##zr[rr][i] = __builtin_nontemporal_load((const u32x2*)(xb + rr * 1024 + c)); else S##z[rr][i] = __builtin_nontemporal_load((const f32x4*)(xs + rr * 1024 + c)); \
                S##yv[rr][i] = __builtin_nontemporal_load((const u32x2*)(A.Y + row * 1024 + c)); \
                S##ya[rr][i] = __builtin_nontemporal_load((const u32x2*)(A.Y2 + row * 2048 + c)); S##yb[rr][i] = __builtin_nontemporal_load((const u32x2*)(A.Y2 + row * 2048 + 1024 + c)); } } } while (0)
#define LNF_COMPUTE(S, R0) do { const int r0_ = (R0); \
        const int mr = mrow_of(r0_); const float* gm = A.modl + (size_t)mr * 6144 + 2 * 1024; const float* gf = A.modl + (size_t)mr * 6144 + 5 * 1024;        \
          \
        f32x4 pg1[4], pg2[4], pa1[4], pb1[4], pa[4], pb[4], psc[4], psh[4]; \
        _Pragma("unroll") for (int i = 0; i < 4; ++i) { const int c = i * 256 + lane * 4; \
            pg1[i] = *(const f32x4*)(gm + c); pg2[i] = *(const f32x4*)(gf + c); pa1[i] = *(const f32x4*)(A.gam1 + c); pb1[i] = *(const f32x4*)(A.bet1 + c); \
            pa[i] = *(const f32x4*)(A.gam + c); pb[i] = *(const f32x4*)(A.bet + c); \
            if (XINBF && A.H) { const float* mp = A.modn + (size_t)mr * 6144; psc[i] = *(const f32x4*)(mp + 1024 + c); psh[i] = *(const f32x4*)(mp + c); } } \
        __builtin_amdgcn_sched_barrier(0); \
        _Pragma("unroll") for (int rr = 0; rr < 2; ++rr) { \
            const size_t row = (size_t)(r0_ + rr); \
            f32x4 zz[4]; float s = 0.f, q = 0.f; \
            _Pragma("unroll") for (int i = 0; i < 4; ++i) { \
                const u32x2 y1 = S##yv[rr][i], a = S##ya[rr][i], b = S##yb[rr][i]; \
                f32x4 xin; if (XINBF) { const u32x2 xr = S##zr[rr][i]; xin[0] = f16lo(xr.x); xin[1] = f16hi(xr.x); xin[2] = f16lo(xr.y); xin[3] = f16hi(xr.y); } else xin = S##z[rr][i]; \
                f32x4 ym; ym[0] = bf2f(y1.x & 0xffffu); ym[1] = bf2f(y1.x >> 16); ym[2] = bf2f(y1.y & 0xffffu); ym[3] = bf2f(y1.y >> 16); \
                const f32x4 x1 = ((xin * DN_ALPHA + pg1[i] * ym) - S##st[rr][0]) * S##st[rr][1] * pa1[i] + pb1[i]; \
                f32x4 y; y[0] = bf2f(a.x & 0xffffu) + bf2f(b.x & 0xffffu); y[1] = bf2f(a.x >> 16) + bf2f(b.x >> 16); y[2] = bf2f(a.y & 0xffffu) + bf2f(b.y & 0xffffu); y[3] = bf2f(a.y >> 16) + bf2f(b.y >> 16); \
                const f32x4 v = x1 * DN_ALPHA + pg2[i] * y; zz[i] = v; s += (v[0] + v[1]) + (v[2] + v[3]); q += (v[0] * v[0] + v[1] * v[1]) + (v[2] * v[2] + v[3] * v[3]); } \
            wave_sum2(s, q); \
            const float mean = s * (1.f / 1024.f); const float var = fmaxf(q * (1.f / 1024.f) - mean * mean, 0.f); \
            const float rstd = 1.0f / sqrtf(var + LN_EPS); \
            _Pragma("unroll") for (int i = 0; i < 4; ++i) { const int c = i * 256 + lane * 4; \
                const f32x4 xo = (zz[i] - mean) * rstd * pa[i] + pb[i]; \
                if (XOUTBF) { u32x2 xw; xw.x = pack_f16(xo[0], xo[1]); xw.y = pack_f16(xo[2], xo[3]); __builtin_nontemporal_store(xw, (u32x2*)((bf16_t*)A.Xout + row * 1024 + c)); } \
                else *(f32x4*)(A.Xout + row * 1024 + c) = xo; \
                if (A.H) { const float* mp = A.modn + (size_t)mr * 6144; const f32x4 sc_ = XINBF ? psc[i] : *(const f32x4*)(mp + 1024 + c), sh_ = XINBF ? psh[i] : *(const f32x4*)(mp + c);        \
                    const f32x4 h = xo * (sc_ + 1.f) + sh_; \
                    u32x2 wv; wv.x = cvt_pk_bf16(h[0], h[1]); wv.y = cvt_pk_bf16(h[2], h[3]); *(u32x2*)(A.H + row * 1024 + c) = wv; } } } } while (0)
    const int stride = NGW * 2;
    LNF_DECL(c_);
    for (int row0 = gw * 2; row0 < A.nrows; row0 += stride) { LNF_LOAD(c_, row0); LNF_COMPUTE(c_, row0); }
}
#undef LNF_DECL
#undef LNF_LOAD
#undef LNF_COMPUTE
template <bool XINBF, bool XOUTBF>
__device__ __forceinline__ void phase_lnf16(LAS unsigned char* lds, const LnfArgs A, int G, int cid) {
    asm volatile("" : "+s"(G), "+s"(cid));
    int tid_ = threadIdx.x; asm volatile("" : "+v"(tid_));
    const int tid = tid_, lane = tid & 63, w = __builtin_amdgcn_readfirstlane(tid >> 6);
    const int RPB = 2 * ((A.nrows + 2 * G - 1) / (2 * G));
    const int rb0 = cid * RPB, rb1 = rb0 + RPB < A.nrows ? rb0 + RPB : A.nrows;
    const int mr_lo = mrow_of(rb0 < A.nrows ? rb0 : A.nrows - 1), mr_hi = mrow_of(rb1 > rb0 ? rb1 - 1 : (rb0 < A.nrows ? rb0 : A.nrows - 1));
    LAS float* PL = (LAS float*)lds;
    for (int v = tid; v < 12 * 256; v += NTHREADS) {
        const int vec = v >> 8, c = (v & 255) * 4; f32x4 val = (f32x4){0.f, 0.f, 0.f, 0.f};
        if (vec < 4) { const float* src = vec == 0 ? A.gam1 : (vec == 1 ? A.bet1 : (vec == 2 ? A.gam : A.bet)); val = *(const f32x4*)(src + c); }
        else { const int sset = (vec - 4) >> 2, k = (vec - 4) & 3; const int mr = sset ? mr_hi : mr_lo;
            if (k < 2) val = *(const f32x4*)(A.modl + (size_t)mr * 6144 + (k == 0 ? 2 : 5) * 1024 + c);
            else if (A.H) val = *(const f32x4*)(A.modn + (size_t)mr * 6144 + (k == 2 ? 1024 : 0) + c); }
        *(LAS f32x4*)(PL + vec * 1024 + c) = val;
    }
    __syncthreads();
#define L16_DECL(S) f32x4 S##z[2][4]; u32x2 S##zr[2][4], S##yv[2][4], S##ya[2][4], S##yb[2][4]; f32x2 S##st[2]
#define L16_LOAD(S, R0) do { const int r0_ = (R0); \
        const bf16_t* xb = r0_ < TL ? (const bf16_t*)A.Xl + (size_t)r0_ * 1024 : (const bf16_t*)A.Xc + (size_t)(r0_ - TL) * 1024; \
        const float* xs = r0_ < TL ? A.Xl + (size_t)r0_ * 1024 : A.Xc + (size_t)(r0_ - TL) * 1024; \
        _Pragma("unroll") for (int rr = 0; rr < 2; ++rr) { \
            S##st[rr] = *(const f32x2*)(A.STATS + (size_t)(r0_ + rr) * 2); \
            _Pragma("unroll") for (int i = 0; i < 4; ++i) { const int c = i * 256 + lane * 4; const size_t row = (size_t)(r0_ + rr); \
                if (XINBF) S##zr[rr][i] = __builtin_nontemporal_load((const u32x2*)(xb + rr * 1024 + c)); else S##z[rr][i] = __builtin_nontemporal_load((const f32x4*)(xs + rr * 1024 + c)); \
                S##yv[rr][i] = __builtin_nontemporal_load((const u32x2*)(A.Y + row * 1024 + c)); \
                S##ya[rr][i] = __builtin_nontemporal_load((const u32x2*)(A.Y2 + row * 2048 + c)); S##yb[rr][i] = __builtin_nontemporal_load((const u32x2*)(A.Y2 + row * 2048 + 1024 + c)); } } } while (0)
#define L16_COMPUTE(S, R0) do { const int r0_ = (R0); \
        const LAS float* PS = PL + 4096 + (mrow_of(r0_) != mr_lo ? 4096 : 0);        \
        _Pragma("unroll") for (int rr = 0; rr < 2; ++rr) { \
            const size_t row = (size_t)(r0_ + rr); \
            f32x4 zz[4]; float s = 0.f, q = 0.f; \
            _Pragma("unroll") for (int i = 0; i < 4; ++i) { const int c = i * 256 + lane * 4; \
                const f32x4 g1 = *(const LAS f32x4*)(PS + c), g2 = *(const LAS f32x4*)(PS + 1024 + c), a1 = *(const LAS f32x4*)(PL + c), b1 = *(const LAS f32x4*)(PL + 1024 + c); \
                const u32x2 y1 = S##yv[rr][i], a = S##ya[rr][i], b = S##yb[rr][i]; \
                f32x4 xin; if (XINBF) { const u32x2 xr = S##zr[rr][i]; xin[0] = f16lo(xr.x); xin[1] = f16hi(xr.x); xin[2] = f16lo(xr.y); xin[3] = f16hi(xr.y); } else xin = S##z[rr][i]; \
                f32x4 ym; ym[0] = bf2f(y1.x & 0xffffu); ym[1] = bf2f(y1.x >> 16); ym[2] = bf2f(y1.y & 0xffffu); ym[3] = bf2f(y1.y >> 16); \
                const f32x4 x1 = ((xin * DN_ALPHA + g1 * ym) - S##st[rr][0]) * S##st[rr][1] * a1 + b1; \
                f32x4 y; y[0] = bf2f(a.x & 0xffffu) + bf2f(b.x & 0xffffu); y[1] = bf2f(a.x >> 16) + bf2f(b.x >> 16); y[2] = bf2f(a.y & 0xffffu) + bf2f(b.y & 0xffffu); y[3] = bf2f(a.y >> 16) + bf2f(b.y >> 16); \
                const f32x4 v = x1 * DN_ALPHA + g2 * y; zz[i] = v; s += (v[0] + v[1]) + (v[2] + v[3]); q += (v[0] * v[0] + v[1] * v[1]) + (v[2] * v[2] + v[3] * v[3]); } \
            wave_sum2(s, q); \
            const float mean = s * (1.f / 1024.f); const float var = fmaxf(q * (1.f / 1024.f) - mean * mean, 0.f); \
            const float rstd = 1.0f / sqrtf(var + LN_EPS); \
            _Pragma("unroll") for (int i = 0; i < 4; ++i) { const int c = i * 256 + lane * 4; \
                const f32x4 xo = (zz[i] - mean) * rstd * *(const LAS f32x4*)(PL + 2048 + c) + *(const LAS f32x4*)(PL + 3072 + c); \
                if (XOUTBF) { u32x2 xw; xw.x = pack_f16(xo[0], xo[1]); xw.y = pack_f16(xo[2], xo[3]); __builtin_nontemporal_store(xw, (u32x2*)((bf16_t*)A.Xout + row * 1024 + c)); } \
                else *(f32x4*)(A.Xout + row * 1024 + c) = xo; \
                if (A.H) { const f32x4 h = xo * (*(const LAS f32x4*)(PS + 2048 + c) + 1.f) + *(const LAS f32x4*)(PS + 3072 + c); \
                    u32x2 wv; wv.x = cvt_pk_bf16(h[0], h[1]); wv.y = cvt_pk_bf16(h[2], h[3]); *(u32x2*)(A.H + row * 1024 + c) = wv; } } } } while (0)
    L16_DECL(a_); L16_DECL(b_);
    int r = rb0 + 2 * w;
    if (r < rb1) L16_LOAD(a_, r);
    for (; r < rb1; r += 32) {
        const int r1 = r + 16, r2 = r + 32;
        if (r1 < rb1) L16_LOAD(b_, r1);
        L16_COMPUTE(a_, r);
        if (r1 >= rb1) break;
        if (r2 < rb1) L16_LOAD(a_, r2);
        L16_COMPUTE(b_, r1);
    }
    __syncthreads();
#undef L16_DECL
#undef L16_LOAD
#undef L16_COMPUTE
}
}
#ifndef PH_MASK
#define PH_MASK 0xFFFF
#endif
#define PH_EN(k) ((PH_MASK >> (k)) & 1)
#ifndef PH_REPM
#define PH_REPM 0
#endif
#define NREP(k) (((PH_REPM >> (k)) & 1) ? 2 : 1)
#ifndef ATT_PIPE_A
#define ATT_PIPE_A false
#endif
#ifndef ATT_PIPE_B
#define ATT_PIPE_B false
#endif
#ifndef ATT_PIPE_C
#define ATT_PIPE_C false
#endif
#ifndef ONE_LAUNCH
#define ONE_LAUNCH 1
#endif
constexpr int NPH = 2 + 8 * DEPTH;
struct Params { const float* in[30]; float* out; unsigned char* ws; int ph_lo, ph_hi; };

__global__ void __launch_bounds__(NTHREADS, 2) k_run(Params p) {
    extern __shared__ __attribute__((aligned(16))) unsigned char lds_raw[];
    LAS unsigned char* lds = (LAS unsigned char*)lds_raw;
    volatile LAS unsigned* MISC = (volatile LAS unsigned*)(lds + MISC_OFF);
    const int G = gridDim.x;
    const int cid = (G % 8 == 0) ? ((int)blockIdx.x % 8) * (G / 8) + (int)blockIdx.x / 8 : (int)blockIdx.x;
    typedef const __attribute__((address_space(4))) Params* KP;
    KP pp = (KP)__builtin_amdgcn_kernarg_segment_ptr();
    unsigned char* ws = p.ws;
    for (int u = threadIdx.x; u < 256; u += NTHREADS) MISC[u] = 0u;
    __syncthreads();
    const int lo = p.ph_lo, hi = p.ph_hi;
    XcdBarrier bar; bar.bar = (unsigned*)(ws + WS_CTL) + CW_BAR; bar.x = 0; bar.st = nullptr;
    if (hi - lo > 1) bar = xcd_barrier_post((unsigned*)(ws + WS_CTL) + CW_BAR, MISC + 8);
#define IN(k) (lo <= (k) && (k) < hi)
#define SEAM(k) do { if (IN(k) && IN((k) + 1)) { xcd_barrier(bar); if (NREP(15) == 2) xcd_barrier(bar); } } while (0)

    if (PH_EN(0) && IN(0)) {
        thin::ProIn I; I.c = p.in[1]; I.c_ctx = p.in[3]; I.ada_w = p.in[4]; I.ada_b = p.in[5]; I.win_w_in = p.in[10]; I.win_w_out = p.in[11];
        I.mla_w_in = p.in[13]; I.mla_q_norm = p.in[14]; I.mla_kv_norm = p.in[15]; I.mla_w_uq = p.in[16]; I.mla_w_ukv = p.in[17]; I.mla_w_out = p.in[18];
        I.dif_w_in = p.in[19]; I.dif_w_out = p.in[22]; I.moe_w_grp = p.in[23]; I.moe_w_rt = p.in[25]; I.moe_w_gate = p.in[27]; I.moe_w_up = p.in[28]; I.moe_w_down = p.in[29]; I.ws = ws;
        for (int rep = 0; rep < NREP(0); ++rep) { thin::prologue(lds, I, G, cid); __syncthreads(); }
    }
    SEAM(0);
    if (PH_EN(1) && IN(1)) for (int rep = 0; rep < NREP(1); ++rep) thin::phase_h0(p.in[0], p.in[2], (const float*)(ws + WS_MOD), (bf16_t*)(ws + WS_H), G, cid);
    SEAM(1);

#pragma unroll 1
    for (int li = 0; li < DEPTH; ++li) {
        asm volatile("" : "+s"(pp));
        { size_t zoff = 0; asm volatile("" : "+s"(zoff)); ws = pp->ws + zoff; }
        const int base = 2 + 8 * li, kind = li % 3, slot = li / 3; const bool last = li == DEPTH - 1;
        float* mod = (float*)(ws + WS_MOD);
        const float* tab64 = (const float*)(ws + WS_TAB64); const float* tab32 = (const float*)(ws + WS_TAB32);
        float* X = (float*)(ws + WS_X); bf16_t* H = (bf16_t*)(ws + WS_H); bf16_t* O = (bf16_t*)(ws + WS_O);
        unsigned char* R1 = ws + WS_R1;
        int* list = (int*)(ws + WS_LIST); float* tokw = (float*)(ws + WS_TOKW); float* SSQ = (float*)(ws + WS_SSQ);
        const float* modl = mod + (size_t)li * 9 * 6144;
        const int Mpost = last ? TL : T;
        int* cnt = (int*)(ws + WS_CTL) + CW_CNT + li * NE * 64;
#define IDLE_FILL(nunits, myid, budget) do { if (li + 1 < DEPTH) { const int nu_ = (nunits), R_ = (nu_ + G - 1) / G - 1; if (R_ * G + (myid) >= nu_) { \
            thin::moe_fill(lds, pp->in[27], pp->in[28], pp->in[29], ws, li + 1, (budget), (int*)(ws + WS_CTL) + CW_Q + 64 * (li + 1)); __syncthreads(); } } } while (0)
        if (IN(base + 0)) {
            if (PH_EN(2) && kind == 0) {
                pg8::Gemm g{H, (const bf16_t*)(ws + W_A_IN) + (size_t)slot * 1536 * 1024, 1024}; pg8::StaticOrder So; So.init(T, 1536, G, (int)blockIdx.x);
                epi::EpiQKV E{(bf16_t*)(R1 + R_QA), 1024, (bf16_t*)(R1 + R_KA), 256, (bf16_t*)(R1 + R_VTA), 4, 64, 4, 1, 0.125f * LOG2E, tab64};
                for (int rep = 0; rep < NREP(2); ++rep) pg8::gemm_phase<epi::EpiQKV, pg8::StaticOrder, true>(lds, g, So, E);
            } else if (PH_EN(3) && kind == 1) {
                pg8::Gemm g{H, (const bf16_t*)(ws + W_B_IN), 1024}; pg8::StaticOrder So; So.init(T, 1024, G, (int)blockIdx.x);
                epi::EpiB1 E{(bf16_t*)(R1 + R_CQ), (bf16_t*)(R1 + R_CKV), (bf16_t*)(R1 + R_KR), SSQ, tab32};
                for (int rep = 0; rep < NREP(3); ++rep) pg8::gemm_phase<epi::EpiB1, pg8::StaticOrder, true>(lds, g, So, E);
            } else if (PH_EN(4) && kind == 2) {
                pg8::Gemm g{H, (const bf16_t*)(ws + W_C_IN), 1024}; pg8::StaticOrder So; So.init(T, 3072, G, (int)blockIdx.x);
                epi::EpiQKV E{(bf16_t*)(R1 + R_QC), 1024, (bf16_t*)(R1 + R_KC), 1024, (bf16_t*)(R1 + R_VTC), 8, 128, 4, 4, 0.125f * LOG2E, tab64};
                for (int rep = 0; rep < NREP(4); ++rep) pg8::gemm_phase<epi::EpiQKV, pg8::StaticOrder, true>(lds, g, So, E);
            }
        }
        SEAM(base + 0);
        if (PH_EN(5) && IN(base + 1) && kind == 1) {
            { pg8::Gemm g{(const bf16_t*)(R1 + R_CQ), (const bf16_t*)(ws + W_B_UQ), 512}; pg8::StaticOrder So; So.init(T, 1536, G, (int)blockIdx.x);
              epi::EpiB2 E{(bf16_t*)(R1 + R_QB), SSQ, tab32, 0.10206207261596575f * LOG2E};
              for (int rep = 0; rep < NREP(5); ++rep) pg8::gemm_phase<epi::EpiB2, pg8::StaticOrder, true>(lds, g, So, E); }
            { pg8::Gemm g{(const bf16_t*)(R1 + R_CKV), (const bf16_t*)(ws + W_B_UKV), 256}; pg8::StaticOrder So; So.init(T, 2048, G, (int)blockIdx.x);
              epi::EpiB3 E{(bf16_t*)(R1 + R_KN), (bf16_t*)(R1 + R_VTB), SSQ};
              for (int rep = 0; rep < NREP(5); ++rep) pg8::gemm_phase<epi::EpiB3, pg8::StaticOrder, true>(lds, g, So, E); }
        }
        if (kind == 1) SEAM(base + 1);
#ifdef CLK_PROBE
        if (li == 1 && IN(base + 2)) {
            f32x16 c0; bf16x8 fa, fb;
#pragma unroll
            for (int i = 0; i < 16; ++i) c0[i] = 0.f;
#pragma unroll
            for (int i = 0; i < 8; ++i) { fa[i] = (short)(0x3c00 + tid + i); fb[i] = (short)(0x3d00 + i); }
#pragma unroll 1
            for (int it = 0; it < 16384 / 8; ++it) {
#pragma unroll
                for (int u = 0; u < 8; ++u) c0 = MFMA32(fa, fb, c0);
            }
            float sres = 0.f;
#pragma unroll
            for (int i = 0; i < 16; ++i) sres += c0[i];
            ((float*)pp->out)[blockIdx.x * NTHREADS + tid] = sres;
        }
#endif
        if (IN(base + 2)) {
            attn::Tensors At; At.O = O; At.sink = nullptr; At.lamp = nullptr; At.subln = nullptr; At.lambda_init = 0.f; At.K2 = nullptr;
            if (PH_EN(6) && kind == 0) { At.Q = (const bf16_t*)(R1 + R_QA); At.K1 = (const bf16_t*)(R1 + R_KA); At.VT = (const bf16_t*)(R1 + R_VTA); At.sink = pp->in[12] + slot * 16;
                for (int rep = 0; rep < NREP(6); ++rep) attn::phase<0, ATT_PIPE_A>(lds, At, G, cid, !last); }
            else if (PH_EN(7) && kind == 1) { At.Q = (const bf16_t*)(R1 + R_QB); At.K1 = (const bf16_t*)(R1 + R_KN); At.K2 = (const bf16_t*)(R1 + R_KR); At.VT = (const bf16_t*)(R1 + R_VTB);
#ifdef ATT_PROBE
                { attn::Tensors At2 = At; At2.O = (bf16_t*)pp->out; attn::phase<1, ATT_PIPE_B, ATT_PROBE>(lds, At2, G, cid, !last); }
#endif
                for (int rep = 0; rep < NREP(7); ++rep) attn::phase<1, ATT_PIPE_B>(lds, At, G, cid, !last); }
            else if (PH_EN(8) && kind == 2) { At.Q = (const bf16_t*)(R1 + R_QC); At.K1 = (const bf16_t*)(R1 + R_KC); At.VT = (const bf16_t*)(R1 + R_VTC); At.lamp = pp->in[20] + slot * 256; At.subln = pp->in[21] + slot * 128;
                At.lambda_init = 0.8f - 0.6f * expf(-0.3f * (float)li);
                for (int rep = 0; rep < NREP(8); ++rep) attn::phase<2, ATT_PIPE_C>(lds, At, G, cid, !last); }
        }
        SEAM(base + 2);
        if (PH_EN(9) && IN(base + 3)) {
            const bf16_t* Wt = kind == 0 ? (const bf16_t*)(ws + W_A_OUT) + (size_t)slot * 1024 * 1024 : (kind == 1 ? (const bf16_t*)(ws + W_B_OUT) : (const bf16_t*)(ws + W_C_OUT));
            pg8::Gemm g{O, Wt, 1024}; pg8::StaticOrder So; So.init(Mpost, 1024, G, (int)blockIdx.x);
            epi::EpiOut E{(bf16_t*)(R1 + R_Y)};
            if (NREP(9) == 2) pg8::gemm_phase<epi::EpiOut, pg8::StaticOrder, true>(lds, g, So, E);
            pg8::gemm_phase<epi::EpiOut, pg8::StaticOrder, true>(lds, g, So, E);
        }
        SEAM(base + 3);
        if (PH_EN(10) && IN(base + 4)) {
            const float* Xl = li == 0 ? pp->in[0] : X; const float* Xc = li == 0 ? pp->in[2] : (const float*)((const bf16_t*)X + (size_t)TL * 1024);
            thin::LnrArgs A{Xl, Xc, (const bf16_t*)(R1 + R_Y), (float*)(ws + WS_STATS), H, modl, pp->in[6] + li * 1024, pp->in[7] + li * 1024, (const bf16_t*)(ws + WS_RTW) + (size_t)li * 2 * 65536, pp->in[24] + li * 4, pp->in[26] + li * 32, cnt, list, tokw, Mpost};
            if (NREP(10) == 2) { thin::LnrArgs A2 = A; A2.STATS = (float*)R1; A2.H = (bf16_t*)(R1 + (size_t)T * 4096); A2.cnt = (int*)(ws + WS_CTL) + CW_CNT + 4 * NE * 64; A2.list = (int*)(R1 + (size_t)T * 6144); A2.tokw = (float*)(R1 + (size_t)T * 6144 + (size_t)NE * T * 4);
#ifdef LNR_PROBE
            thin::phase_lnr<LNR_PROBE>(lds, A2, G, cid);
#else
            thin::phase_lnr(lds, A2, G, cid);
#endif
            }
            if (li == 0) thin::phase_lnr<0, false>(lds, A, G, cid); else thin::phase_lnr<0, true>(lds, A, G, cid);
        }
        SEAM(base + 4);
        if (IN(base + 5) || IN(base + 6)) {
            { int tq_ = threadIdx.x; asm volatile("" : "+v"(tq_));
              if (tq_ < NE) MISC[64 + tq_] = (unsigned)((cnt[tq_ * 64] + 255) >> 8);
              __syncthreads();
              if (tq_ <= NE) { unsigned a = 0; for (int e = 0; e < NE; ++e) a += e < tq_ ? MISC[64 + e] : 0u; MISC[16 + tq_] = a; } }
            __syncthreads();
        }
        if (PH_EN(11) && IN(base + 5)) {
            pg8::Gemm g{H, (const bf16_t*)(ws + WS_WGU) + (size_t)li * NE * 1024 * 1024, 1024};
            MoeOrder<true> So{(const LAS int*)(lds + MISC_OFF + 64), cnt, list, G, cid};
            epi::EpiGU E{(bf16_t*)(R1 + R_ACT)};
            for (int rep = 0; rep < NREP(11); ++rep) pg8::gemm_phase<epi::EpiGU, MoeOrder<true>, true>(lds, g, So, E);
        }
        SEAM(base + 5);
        if (PH_EN(12) && IN(base + 6)) {
            pg8::Gemm g{(const bf16_t*)(R1 + R_ACT), (const bf16_t*)(ws + WS_WD) + (size_t)li * NE * 1024 * 512, 512};
            MoeOrder<false> So{(const LAS int*)(lds + MISC_OFF + 64), cnt, list, G, cid};
            epi::EpiDown E{(bf16_t*)(R1 + R_Y2), list, cnt, tokw};
            for (int rep = 0; rep < NREP(12); ++rep) pg8::gemm_phase<epi::EpiDown, MoeOrder<false>, true>(lds, g, So, E);
        }
        SEAM(base + 6);
        if (PH_EN(13) && IN(base + 7)) {
            const float* Xl = li == 0 ? pp->in[0] : X; const float* Xc = li == 0 ? pp->in[2] : (const float*)((const bf16_t*)X + (size_t)TL * 1024);
            thin::LnfArgs A{Xl, Xc, (const bf16_t*)(R1 + R_Y), (const float*)(ws + WS_STATS), (const bf16_t*)(R1 + R_Y2), modl, pp->in[6] + li * 1024, pp->in[7] + li * 1024, pp->in[8] + li * 1024, pp->in[9] + li * 1024, last ? pp->out : X, last ? nullptr : H, last ? nullptr : mod + (size_t)(li + 1) * 9 * 6144, Mpost};
            if (NREP(13) == 2 && !last) { thin::LnfArgs A2 = A; A2.Xout = pp->out; A2.H = O; A2.nrows = TL; thin::phase_lnf(A2, G, cid); }
            if (li == 0) thin::phase_lnf16<false, true>(lds, A, G, cid); else if (!last) thin::phase_lnf16<true, true>(lds, A, G, cid); else thin::phase_lnf16<true, false>(lds, A, G, cid);
        }
        if (!last) SEAM(base + 7);
    }
#undef IN
#undef SEAM
}

extern "C" void kernel_launch(void* const* d_in, const int* in_sizes, int n_in, void* d_out, int out_size, void* d_ws, size_t ws_size, hipStream_t stream) {
    static int grid = 0;
    if (grid == 0) {
        if (n_in != 30 || ws_size < WS_END) { grid = -1; return; }
        int dev = 0, cus = 0;
        if (hipGetDevice(&dev) != hipSuccess || hipDeviceGetAttribute(&cus, hipDeviceAttributeMultiprocessorCount, dev) != hipSuccess) { grid = -1; return; }
        if (hipFuncSetAttribute((const void*)k_run, hipFuncAttributeMaxDynamicSharedMemorySize, LDS_BYTES) != hipSuccess) { grid = -1; return; }
        int per_cu = 0;
        if (hipOccupancyMaxActiveBlocksPerMultiprocessor(&per_cu, (const void*)k_run, NTHREADS, LDS_BYTES) != hipSuccess || per_cu < 1) { (void)hipGetLastError(); grid = -1; return; }
        grid = cus;
    }
    if (grid < 0) return;
    (void)hipMemsetAsync((char*)d_ws + WS_CTL, 0, CTL_ZERO_BYTES, stream);
    Params p{};
    for (int i = 0; i < 30; ++i) p.in[i] = (const float*)d_in[i];
    p.out = (float*)d_out; p.ws = (unsigned char*)d_ws;
#if ONE_LAUNCH
    p.ph_lo = 0; p.ph_hi = NPH;
    k_run<<<dim3(grid), dim3(NTHREADS), LDS_BYTES, stream>>>(p);
#else
    for (int ph = 0; ph < NPH; ++ph) {
        if (ph >= 2 && ((ph - 2) % 8) == 1 && (((ph - 2) / 8) % 3) != 1) continue;
        p.ph_lo = ph; p.ph_hi = ph + 1;
        k_run<<<dim3(grid), dim3(NTHREADS), LDS_BYTES, stream>>>(p);
    }
#endif
}
```
